# Optimizing an MI355X kernel written in HIP

```python
import math
import jax, jax.numpy as jnp
from jax import lax
import numpy as np

D_MODEL = 1024
BATCH = 8
SEQ = 4096
DEPTH = 1

ATTN_HEADS = 8
ATTN_HEAD_DIM = 64
ATTN_V_DIM = 2 * ATTN_HEAD_DIM
ROPE_THETA = 500000.0
ROPE_DIM = ATTN_HEAD_DIM // 4
Q_BLOCK = 128
GMLP_WIDTH = D_MODEL
GMLP_GROUPS = 8
GMLP_GROUP_DIM = GMLP_WIDTH // GMLP_GROUPS
GMLP_CHUNK = 128
PEER_HEADS = 8
PEER_KEYS = 128
PEER_EXPERTS = PEER_KEYS * PEER_KEYS
PEER_TOPK = 16
PEER_QDIM = 256
PEER_HALF = PEER_QDIM // 2
PEER_TOKEN_BLOCK = 128
NORM_EPS = 1e-6
N_MOD = 6

Q_COLS = ATTN_HEADS * 2 * ATTN_HEAD_DIM
K_COLS = ATTN_HEADS * 2 * ATTN_HEAD_DIM
V_COLS = ATTN_HEADS * ATTN_V_DIM
Z_COLS = 2 * GMLP_WIDTH
GATE_COLS = 2 * D_MODEL
IN_COLS = Q_COLS + K_COLS + V_COLS + Z_COLS + GATE_COLS
SPLITS = [Q_COLS, Q_COLS + K_COLS, Q_COLS + K_COLS + V_COLS, Q_COLS + K_COLS + V_COLS + Z_COLS]

kernel_name = "hybrid_diffattn_gmlp_peer_encoder"


def rms_norm(x, g):
    xf = x.astype(jnp.float32)
    y = xf * lax.rsqrt(jnp.mean(xf * xf, axis=-1, keepdims=True) + NORM_EPS)
    return (y * g.astype(jnp.float32)).astype(x.dtype)


def layer_norm(x, g, b):
    xf = x.astype(jnp.float32)
    mu = jnp.mean(xf, axis=-1, keepdims=True)
    var = jnp.mean(jnp.square(xf - mu), axis=-1, keepdims=True)
    y = (xf - mu) * lax.rsqrt(var + NORM_EPS)
    return (y * g.astype(jnp.float32) + b.astype(jnp.float32)).astype(x.dtype)


def rope_tables(positions, dtype):
    inv_freq = ROPE_THETA ** (-jnp.arange(0, ROPE_DIM, 2, dtype=jnp.float32) / ROPE_DIM)
    ang = positions.astype(jnp.float32)[..., None] * inv_freq
    return (jnp.cos(ang)[:, :, None, None, :].astype(dtype),
            jnp.sin(ang)[:, :, None, None, :].astype(dtype))


def partial_rope(t, cos, sin):
    half = ROPE_DIM // 2
    r1 = t[..., :half]
    r2 = t[..., half:ROPE_DIM]
    return jnp.concatenate([r1 * cos - r2 * sin, r2 * cos + r1 * sin, t[..., ROPE_DIM:]], axis=-1)


def diff_attention(q, k, v, lam):
    B, S = q.shape[0], q.shape[1]
    nb = S // Q_BLOCK
    scale = ATTN_HEAD_DIM ** -0.5
    qb = (q * scale).reshape(B, nb, Q_BLOCK, ATTN_HEADS, 2, ATTN_HEAD_DIM).transpose(1, 0, 2, 3, 4, 5)

    def block(qi):
        s = jnp.einsum('bqhtd,bkhtd->bhtqk', qi, k).astype(jnp.float32)
        p = jax.nn.softmax(s, axis=-1)
        a = p[:, :, 0] - lam * p[:, :, 1]
        return jnp.einsum('bhqk,bkhe->bqhe', a.astype(v.dtype), v)

    o = lax.map(block, qb)
    return o.transpose(1, 0, 2, 3, 4).reshape(B, S, ATTN_HEADS, ATTN_V_DIM)


def spatial_gating(z, ln_g, ln_b, w_s, b_s):
    u, v = jnp.split(z, 2, axis=-1)
    v = layer_norm(v, ln_g, ln_b)
    B, S = v.shape[0], v.shape[1]
    vc = v.reshape(B, S // GMLP_CHUNK, GMLP_CHUNK, GMLP_GROUPS, GMLP_GROUP_DIM)
    sv = jnp.einsum('gpq,bcqgh->bcpgh', w_s, vc) + b_s.T[None, None, :, :, None]
    return u * sv.reshape(B, S, GMLP_WIDTH)


def peer(h, w_q, sub_keys, exp_u, exp_v):
    B, S, D = h.shape
    q = (h @ w_q).reshape(B, S, PEER_HEADS, 2, PEER_HALF)
    s = jnp.einsum('bshtd,htnd->bshtn', q, sub_keys).astype(jnp.float32)
    s_top, i_top = lax.top_k(s, PEER_TOPK)
    cand = s_top[..., 0, :, None] + s_top[..., 1, None, :]
    cand_idx = i_top[..., 0, :, None] * PEER_KEYS + i_top[..., 1, None, :]
    cand = cand.reshape(B, S, PEER_HEADS, PEER_TOPK * PEER_TOPK)
    cand_idx = cand_idx.reshape(B, S, PEER_HEADS, PEER_TOPK * PEER_TOPK)
    best, sel = lax.top_k(cand, PEER_TOPK)
    idx = jnp.take_along_axis(cand_idx, sel, axis=-1)
    g = jax.nn.softmax(best, axis=-1).astype(h.dtype)
    T = B * S
    E = PEER_HEADS * PEER_TOPK
    nb = T // PEER_TOKEN_BLOCK
    xt = h.reshape(nb, PEER_TOKEN_BLOCK, D)
    it = idx.reshape(nb, PEER_TOKEN_BLOCK, E)
    gt = g.reshape(nb, PEER_TOKEN_BLOCK, E)

    def block(args):
        xb, ib, gb = args
        u = exp_u[ib]
        a = jax.nn.gelu(jnp.einsum('td,ted->te', xb, u)) * gb
        return jnp.einsum('te,ted->td', a, exp_v[ib])

    y = lax.map(block, (xt, it, gt))
    return y.reshape(B, S, D)


def setup_inputs(seed: int = 0) -> dict:
    key = jax.random.key(seed)
    ks = jax.random.split(key, 32)
    f32 = jnp.float32
    L, D = DEPTH, D_MODEL

    def nrm(k, shape, std):
        return jax.random.normal(k, shape, f32) * std

    def gain(k, shape):
        return 1.0 + 0.02 * jax.random.normal(k, shape, f32)

    x = jax.random.normal(ks[0], (BATCH, SEQ, D), f32)
    c = jax.random.normal(ks[1], (BATCH, D), f32)
    offset = jax.random.randint(ks[2], (BATCH, 1), 0, 1024, dtype=jnp.int32)
    positions = jnp.arange(SEQ, dtype=jnp.int32)[None, :] + offset
    return {
        "x": x,
        "c": c,
        "positions": positions,
        "w_ada": nrm(ks[3], (L, D, N_MOD * D), 0.5 * D ** -0.5),
        "b_ada": nrm(ks[4], (L, N_MOD * D), 0.02),
        "g_pre_mix": gain(ks[5], (L, D)),
        "g_post_mix": gain(ks[6], (L, D)),
        "w_in": nrm(ks[7], (L, D, IN_COLS), D ** -0.5),
        "lambda_q1": nrm(ks[8], (L, ATTN_HEAD_DIM), 0.1),
        "lambda_k1": nrm(ks[9], (L, ATTN_HEAD_DIM), 0.1),
        "lambda_q2": nrm(ks[10], (L, ATTN_HEAD_DIM), 0.1),
        "lambda_k2": nrm(ks[11], (L, ATTN_HEAD_DIM), 0.1),
        "g_subln": gain(ks[12], (L, ATTN_V_DIM)),
        "w_attn_branch": nrm(ks[13], (L, V_COLS, D), V_COLS ** -0.5),
        "gmlp_ln_g": gain(ks[14], (L, GMLP_WIDTH)),
        "gmlp_ln_b": nrm(ks[15], (L, GMLP_WIDTH), 0.02),
        "w_spatial": nrm(ks[16], (L, GMLP_GROUPS, GMLP_CHUNK, GMLP_CHUNK), GMLP_CHUNK ** -0.5),
        "b_spatial": gain(ks[17], (L, GMLP_GROUPS, GMLP_CHUNK)),
        "w_gmlp_branch": nrm(ks[18], (L, GMLP_WIDTH, D), GMLP_WIDTH ** -0.5),
        "w_out": nrm(ks[19], (L, D, D), D ** -0.5),
        "g_pre_ffn": gain(ks[20], (L, D)),
        "g_post_ffn": gain(ks[21], (L, D)),
        "w_peer_q": nrm(ks[22], (L, D, PEER_HEADS * PEER_QDIM), D ** -0.5),
        "peer_sub_keys": nrm(ks[23], (L, PEER_HEADS, 2, PEER_KEYS, PEER_HALF), PEER_HALF ** -0.5),
        "peer_u": nrm(ks[24], (L, PEER_EXPERTS, D), D ** -0.5),
        "peer_v": nrm(ks[25], (L, PEER_EXPERTS, D), PEER_HEADS ** -0.5),
    }


def reference(x, c, positions, w_ada, b_ada, g_pre_mix, g_post_mix, w_in,
              lambda_q1, lambda_k1, lambda_q2, lambda_k2, g_subln, w_attn_branch,
              gmlp_ln_g, gmlp_ln_b, w_spatial, b_spatial, w_gmlp_branch, w_out,
              g_pre_ffn, g_post_ffn, w_peer_q, peer_sub_keys, peer_u, peer_v):
    B, S, D = x.shape
    cos, sin = rope_tables(positions, x.dtype)
    c_act = jax.nn.silu(c)
    for l in range(DEPTH):
        mod = c_act @ w_ada[l] + b_ada[l]
        sh1, sc1, gt1, sh2, sc2, gt2 = [m[:, None, :] for m in jnp.split(mod, N_MOD, axis=-1)]

        h = rms_norm(x, g_pre_mix[l]) * (1.0 + sc1) + sh1
        p = h @ w_in[l]
        q, k, v, z, gates = jnp.split(p, SPLITS, axis=-1)

        q = partial_rope(q.reshape(B, S, ATTN_HEADS, 2, ATTN_HEAD_DIM), cos, sin)
        k = partial_rope(k.reshape(B, S, ATTN_HEADS, 2, ATTN_HEAD_DIM), cos, sin)
        v = v.reshape(B, S, ATTN_HEADS, ATTN_V_DIM)
        lambda_init = 0.8 - 0.6 * math.exp(-0.3 * l)
        lam = (jnp.exp(jnp.sum(lambda_q1[l].astype(jnp.float32) * lambda_k1[l].astype(jnp.float32)))
               - jnp.exp(jnp.sum(lambda_q2[l].astype(jnp.float32) * lambda_k2[l].astype(jnp.float32)))
               + lambda_init)
        o = diff_attention(q, k, v, lam)
        o = rms_norm(o, g_subln[l]) * (1.0 - lambda_init)
        y_attn = o.reshape(B, S, V_COLS) @ w_attn_branch[l]

        sg = spatial_gating(jax.nn.gelu(z), gmlp_ln_g[l], gmlp_ln_b[l], w_spatial[l], b_spatial[l])
        y_gmlp = sg @ w_gmlp_branch[l]

        gate_a, gate_g = jnp.split(jax.nn.sigmoid(gates), 2, axis=-1)
        mix = (gate_a * y_attn + gate_g * y_gmlp) @ w_out[l]
        x = x + gt1 * rms_norm(mix, g_post_mix[l])

        h2 = rms_norm(x, g_pre_ffn[l]) * (1.0 + sc2) + sh2
        y = peer(h2, w_peer_q[l], peer_sub_keys[l], peer_u[l], peer_v[l])
        x = x + gt2 * rms_norm(y, g_post_ffn[l])
    return x
```

```cpp
#include <hip/hip_runtime.h>
#include <cstdio>
#include <cstdint>
namespace pg8 {
#define PG8_LAS __attribute__((address_space(3)))
typedef unsigned short bf16_t;
typedef short bf16x8 __attribute__((ext_vector_type(8)));
typedef float f32x4 __attribute__((ext_vector_type(4)));
typedef unsigned u32x4 __attribute__((ext_vector_type(4)));
constexpr int BM = 256, BK = 64, HALF = 128, HTB = HALF * BK * 2  , STAGE_BYTES = 8 * HTB, NXCD = 8, WGM = 8;

__host__ __device__ __forceinline__ int lds_byte(int r, int c) { const int st = (r >> 4) * 2 + (c >> 5), rr = r & 15, cc = c & 31, ob = rr * 64 + cc * 2; return st * 1024 + (ob ^ (((ob >> 9) & 1) << 5)); }
__host__ __device__ __forceinline__ void stage_rc(int b, int& R, int& C) { const int st = b / 1024, sb = b % 1024, swz = sb ^ (((sb >> 9) & 1) << 5); R = (st >> 1) * 16 + swz / 64; C = (st & 1) * 32 + (swz % 64) / 2; }
__host__ __device__ __forceinline__ int perm32(int rho) { const int n = rho >> 4, i = rho & 15; return 8 * (i >> 2) + 4 * n + (i & 3); }

struct Unit { int pm, pn, w; };
struct Gemm { const bf16_t* A0; const bf16_t* A1; const bf16_t* B0; const bf16_t* B1; int M, N, K; };

struct StaticOrder {
    int nM, nN, nwg, G, c, passes;
    __host__ __device__ void init(int M, int N, int G_, int c_, int passes_ = 1) { nM = M / BM; nN = N / BM; nwg = nM * nN; G = G_; c = c_; passes = passes_; }
    __host__ __device__ bool next(int i, Unit& u) const {
        const int ti = (passes == 2) ? (i >> 1) : i; u.w = (passes == 2) ? (i & 1) : 0;
        const long L = (long)ti * G + c; if (L >= nwg) return false;
        int wgid = (int)L; { const int q = nwg / NXCD, r = nwg % NXCD, xcd = wgid % NXCD, off = wgid / NXCD; wgid = (xcd < r ? xcd * (q + 1) : r * (q + 1) + (xcd - r) * q) + off; }
        const int nig = WGM * nN, gid = wgid / nig, fm = gid * WGM, gsz = (nM - fm) < WGM ? (nM - fm) : WGM;
        u.pm = fm + ((wgid % nig) % gsz); u.pn = (wgid % nig) / gsz; return true;
    }
    __device__ __forceinline__ void a_ready(const Unit&) const {}
    __device__ __forceinline__ void done(const Unit&) const {}
};

typedef float f32x2c __attribute__((ext_vector_type(2))); typedef __bf16 bf16x2c __attribute__((ext_vector_type(2)));
__device__ __forceinline__ unsigned cvt_pk_bf16(float lo, float hi) { f32x2c v = {lo, hi}; bf16x2c b = __builtin_convertvector(v, bf16x2c); return __builtin_bit_cast(unsigned, b); }
typedef float f32x2 __attribute__((ext_vector_type(2)));
__device__ __forceinline__ f32x2 gelu_pk(f32x2 v) {
    const f32x2 av = __builtin_elementwise_abs(v), d = av * 0.2316418882f + 1.0f;
    f32x2 t; t.x = __builtin_amdgcn_rcpf(d.x); t.y = __builtin_amdgcn_rcpf(d.y);
    f32x2 q = t * 0.5307027145f + (-0.7265760135f); q = q * t + 0.7107068705f; q = q * t + (-0.142248368f); q = q * t + 0.127414796f; q = q * t;
    const f32x2 s = (v * v) * (-0.72134752044f);
    f32x2 e; e.x = __builtin_amdgcn_exp2f(s.x); e.y = __builtin_amdgcn_exp2f(s.y);
    const f32x2 m = v * (q * e), r = v - m;
    f32x2 o; o.x = v.x < 0.f ? m.x : r.x; o.y = v.y < 0.f ? m.y : r.y; return o;
}

template <int ACT  > struct EpiBf16 {
    static constexpr bool PERM = true, AFTER_DRAIN = false; static_assert(ACT == 0 || ACT == 1, "EpiBf16: ACT is 0 (none) or 1 (gelu_pk)");
    bf16_t* O; int ldc; const float* bias; int split_cols; size_t split_stride; float scale0;
    __device__ __forceinline__ void operator()(const f32x4 (&acc)[2][2][4][2], const Unit& u, int wr, int wc, int fr, int fq) const {
        const int row0 = u.pm * BM + wr * 64 + fr; int colt = u.pn * BM; bf16_t* base = O;
        float sc = 1.f; if (split_cols) { const int t = colt / split_cols; base += (size_t)t * split_stride; colt -= t * split_cols; if (t == 0) sc = scale0; }
        const int col0 = colt + wc * 32 + 8 * fq, bcol0 = u.pn * BM + wc * 32 + 8 * fq;
        f32x4 bv[2][2];
#pragma unroll
        for (int bj = 0; bj < 2; ++bj)
#pragma unroll
            for (int n = 0; n < 2; ++n) bv[bj][n] = bias ? *(const f32x4*)(bias + bcol0 + bj * HALF + 4 * n) : (f32x4){0.f, 0.f, 0.f, 0.f};
#pragma unroll
        for (int ai = 0; ai < 2; ++ai)
#pragma unroll
            for (int m = 0; m < 4; ++m) { bf16_t* rowp = base + (size_t)(row0 + ai * HALF + m * 16) * ldc + col0;
#pragma unroll
                for (int bj = 0; bj < 2; ++bj) { f32x4 v0 = acc[ai][bj][m][0] + bv[bj][0], v1 = acc[ai][bj][m][1] + bv[bj][1];
                    if (ACT == 1) { f32x2 a = gelu_pk((f32x2){v0[0], v0[1]}), b = gelu_pk((f32x2){v0[2], v0[3]}), c = gelu_pk((f32x2){v1[0], v1[1]}), d = gelu_pk((f32x2){v1[2], v1[3]});
                        v0 = (f32x4){a.x, a.y, b.x, b.y}; v1 = (f32x4){c.x, c.y, d.x, d.y}; }
                    v0 = v0 * sc; v1 = v1 * sc; u32x4 w; w.x = cvt_pk_bf16(v0[0], v0[1]); w.y = cvt_pk_bf16(v0[2], v0[3]); w.z = cvt_pk_bf16(v1[0], v1[1]); w.w = cvt_pk_bf16(v1[2], v1[3]);
                    *(u32x4*)(rowp + bj * HALF) = w; } }
    }
};

template <class Epi, class Sched, bool ALIGN_EPI = false, bool SP2 = false>
__device__ __forceinline__ void gemm_phase(PG8_LAS unsigned char* lds, const Gemm g, const Sched& S, const Epi& E) {
    const int tid = threadIdx.x, wid = __builtin_amdgcn_readfirstlane(tid >> 6), lane = tid & 63, wr = wid >> 2, wc = wid & 3, fr = lane & 15, fq = lane >> 4;
    const int K = g.K, nt = K / BK;
    unsigned voffA[2], voffB[2];
#pragma unroll
    for (int i = 0; i < 2; ++i) { int R, C; stage_rc(tid * 16 + i * 8192, R, C); const int Rb = Epi::PERM ? ((R & ~31) + perm32(R & 31)) : R;
        voffA[i] = (unsigned)(R * K + C) * 2u; voffB[i] = (unsigned)(Rb * K + C) * 2u; }
    const size_t kstep = (size_t)(BK * 2);
    const size_t hstep = (size_t)HALF * K * 2;
    const size_t tstep = 2 * hstep;
    const unsigned ldsw = (unsigned)wid * 1024u;
    const int aoff = lds_byte(wr * 64 + fr, fq * 8), boff = lds_byte(wc * 32 + fr, fq * 8);
#define PG8_SA(b, h) (((b) * 2 + (h)) * HTB)
#define PG8_SB(b, h) ((4 + (b) * 2 + (h)) * HTB)
#define PG8_STAGE(bufoff, gbase, voff) do { _Pragma("unroll") for (int _i = 0; _i < 2; ++_i) \
        __builtin_amdgcn_global_load_lds((const unsigned*)((const char*)(gbase) + (voff)[_i]), (PG8_LAS unsigned*)(lds + (bufoff) + ldsw + _i * 8192), 16, 0, 0); } while (0)
#define PG8_LDA(dst, b, h) do { _Pragma("unroll") for (int m = 0; m < 4; ++m) _Pragma("unroll") for (int k = 0; k < 2; ++k) dst[m][k] = *(const PG8_LAS bf16x8*)(lds + PG8_SA(b, h) + aoff + m * 2048 + k * 1024); } while (0)
#define PG8_LDB(dst, b, h) do { _Pragma("unroll") for (int n = 0; n < 2; ++n) _Pragma("unroll") for (int k = 0; k < 2; ++k) dst[n][k] = *(const PG8_LAS bf16x8*)(lds + PG8_SB(b, h) + boff + n * 2048 + k * 1024); } while (0)
#define PG8_MMA(ai, bj, At, Bt) do { __builtin_amdgcn_s_setprio(1); _Pragma("unroll") for (int m = 0; m < 4; ++m) _Pragma("unroll") for (int n = 0; n < 2; ++n) _Pragma("unroll") for (int k = 0; k < 2; ++k) \
        acc[ai][bj][m][n] = __builtin_amdgcn_mfma_f32_16x16x32_bf16(Bt[n][k], At[m][k], acc[ai][bj][m][n], 0, 0, 0); __builtin_amdgcn_s_setprio(0); } while (0)
#define PG8_WAIT_V(n) asm volatile("s_waitcnt vmcnt(" #n ")" ::: "memory")
#define PG8_WAIT_L(n) asm volatile("s_waitcnt lgkmcnt(" #n ")" ::: "memory")
#define PG8_BAR __builtin_amdgcn_s_barrier()
#define PG8_SCHED __builtin_amdgcn_sched_barrier(0)
    Unit cur, nxt; int ui = 0;
    if (!S.next(0, cur)) return;
    f32x4 acc[2][2][4][2];
#pragma unroll
    for (int a = 0; a < 2; ++a)
#pragma unroll
        for (int b = 0; b < 2; ++b)
#pragma unroll
            for (int m = 0; m < 4; ++m)
#pragma unroll
                for (int n = 0; n < 2; ++n) acc[a][b][m][n] = (f32x4){0.f, 0.f, 0.f, 0.f};
    bf16x8 At[4][2], B0[2][2], B1[2][2];
    const char* cA = (const char*)(cur.w ? g.A1 : g.A0) + (size_t)cur.pm * tstep; const char* cB = (const char*)(cur.w ? g.B1 : g.B0) + (size_t)cur.pn * tstep;
    S.a_ready(cur);
    if constexpr (SP2) {
        PG8_STAGE(PG8_SB(0, 0), cB, voffB); PG8_STAGE(PG8_SB(0, 1), cB + hstep, voffB); PG8_STAGE(PG8_SA(0, 0), cA, voffA); PG8_STAGE(PG8_SA(0, 1), cA + hstep, voffA);
        if (wr == 1) PG8_BAR;
        PG8_WAIT_V(2); PG8_BAR;
        PG8_STAGE(PG8_SB(1, 0), cB + kstep, voffB); PG8_STAGE(PG8_SA(1, 0), cA + kstep, voffA); PG8_STAGE(PG8_SB(1, 1), cB + hstep + kstep, voffB);
        PG8_WAIT_V(6); PG8_BAR;
    } else {
        PG8_STAGE(PG8_SB(0, 0), cB, voffB); PG8_STAGE(PG8_SA(0, 0), cA, voffA); PG8_STAGE(PG8_SB(0, 1), cB + hstep, voffB); PG8_STAGE(PG8_SA(0, 1), cA + hstep, voffA);
        if (wr == 1) PG8_BAR;
        PG8_WAIT_V(4); PG8_BAR;
        PG8_STAGE(PG8_SB(1, 0), cB + kstep, voffB); PG8_STAGE(PG8_SA(1, 0), cA + kstep, voffA); PG8_STAGE(PG8_SB(1, 1), cB + hstep + kstep, voffB);
        PG8_WAIT_V(6); PG8_BAR;
    }
    for (;;) {
        const bool has_next = S.next(ui + 1, nxt);
        const char* nA = has_next ? (const char*)(nxt.w ? g.A1 : g.A0) + (size_t)nxt.pm * tstep : cA; const char* nB = has_next ? (const char*)(nxt.w ? g.B1 : g.B0) + (size_t)nxt.pn * tstep : cB;
        for (int t = 0; t < nt; t += 2) {
            const bool last = (t == nt - 2);
            const char* a1 = cA + (size_t)(t + 1) * kstep;
            const char* a2 = last ? nA : cA + (size_t)(t + 2) * kstep; const char* b2 = last ? nB : cB + (size_t)(t + 2) * kstep;
            const char* a3 = a2 + kstep; const char* b3 = b2 + kstep;
            if (last && has_next) S.a_ready(nxt);
            if constexpr (SP2) {
            PG8_LDB(B0, 0, 0); PG8_LDB(B1, 0, 1); PG8_SCHED; PG8_LDA(At, 0, 0); PG8_STAGE(PG8_SA(1, 1), a1 + hstep, voffA);
            PG8_WAIT_V(8); PG8_WAIT_L(0); PG8_BAR; PG8_MMA(0, 0, At, B0); PG8_MMA(0, 1, At, B1); PG8_BAR; PG8_SCHED;
            PG8_LDA(At, 0, 1); PG8_STAGE(PG8_SB(0, 0), b2, voffB); PG8_STAGE(PG8_SB(0, 1), b2 + hstep, voffB); PG8_STAGE(PG8_SA(0, 0), a2, voffA);
            PG8_WAIT_V(8); PG8_WAIT_L(0); PG8_BAR; PG8_MMA(1, 0, At, B0); PG8_MMA(1, 1, At, B1); PG8_BAR; PG8_SCHED;
            PG8_LDB(B0, 1, 0); PG8_LDB(B1, 1, 1); PG8_SCHED; PG8_LDA(At, 1, 0); PG8_STAGE(PG8_SA(0, 1), a2 + hstep, voffA);
            PG8_WAIT_V(8); PG8_WAIT_L(0); PG8_BAR; PG8_MMA(0, 0, At, B0); PG8_MMA(0, 1, At, B1); PG8_BAR; PG8_SCHED;
            PG8_LDA(At, 1, 1); PG8_STAGE(PG8_SB(1, 0), b3, voffB); PG8_STAGE(PG8_SB(1, 1), b3 + hstep, voffB); PG8_STAGE(PG8_SA(1, 0), a3, voffA);
            PG8_WAIT_V(8); PG8_WAIT_L(0); PG8_BAR; PG8_MMA(1, 0, At, B0); PG8_MMA(1, 1, At, B1); PG8_BAR; PG8_SCHED;
            } else {
            PG8_LDB(B0, 0, 0); PG8_SCHED; PG8_LDA(At, 0, 0); PG8_STAGE(PG8_SA(1, 1), a1 + hstep, voffA);
            PG8_WAIT_L(8); PG8_BAR; PG8_WAIT_L(0); PG8_MMA(0, 0, At, B0); PG8_BAR; PG8_SCHED;
            PG8_LDB(B1, 0, 1); PG8_STAGE(PG8_SB(0, 0), b2, voffB);
            PG8_BAR; PG8_WAIT_L(0); PG8_MMA(0, 1, At, B1); PG8_BAR;
            PG8_LDA(At, 0, 1); PG8_STAGE(PG8_SA(0, 0), a2, voffA);
            PG8_BAR; PG8_WAIT_L(0); PG8_MMA(1, 0, At, B0); PG8_BAR; PG8_SCHED;
            PG8_STAGE(PG8_SB(0, 1), b2 + hstep, voffB);
            PG8_WAIT_V(6); PG8_BAR; PG8_MMA(1, 1, At, B1); PG8_BAR;
            PG8_LDB(B0, 1, 0); PG8_SCHED; PG8_LDA(At, 1, 0); PG8_STAGE(PG8_SA(0, 1), a2 + hstep, voffA);
            PG8_WAIT_L(8); PG8_BAR; PG8_WAIT_L(0); PG8_MMA(0, 0, At, B0); PG8_BAR; PG8_SCHED;
            PG8_LDB(B1, 1, 1); PG8_STAGE(PG8_SB(1, 0), b3, voffB);
            PG8_BAR; PG8_WAIT_L(0); PG8_MMA(0, 1, At, B1); PG8_BAR;
            PG8_LDA(At, 1, 1); PG8_STAGE(PG8_SA(1, 0), a3, voffA);
            PG8_BAR; PG8_WAIT_L(0); PG8_MMA(1, 0, At, B0); PG8_BAR; PG8_SCHED;
            PG8_STAGE(PG8_SB(1, 1), b3 + hstep, voffB);
            PG8_WAIT_V(6); PG8_BAR; PG8_MMA(1, 1, At, B1); PG8_BAR;
            }
        }
        if constexpr (ALIGN_EPI) { if (wr == 0) PG8_BAR; }
        if constexpr (!Epi::AFTER_DRAIN) { E(acc, cur, wr, wc, fr, fq); S.done(cur); }
        if (!has_next) break;
#pragma unroll
        for (int a = 0; a < 2; ++a)
#pragma unroll
            for (int b = 0; b < 2; ++b)
#pragma unroll
                for (int m = 0; m < 4; ++m)
#pragma unroll
                    for (int n = 0; n < 2; ++n) acc[a][b][m][n] = (f32x4){0.f, 0.f, 0.f, 0.f};
        cur = nxt; cA = nA; cB = nB; ++ui;
        if constexpr (ALIGN_EPI) { if (wr == 1) PG8_BAR; }
    }
    PG8_WAIT_V(0);
    if constexpr (!ALIGN_EPI) { if (wr == 0) PG8_BAR; }
    PG8_BAR;
    if constexpr (Epi::AFTER_DRAIN) { E.fused(acc, cur, wr, wc, fr, fq, lds, wid, lane); S.done(cur); }
#undef PG8_SA
#undef PG8_SB
#undef PG8_STAGE
#undef PG8_LDA
#undef PG8_LDB
#undef PG8_MMA
#undef PG8_WAIT_V
#undef PG8_WAIT_L
#undef PG8_BAR
#undef PG8_SCHED
}
}

constexpr int BATCH = 8, SEQ = 4096, D = 1024, M = BATCH * SEQ, NIN = 7168, NMOD = 6 * D, NEXP = 16384, NPQ = 2048;
constexpr float EPS = 1e-6f;
constexpr int NWAVES = 8;
#ifndef MK_N_LAUNCHES
#define MK_N_LAUNCHES 1
#endif
#define DBG_STOP 99
#define PEER_OPT 7
constexpr int NPHASE = 13;
constexpr int N_LAUNCHES = MK_N_LAUNCHES;

constexpr size_t MiB = 1u << 20;
constexpr size_t WS_CTL = 0, CTL_ZERO_BYTES = 2 * MiB;
constexpr size_t WS_MOD = 1 * MiB;
constexpr size_t WS_ROPE = 2 * MiB;
constexpr size_t WS_STATS = 4 * MiB;
constexpr size_t WS_WIN = 8 * MiB, WS_WA = 22 * MiB, WS_WG = 24 * MiB, WS_WOUT = 26 * MiB, WS_WPQ = 28 * MiB, WS_KEYS = 32 * MiB, WS_WSP = 33 * MiB;
constexpr size_t WS_XN = 40 * MiB, WS_Q = 104 * MiB, WS_K = 168 * MiB, WS_V = 232 * MiB, WS_U = 296 * MiB, WS_ZV = 360 * MiB, WS_END = 424 * MiB;
constexpr size_t WS_O0 = WS_XN;
constexpr size_t WS_T1 = WS_K;
constexpr size_t WS_MIXIN = WS_ZV;
constexpr size_t WS_H2 = WS_XN;
constexpr size_t WS_QP = WS_K;
constexpr size_t WS_IDX = WS_U, WS_GATE = WS_U + 16 * MiB;
constexpr size_t WS_PU = WS_Q, WS_PV = WS_Q + 32 * MiB;
constexpr size_t WS_PART = WS_K;
constexpr size_t WS_A = WS_U + 32 * MiB;
constexpr size_t WS_Y = WS_K;
constexpr int CW_TMO = 0, CW_BAR = 4096;

constexpr int RING_BYTES = 131072, LDSCTL_OFF = RING_BYTES, MISC_OFF = LDSCTL_OFF + 320, LDS_BYTES = 147456;

#define GAS __attribute__((address_space(1)))
#define LAS __attribute__((address_space(3)))
typedef unsigned short bf16;
typedef unsigned v4u __attribute__((ext_vector_type(4)));
typedef unsigned v2u __attribute__((ext_vector_type(2)));
typedef float f32x4 __attribute__((ext_vector_type(4)));
typedef float f32x2 __attribute__((ext_vector_type(2)));
typedef float f32x16 __attribute__((ext_vector_type(16)));
typedef short bf16x8 __attribute__((ext_vector_type(8)));
typedef short s16x4 __attribute__((ext_vector_type(4)));
typedef __bf16 bf16x2_t __attribute__((ext_vector_type(2)));
typedef GAS unsigned gu32;
#define RLX_AGENT __ATOMIC_RELAXED, __HIP_MEMORY_SCOPE_AGENT
#define LDS_WAIT() asm volatile("s_waitcnt lgkmcnt(0)" ::: "memory")
#define VM_WAIT() asm volatile("s_waitcnt vmcnt(0)" ::: "memory")
#define SBAR() __builtin_amdgcn_sched_barrier(0)
__device__ __forceinline__ unsigned f2bf(float f) { unsigned u = __builtin_bit_cast(unsigned, f); return (u + 0x7fffu + ((u >> 16) & 1u)) >> 16; }
__device__ __forceinline__ unsigned pk2(float lo, float hi) { f32x2 v = {lo, hi}; bf16x2_t b = __builtin_convertvector(v, bf16x2_t); return __builtin_bit_cast(unsigned, b); }
__device__ __forceinline__ float bflo(unsigned w) { return __builtin_bit_cast(float, w << 16); }
__device__ __forceinline__ float bfhi(unsigned w) { return __builtin_bit_cast(float, w & 0xffff0000u); }
__device__ __forceinline__ float gelu_tanh(float x) {
    const float u = x * (0.7978845608f + 0.035677408137f * x * x);
    const float e = __builtin_amdgcn_exp2f(-2.885390081777927f * u);
    return x * __builtin_amdgcn_rcpf(1.f + e);
}
__device__ __forceinline__ float sigmoidf_(float x) { return __builtin_amdgcn_rcpf(1.f + __builtin_amdgcn_exp2f(-1.4426950408889634f * x)); }
__device__ __forceinline__ float wave_sum(float v) {
#pragma unroll
    for (int o = 1; o < 64; o <<= 1) v += __shfl_xor(v, o);
    return v;
}
__device__ __forceinline__ int crow(int r, int hi) { return (r & 3) + 8 * (r >> 2) + 4 * hi; }


namespace pg8 {
typedef float f32x2e __attribute__((ext_vector_type(2)));
__device__ __forceinline__ float bf_lo(unsigned w) { return __builtin_bit_cast(float, w << 16); }
__device__ __forceinline__ float bf_hi(unsigned w) { return __builtin_bit_cast(float, w & 0xffff0000u); }
__device__ __forceinline__ float gelu_t(float x) { const float u = x * (0.7978845608f + 0.035677408137f * x * x); const float e = __builtin_amdgcn_exp2f(-2.885390081777927f * u); return x * __builtin_amdgcn_rcpf(1.f + e); }
__device__ __forceinline__ float sigm(float x) { return __builtin_amdgcn_rcpf(1.f + __builtin_amdgcn_exp2f(-1.4426950408889634f * x)); }
__device__ __forceinline__ u32x4 pack8(const f32x4& a, const f32x4& b) { u32x4 w; w.x = cvt_pk_bf16(a[0], a[1]); w.y = cvt_pk_bf16(a[2], a[3]); w.z = cvt_pk_bf16(b[0], b[1]); w.w = cvt_pk_bf16(b[2], b[3]); return w; }

struct EpiInProj {
    static constexpr bool PERM = true, AFTER_DRAIN = false;
    bf16_t* Q; bf16_t* K; bf16_t* V; bf16_t* U; bf16_t* ZV; bf16_t* GA; bf16_t* GG; const float* rope; float* stats;
    __device__ __forceinline__ void operator()(const f32x4 (&acc)[2][2][4][2], const Unit& u, int wr, int wc, int fr, int fq) const {
        const int ty = u.pn >> 2;
        const int row0 = u.pm * BM + wr * 64 + fr;
        const int cc0 = (u.pn & 3) * BM + wc * 32 + 8 * fq;
        bf16_t* base = ty == 0 ? Q : ty == 1 ? K : ty == 2 ? V : ty == 3 ? U : ty == 4 ? ZV : ty == 5 ? GA : GG;
        if (ty <= 1) {
            const bool even = (wc & 1) == 0;
            const bool part = even && fq < 2;
            const float sg = (fq == 0) ? -1.f : 1.f;
#pragma unroll
            for (int ai = 0; ai < 2; ++ai)
#pragma unroll
                for (int m = 0; m < 4; ++m) {
                    const int row = row0 + ai * HALF + m * 16;
                    f32x4 c0 = {1.f, 1.f, 1.f, 1.f}, c1 = c0, s0 = {0.f, 0.f, 0.f, 0.f}, s1 = s0;
                    if (even) { const f32x4* rp = (const f32x4*)(rope + (size_t)row * 16); c0 = rp[0]; c1 = rp[1]; s0 = rp[2]; s1 = rp[3]; }
#pragma unroll
                    for (int bj = 0; bj < 2; ++bj) {
                        f32x4 v0 = acc[ai][bj][m][0], v1 = acc[ai][bj][m][1];
                        if (even) {
                            f32x4 p0, p1;
#pragma unroll
                            for (int j = 0; j < 4; ++j) { p0[j] = __shfl_xor(v0[j], 16); p1[j] = __shfl_xor(v1[j], 16); }
                            if (part) { v0 = v0 * c0 + (p0 * s0) * sg; v1 = v1 * c1 + (p1 * s1) * sg; }
                        }
                        *(u32x4*)(base + (size_t)row * 1024 + cc0 + bj * HALF) = pack8(v0, v1);
                    }
                }
        } else if (ty == 2) {
#pragma unroll
            for (int ai = 0; ai < 2; ++ai)
#pragma unroll
                for (int m = 0; m < 4; ++m) { const int row = row0 + ai * HALF + m * 16;
#pragma unroll
                    for (int bj = 0; bj < 2; ++bj) *(u32x4*)(base + (size_t)row * 1024 + cc0 + bj * HALF) = pack8(acc[ai][bj][m][0], acc[ai][bj][m][1]); }
        } else if (ty <= 4) {
#pragma unroll
            for (int ai = 0; ai < 2; ++ai)
#pragma unroll
                for (int m = 0; m < 4; ++m) { const int row = row0 + ai * HALF + m * 16; float s = 0.f, q = 0.f;
#pragma unroll
                    for (int bj = 0; bj < 2; ++bj) { f32x4 v0 = acc[ai][bj][m][0], v1 = acc[ai][bj][m][1];
#pragma unroll
                        for (int j = 0; j < 4; ++j) { v0[j] = gelu_t(v0[j]); v1[j] = gelu_t(v1[j]); }
                        const u32x4 w = pack8(v0, v1);
                        *(u32x4*)(base + (size_t)row * 1024 + cc0 + bj * HALF) = w;
                        if (ty == 4) {
#pragma unroll
                            for (int j = 0; j < 4; ++j) { const float a = bf_lo(w[j]), b = bf_hi(w[j]); s += a + b; q += a * a + b * b; } }
                    }
                    if (ty == 4) { s += __shfl_xor(s, 16); s += __shfl_xor(s, 32); q += __shfl_xor(q, 16); q += __shfl_xor(q, 32);
                        if (fq == 0) { f32x2e o = {s, q}; *(f32x2e*)(stats + ((size_t)row * 16 + (u.pn & 3) * 4 + wc) * 2) = o; } }
                }
        } else {
#pragma unroll
            for (int ai = 0; ai < 2; ++ai)
#pragma unroll
                for (int m = 0; m < 4; ++m) { const int row = row0 + ai * HALF + m * 16;
#pragma unroll
                    for (int bj = 0; bj < 2; ++bj) { f32x4 v0 = acc[ai][bj][m][0], v1 = acc[ai][bj][m][1];
#pragma unroll
                        for (int j = 0; j < 4; ++j) { v0[j] = sigm(v0[j]); v1[j] = sigm(v1[j]); }
                        *(u32x4*)(base + (size_t)row * 1024 + cc0 + bj * HALF) = pack8(v0, v1); } }
        }
    }
};

struct EpiMerge {
    static constexpr bool PERM = true, AFTER_DRAIN = false;
    const bf16_t* GA; const bf16_t* GG; float* T1; bf16_t* O;
    __device__ __forceinline__ void operator()(const f32x4 (&acc)[2][2][4][2], const Unit& u, int wr, int wc, int fr, int fq) const {
        const int row0 = u.pm * BM + wr * 64 + fr, col0 = u.pn * BM + wc * 32 + 8 * fq;
        const bf16_t* G = u.w == 0 ? GA : GG;
#pragma unroll
        for (int ai = 0; ai < 2; ++ai)
#pragma unroll
            for (int m = 0; m < 4; ++m) { const size_t ro = (size_t)(row0 + ai * HALF + m * 16) * 1024 + col0;
#pragma unroll
                for (int bj = 0; bj < 2; ++bj) { const size_t off = ro + bj * HALF;
                    const u32x4 g = *(const u32x4*)(G + off);
                    f32x4 v0 = acc[ai][bj][m][0], v1 = acc[ai][bj][m][1];
                    v0[0] *= bf_lo(g.x); v0[1] *= bf_hi(g.x); v0[2] *= bf_lo(g.y); v0[3] *= bf_hi(g.y);
                    v1[0] *= bf_lo(g.z); v1[1] *= bf_hi(g.z); v1[2] *= bf_lo(g.w); v1[3] *= bf_hi(g.w);
                    if (u.w == 0) { *(f32x4*)(T1 + off) = v0; *(f32x4*)(T1 + off + 4) = v1; }
                    else { const f32x4 t0 = *(const f32x4*)(T1 + off), t1 = *(const f32x4*)(T1 + off + 4); *(u32x4*)(O + off) = pack8(v0 + t0, v1 + t1); } } }
    }
};

struct EpiF32 {
    static constexpr bool PERM = true, AFTER_DRAIN = false;
    float* O; int ldc;
    __device__ __forceinline__ void operator()(const f32x4 (&acc)[2][2][4][2], const Unit& u, int wr, int wc, int fr, int fq) const {
        const int row0 = u.pm * BM + wr * 64 + fr, col0 = u.pn * BM + wc * 32 + 8 * fq;
#pragma unroll
        for (int ai = 0; ai < 2; ++ai)
#pragma unroll
            for (int m = 0; m < 4; ++m) { float* rowp = O + (size_t)(row0 + ai * HALF + m * 16) * ldc + col0;
#pragma unroll
                for (int bj = 0; bj < 2; ++bj) { *(f32x4*)(rowp + bj * HALF) = acc[ai][bj][m][0]; *(f32x4*)(rowp + bj * HALF + 4) = acc[ai][bj][m][1]; } }
    }
};
}
#define XB_TMO      128
#define XB_XCNT(j)  (256  + 64 * (j))
#define XB_XSUB(j)  (1280 + 64 * (j))
#define XB_XGEN(j)  (2304 + 64 * (j))
#define XB_TOP      3328
#define XB_TOPGEN   3392
#define XCD_BAR_WORDS 3456
#define XB_SPIN_CAP (1u << 18)

__device__ __forceinline__ unsigned xb_ld(unsigned* p)              { return __hip_atomic_load(p, __ATOMIC_RELAXED, __HIP_MEMORY_SCOPE_AGENT); }
__device__ __forceinline__ unsigned xb_add(unsigned* p, unsigned v) { return __hip_atomic_fetch_add(p, v, __ATOMIC_RELAXED, __HIP_MEMORY_SCOPE_AGENT); }
__device__ __forceinline__ unsigned xb_xcc_id() { return (unsigned)__builtin_amdgcn_s_getreg((3 << 11) | 20) & 0xFu; }
#define XB_SPIN(cond, bar) do { unsigned _sp = 0; while (cond) { __builtin_amdgcn_s_sleep(1); \
    if ((++_sp & 255u) == 0u) { if (xb_ld(&(bar)[XB_TMO])) break; if (_sp > XB_SPIN_CAP) { atomicAdd(&(bar)[XB_TMO], 1u); break; } } } } while (0)

struct XcdBarrier {
    unsigned* bar; unsigned x;
    volatile LAS unsigned* st;
};

__device__ __forceinline__ XcdBarrier xcd_barrier_post(unsigned* bar, volatile LAS unsigned* st) {
    XcdBarrier b; b.bar = bar; b.x = xb_xcc_id(); b.st = st;
    if (threadIdx.x == 0) (void)xb_add(&bar[XB_XCNT(b.x)], 1u);
    return b;
}
__device__ __forceinline__ void xcd_barrier_complete(unsigned* bar, unsigned x, unsigned& nloc, unsigned& nx) {
    const unsigned G = gridDim.x * gridDim.y * gridDim.z;
    unsigned sum, cnt, mine, sp = 0u;
    for (;;) {
        sum = 0u; cnt = 0u; mine = 0u;
#pragma unroll
        for (unsigned j = 0; j < 16; ++j) { const unsigned c = xb_ld(&bar[XB_XCNT(j)]); sum += c; cnt += (c > 0u) ? 1u : 0u; mine = (j == x) ? c : mine; }
        if (sum == G) break;
        __builtin_amdgcn_s_sleep(1);
        if ((++sp & 255u) == 0u) { if (xb_ld(&bar[XB_TMO])) break; if (sp > XB_SPIN_CAP) { atomicAdd(&bar[XB_TMO], 1u); break; } }
    }
    nloc = mine > 0u ? mine : 1u; nx = cnt > 0u ? cnt : 1u;
}

__device__ __forceinline__ void xcd_barrier(const XcdBarrier& b) {
    asm volatile("s_waitcnt vmcnt(0)" ::: "memory");
    __syncthreads();
    if (threadIdx.x == 0) {
        unsigned* bar = b.bar;
        __builtin_amdgcn_s_waitcnt(0);
        unsigned nloc = b.st[0], nx = b.st[1];
        if (nloc == 0u) { xcd_barrier_complete(bar, b.x, nloc, nx); b.st[0] = nloc; b.st[1] = nx; }
        const unsigned old = xb_add(&bar[XB_XSUB(b.x)], 1u);
        const unsigned gen = old / nloc;
        if (old + 1u == (gen + 1u) * nloc) {
            __builtin_amdgcn_fence(__ATOMIC_RELEASE, "agent");
            asm volatile("s_waitcnt vmcnt(0)" ::: "memory");
            const unsigned og = xb_add(&bar[XB_TOP], 1u);
            const unsigned tg = og / nx;
            if (og + 1u == (tg + 1u) * nx) xb_add(&bar[XB_TOPGEN], 1u);
            else XB_SPIN(xb_ld(&bar[XB_TOPGEN]) == tg, bar);
            __builtin_amdgcn_fence(__ATOMIC_ACQUIRE, "agent");
            xb_add(&bar[XB_XGEN(b.x)], 1u);
            asm volatile("s_waitcnt vmcnt(0)" ::: "memory");
        } else {
            XB_SPIN(xb_ld(&bar[XB_XGEN(b.x)]) == gen, bar);
            __builtin_amdgcn_fence(__ATOMIC_ACQUIRE, "agent");
            asm volatile("s_waitcnt vmcnt(0)" ::: "memory");
        }
    }
    __syncthreads();
}

struct Frame {
    LAS unsigned char* lds; int tid, lane, wave, vcu, G;
};

__device__ __forceinline__ void p0_transpose_item(const float* W, int K, int N, bf16* WT, LAS float* scr, int item, int lane) {
    const int nblk = N / 32, kb = item / nblk, nb = item % nblk, k0 = 64 * kb, n0 = 32 * nb;
#pragma unroll 8
    for (int i = 0; i < 32; ++i) { const int kk = 2 * i + (lane >> 5); scr[kk * 33 + (lane & 31)] = W[(size_t)(k0 + kk) * N + n0 + (lane & 31)]; }
    LDS_WAIT(); asm volatile("" ::: "memory");
    const int c = lane & 7;
#pragma unroll
    for (int j = 0; j < 4; ++j) { const int n = (lane >> 3) + 8 * j; const LAS float* s = scr + (8 * c) * 33 + n;
        v4u o; o.x = pk2(s[0 * 33], s[1 * 33]); o.y = pk2(s[2 * 33], s[3 * 33]); o.z = pk2(s[4 * 33], s[5 * 33]); o.w = pk2(s[6 * 33], s[7 * 33]);
        *(GAS v4u*)(WT + (size_t)(n0 + n) * K + k0 + 8 * c) = o; }
    LDS_WAIT(); asm volatile("" ::: "memory");
}
__device__ __forceinline__ void cvt_plain(const Frame& F, const float* src, bf16* dst, long n8) {
    const long gt = (long)(F.vcu * NWAVES + F.wave) * 64 + F.lane, NT = (long)F.G * NWAVES * 64;
    for (long i = gt; i < n8; i += NT) { const f32x4 a = *(const GAS f32x4*)(src + i * 8), b = *(const GAS f32x4*)(src + i * 8 + 4);
        v4u o; o.x = pk2(a[0], a[1]); o.y = pk2(a[2], a[3]); o.z = pk2(b[0], b[1]); o.w = pk2(b[2], b[3]); *(GAS v4u*)(dst + i * 8) = o; }
}
__device__ __forceinline__ void sincos_d(double r, float& s, float& c) {
    const double z = r * r;
    double ps = 1.9572941063391263e-20; ps = ps * z + -8.22063524662433e-18; ps = ps * z + 2.8114572543455206e-15; ps = ps * z + -7.647163731819816e-13; ps = ps * z + 1.6059043836821613e-10;
    ps = ps * z + -2.505210838544172e-08; ps = ps * z + 2.7557319223985893e-06; ps = ps * z + -0.0001984126984126984; ps = ps * z + 0.008333333333333333; ps = ps * z + -0.16666666666666666; ps = ps * z + 1.0;
    double pc = -8.896791392450574e-22; pc = pc * z + 4.110317623312165e-19; pc = pc * z + -1.5619206968586225e-16; pc = pc * z + 4.779477332387385e-14; pc = pc * z + -1.1470745597729725e-11; pc = pc * z + 2.08767569878681e-09;
    pc = pc * z + -2.755731922398589e-07; pc = pc * z + 2.48015873015873e-05; pc = pc * z + -0.001388888888888889; pc = pc * z + 0.041666666666666664; pc = pc * z + -0.5; pc = pc * z + 1.0;
    s = (float)(r * ps); c = (float)pc;
}
struct P0Args { const float *c, *w_ada, *b_ada, *w_in, *w_a, *w_g, *w_out, *w_pq, *keys, *wsp; const int* pos; unsigned char* ws; };
__device__ __forceinline__ void p0_prologue(const Frame& F, const P0Args& a) {
    LAS float* scr = (LAS float*)(F.lds + F.wave * 16384);
    const int gw = F.vcu * NWAVES + F.wave, NGW = F.G * NWAVES;
    constexpr int I_IN = (D / 64) * (NIN / 32), I_SQ = (D / 64) * (D / 32), I_PQ = (D / 64) * (NPQ / 32), NITEMS = I_IN + 3 * I_SQ + I_PQ;
    for (int it = gw; it < NITEMS; it += NGW) {
        int r = it;
        if (r < I_IN) { p0_transpose_item(a.w_in, D, NIN, (bf16*)(a.ws + WS_WIN), scr, r, F.lane); continue; } r -= I_IN;
        if (r < I_SQ) { p0_transpose_item(a.w_a, D, D, (bf16*)(a.ws + WS_WA), scr, r, F.lane); continue; } r -= I_SQ;
        if (r < I_SQ) { p0_transpose_item(a.w_g, D, D, (bf16*)(a.ws + WS_WG), scr, r, F.lane); continue; } r -= I_SQ;
        if (r < I_SQ) { p0_transpose_item(a.w_out, D, D, (bf16*)(a.ws + WS_WOUT), scr, r, F.lane); continue; } r -= I_SQ;
        p0_transpose_item(a.w_pq, D, NPQ, (bf16*)(a.ws + WS_WPQ), scr, r, F.lane);
    }
    cvt_plain(F, a.keys, (bf16*)(a.ws + WS_KEYS), 8 * 2 * 128 * 128 / 8);
    cvt_plain(F, a.wsp, (bf16*)(a.ws + WS_WSP), 8 * 128 * 128 / 8);
    { const long gt = (long)gw * 64 + F.lane, NT = (long)NGW * 64; float* rope = (float*)(a.ws + WS_ROPE);
      for (long m = gt; m < M; m += NT) { const double p = (double)a.pos[m];
          const double invf[8] = {1.0, 0.19392274474868576, 0.03760603093086393, 0.007292664737217109, 0.001414213562373095, 0.0002742481756762073, 5.318295896944988e-05, 1.031338537721246e-05};
          float cs[8], sn[8];
#pragma unroll
          for (int i = 0; i < 8; ++i) { const double ang = p * invf[i]; const double k = __builtin_rint(ang * 0.15915494309189535); const double r = ang - k * 6.283185307179586; sincos_d(r, sn[i], cs[i]); }
          f32x4* o = (f32x4*)(rope + m * 16);
          o[0] = (f32x4){cs[0], cs[1], cs[2], cs[3]}; o[1] = (f32x4){cs[4], cs[5], cs[6], cs[7]}; o[2] = (f32x4){sn[0], sn[1], sn[2], sn[3]}; o[3] = (f32x4){sn[4], sn[5], sn[6], sn[7]}; } }
    { float* mod = (float*)(a.ws + WS_MOD); LAS float* red = (LAS float*)F.lds;
      __syncthreads();
      for (int it = F.vcu; it < NMOD / 32; it += F.G) { const int col = it * 32 + (F.lane & 31), kh = F.lane >> 5, k0 = F.wave * 128 + kh * 64;
          float acc[8];
#pragma unroll
          for (int b = 0; b < 8; ++b) acc[b] = 0.f;
#pragma unroll 8
          for (int kk = 0; kk < 64; ++kk) { const int k = k0 + kk; const float w = a.w_ada[(size_t)k * NMOD + col];
#pragma unroll
              for (int b = 0; b < 8; ++b) { const float cv = a.c[b * D + k]; const float sl = cv * __builtin_amdgcn_rcpf(1.f + __expf(-cv)); acc[b] += sl * w; } }
#pragma unroll
          for (int b = 0; b < 8; ++b) red[((F.wave * 2 + kh) * 8 + b) * 32 + (F.lane & 31)] = acc[b];
          __syncthreads();
          if (F.tid < 256) { const int b = F.tid >> 5, c = F.tid & 31; float s = a.b_ada[it * 32 + c];
#pragma unroll
              for (int p = 0; p < 16; ++p) s += red[(p * 8 + b) * 32 + c];
              mod[b * NMOD + it * 32 + c] = s; }
          __syncthreads(); } }
}

__device__ __forceinline__ void p1_xn(const Frame& F, const float* x, const float* g_pre, const float* mod, bf16* XN) {
    const int gw = F.vcu * NWAVES + F.wave, NGW = F.G * NWAVES;
    for (int m = gw; m < M; m += NGW) { const int b = m >> 12;
        const GAS f32x4* xr = (const GAS f32x4*)(x + (size_t)m * D) + F.lane;
        f32x4 v[4]; float ss = 0.f;
#pragma unroll
        for (int j = 0; j < 4; ++j) { v[j] = xr[64 * j]; ss += (v[j].x * v[j].x + v[j].y * v[j].y) + (v[j].z * v[j].z + v[j].w * v[j].w); }
        const float rs = 1.f / sqrtf(wave_sum(ss) * (1.f / D) + EPS);
        GAS v2u* o8 = (GAS v2u*)(XN + (size_t)m * D) + F.lane;
#pragma unroll
        for (int j = 0; j < 4; ++j) { const int col = 256 * j + 4 * F.lane;
            const f32x4 g = *(const f32x4*)(g_pre + col), sh = *(const f32x4*)(mod + b * NMOD + col), sc = *(const f32x4*)(mod + b * NMOD + D + col);
            const f32x4 h = v[j] * rs * g * (sc + 1.f) + sh; v2u w; w.x = pk2(h.x, h.y); w.y = pk2(h.z, h.w); o8[64 * j] = w; }
    }
}

__device__ __forceinline__ s16x4 tr_read_dyn(unsigned addr) { s16x4 r; asm volatile("ds_read_b64_tr_b16 %0, %1" : "=&v"(r) : "v"(addr) : "memory"); return r; }
struct GmlpArgs { const bf16* ZV; bf16* U; const float* stats; const float* ln_g; const float* ln_b; const bf16* wsp; const float* b_s; };
__device__ __forceinline__ void p3_gmlp(const Frame& F, const GmlpArgs& a) {
    LAS unsigned char* T = F.lds + F.wave * 16384;
    LAS float* MR = (LAS float*)(F.lds + LDSCTL_OFF + 1024);
    const int g = F.wave, lane = F.lane, L31 = lane & 31, hh = lane >> 5;
    const unsigned Tb = (unsigned)(uintptr_t)T;
    const int qq = (lane & 15) >> 2, p4 = lane & 3, g16 = (lane >> 4) & 1, sw = (qq >> 1) & 1;
    const unsigned rb0 = Tb + (8 * hh + qq) * 128 + 64 * (0 ^ sw) + (16 * g16 + 4 * p4) * 2;
    const unsigned rb1 = Tb + (8 * hh + qq) * 128 + 64 * (1 ^ sw) + (16 * g16 + 4 * p4) * 2;
    for (int ck = F.vcu; ck < M / 128; ck += F.G) {
        const size_t rowc = (size_t)ck * 128;
        __syncthreads();
        if (F.tid < 128) { const f32x4* sp = (const f32x4*)(a.stats + (rowc + F.tid) * 32); float s = 0.f, q = 0.f;
#pragma unroll
            for (int j = 0; j < 8; ++j) { const f32x4 t = sp[j]; s += t.x + t.z; q += t.y + t.w; }
            const float mu = s * (1.f / 1024.f), var = q * (1.f / 1024.f) - mu * mu;
            MR[2 * F.tid] = mu; MR[2 * F.tid + 1] = 1.f / sqrtf(fmaxf(var, 0.f) + EPS); }
        __syncthreads();
#pragma unroll 1
        for (int half = 0; half < 2; ++half) {
            const int cbase = g * 128 + half * 64;
            { const int c0 = 8 * (lane & 7);
              const f32x4 ga = *(const f32x4*)(a.ln_g + cbase + c0), gb = *(const f32x4*)(a.ln_g + cbase + c0 + 4), ba = *(const f32x4*)(a.ln_b + cbase + c0), bb = *(const f32x4*)(a.ln_b + cbase + c0 + 4);
#pragma unroll 4
              for (int i = 0; i < 16; ++i) { const int q = (lane >> 3) + 8 * i;
                  const v4u w = *(const GAS v4u*)(a.ZV + (rowc + q) * 1024 + cbase + c0);
                  const float mu = MR[2 * q], rs = MR[2 * q + 1];
                  f32x4 x0 = {bflo(w.x), bfhi(w.x), bflo(w.y), bfhi(w.y)}, x1 = {bflo(w.z), bfhi(w.z), bflo(w.w), bfhi(w.w)};
                  x0 = (x0 - mu) * rs * ga + ba; x1 = (x1 - mu) * rs * gb + bb;
                  v4u o; o.x = pk2(x0[0], x0[1]); o.y = pk2(x0[2], x0[3]); o.z = pk2(x1[0], x1[1]); o.w = pk2(x1[2], x1[3]);
                  *(LAS v4u*)(T + q * 128 + ((c0 * 2) ^ (((q >> 1) & 1) << 6))) = o; } }
            LDS_WAIT(); asm volatile("" ::: "memory");
#pragma unroll 1
            for (int pb = 0; pb < 4; ++pb) {
                bf16x8 af[8];
#pragma unroll
                for (int ks = 0; ks < 8; ++ks) af[ks] = *(const GAS bf16x8*)(a.wsp + ((size_t)(g * 128 + pb * 32 + L31)) * 128 + 16 * ks + 8 * hh);
                f32x16 acc0 = {}, acc1 = {};
#pragma unroll
                for (int ks = 0; ks < 8; ++ks) {
                    const s16x4 l0 = tr_read_dyn(rb0 + ks * 2048), h0 = tr_read_dyn(rb0 + ks * 2048 + 512), l1 = tr_read_dyn(rb1 + ks * 2048), h1 = tr_read_dyn(rb1 + ks * 2048 + 512);
                    asm volatile("s_waitcnt lgkmcnt(0)" ::: "memory"); SBAR();
                    const bf16x8 b0 = {l0[0], l0[1], l0[2], l0[3], h0[0], h0[1], h0[2], h0[3]}, b1 = {l1[0], l1[1], l1[2], l1[3], h1[0], h1[1], h1[2], h1[3]};
                    acc0 = __builtin_amdgcn_mfma_f32_32x32x16_bf16(af[ks], b0, acc0, 0, 0, 0);
                    acc1 = __builtin_amdgcn_mfma_f32_32x32x16_bf16(af[ks], b1, acc1, 0, 0, 0);
                }
#pragma unroll
                for (int r = 0; r < 16; ++r) { const int p = pb * 32 + crow(r, hh); const float bs = a.b_s[g * 128 + p];
                    bf16* up = a.U + (rowc + p) * 1024 + cbase + L31;
                    const float u0 = bflo((unsigned)up[0]), u1 = bflo((unsigned)up[32]);
                    up[0] = (bf16)f2bf(u0 * (acc0[r] + bs)); up[32] = (bf16)f2bf(u1 * (acc1[r] + bs)); }
            }
            LDS_WAIT(); asm volatile("" ::: "memory");
        }
    }
    __syncthreads();
}

namespace att {
constexpr int NW = 8, QBLK = 32, KVBLK = 64, LD = 1024;
constexpr float SCALE = 0.125f, THR = 8.f;
constexpr int SHM_V = 16384, SHM_K = 8192, OFF_V = 0, OFF_K = 2 * SHM_V, OFF_WS = OFF_K + 2 * SHM_K, OFF_STG = OFF_WS + NW * 64 * 4, ATT_LDS = OFF_STG + NW * 8192;
static_assert(ATT_LDS <= 131072, "attention LDS");
#define KSWZ64(row, colB) ((row) * 128 + ((colB) ^ ((((row) >> 1) & 7) << 4)))
__device__ __forceinline__ unsigned cvtpk(float lo, float hi) { return pk2(lo, hi); }
__device__ __forceinline__ void partialSM(f32x16& p0, f32x16& p1, float& m_reg, float& mn, float& alpha) {
  constexpr float C = SCALE * 1.4426950408889634f;
  float pmax = p0[0];
#pragma unroll
  for (int r = 1; r < 16; ++r) pmax = fmaxf(pmax, p0[r]);
#pragma unroll
  for (int r = 0; r < 16; ++r) pmax = fmaxf(pmax, p1[r]);
  { auto rr = __builtin_amdgcn_permlane32_swap(__float_as_uint(pmax), __float_as_uint(pmax), false, false);
    pmax = fmaxf(__uint_as_float(rr[0]), __uint_as_float(rr[1])); }
  if (__builtin_expect(__all(pmax - m_reg <= THR / SCALE), 1)) { mn = m_reg; alpha = 1.f; }
  else { mn = fmaxf(m_reg, pmax); alpha = __builtin_amdgcn_exp2f((m_reg - mn) * C); m_reg = mn; }
  float mnC = -mn * C;
#pragma unroll
  for (int r = 0; r < 16; ++r) p0[r] = fmaf(p0[r], C, mnC);
#pragma unroll
  for (int r = 0; r < 16; ++r) p1[r] = fmaf(p1[r], C, mnC);
#pragma unroll
  for (int r = 0; r < 16; ++r) p0[r] = __builtin_amdgcn_exp2f(p0[r]);
}
__device__ __forceinline__ void finishSM(f32x16& p0, f32x16& p1, float alpha, float& l_reg, bf16x8& pa0, bf16x8& pa1, bf16x8& pa2, bf16x8& pa3) {
#pragma unroll
  for (int r = 0; r < 16; ++r) p1[r] = __builtin_amdgcn_exp2f(p1[r]);
  float ps = 0;
#pragma unroll
  for (int r = 0; r < 16; ++r) ps += p0[r];
#pragma unroll
  for (int r = 0; r < 16; ++r) ps += p1[r];
  { auto rr = __builtin_amdgcn_permlane32_swap(__float_as_uint(ps), __float_as_uint(ps), false, false);
    ps = __uint_as_float(rr[0]) + __uint_as_float(rr[1]); }
  l_reg = l_reg * alpha + ps;
#define PK4(P, BASE, OUT) do { unsigned a0 = cvtpk(P[BASE + 0], P[BASE + 1]), a1 = cvtpk(P[BASE + 2], P[BASE + 3]);   \
    unsigned b0 = cvtpk(P[BASE + 4], P[BASE + 5]), b1 = cvtpk(P[BASE + 6], P[BASE + 7]);                              \
    auto r0 = __builtin_amdgcn_permlane32_swap(a0, b0, false, false); auto r1 = __builtin_amdgcn_permlane32_swap(a1, b1, false, false); \
    v4u w = {r0[0], r1[0], r0[1], r1[1]}; OUT = *reinterpret_cast<bf16x8*>(&w); } while (0)
  PK4(p0, 0, pa0); PK4(p0, 8, pa1); PK4(p1, 0, pa2); PK4(p1, 8, pa3);
#undef PK4
}
__device__ __forceinline__ void qkt(f32x16& p0, f32x16& p1, const char* Ks, const bf16x8* qr, int r32, int hi) {
  p0 = f32x16{}; p1 = f32x16{};
#pragma unroll
  for (int d0 = 0; d0 < 4; ++d0) { const int cb = (d0 * 16 + hi * 8) * 2;
    bf16x8 b0 = *reinterpret_cast<const bf16x8*>(Ks + KSWZ64(r32, cb));
    bf16x8 b1 = *reinterpret_cast<const bf16x8*>(Ks + KSWZ64(32 + r32, cb));
    p0 = __builtin_amdgcn_mfma_f32_32x32x16_bf16(b0, qr[d0], p0, 0, 0, 0);
    p1 = __builtin_amdgcn_mfma_f32_32x32x16_bf16(b1, qr[d0], p1, 0, 0, 0); }
}
__device__ __forceinline__ int v_st(int k, int c) { const int kk = (k & ~0xC) | ((k & 4) << 1) | ((k & 8) >> 1); return ((kk >> 3) * 4 + (c >> 5)) * 512 + ((kk & 7) * 32 + (c & 31)) * 2; }
__device__ __forceinline__ int v_rd_base(int lane) { return ((lane & 3) << 3) | (((lane >> 2) & 3) << 6) | (((lane >> 4) & 1) << 5) | (((lane >> 5) & 1) << 8); }
constexpr int v_rd_off(int d0, int ks, int half) { return d0 * 512 + ks * 4096 + half * 2048; }
template <int OFF> __device__ __forceinline__ s16x4 tr_read(int vb) {
  s16x4 r; asm volatile("ds_read_b64_tr_b16 %0, %1 offset:%2" : "=&v"(r) : "v"(vb), "i"(OFF) : "memory"); return r;
}
template <int D0> __device__ __forceinline__ void pv_one(f32x16& od, int vb, bf16x8 pa0, bf16x8 pa1, bf16x8 pa2, bf16x8 pa3) {
  const s16x4 l0 = tr_read<v_rd_off(D0, 0, 0)>(vb), h0 = tr_read<v_rd_off(D0, 0, 1)>(vb), l1 = tr_read<v_rd_off(D0, 1, 0)>(vb), h1 = tr_read<v_rd_off(D0, 1, 1)>(vb);
  const s16x4 l2 = tr_read<v_rd_off(D0, 2, 0)>(vb), h2 = tr_read<v_rd_off(D0, 2, 1)>(vb), l3 = tr_read<v_rd_off(D0, 3, 0)>(vb), h3 = tr_read<v_rd_off(D0, 3, 1)>(vb);
  asm volatile("s_waitcnt lgkmcnt(0)" ::: "memory"); SBAR();
#define PK(L, H) (bf16x8){L[0], L[1], L[2], L[3], H[0], H[1], H[2], H[3]}
  od = __builtin_amdgcn_mfma_f32_32x32x16_bf16(pa0, PK(l0, h0), od, 0, 0, 0);
  od = __builtin_amdgcn_mfma_f32_32x32x16_bf16(pa1, PK(l1, h1), od, 0, 0, 0);
  od = __builtin_amdgcn_mfma_f32_32x32x16_bf16(pa2, PK(l2, h2), od, 0, 0, 0);
  od = __builtin_amdgcn_mfma_f32_32x32x16_bf16(pa3, PK(l3, h3), od, 0, 0, 0);
#undef PK
}
__device__ __forceinline__ void pv_d0(f32x16* o, int vb, bf16x8 pa0, bf16x8 pa1, bf16x8 pa2, bf16x8 pa3) {
  pv_one<0>(o[0], vb, pa0, pa1, pa2, pa3); pv_one<1>(o[1], vb, pa0, pa1, pa2, pa3); pv_one<2>(o[2], vb, pa0, pa1, pa2, pa3); pv_one<3>(o[3], vb, pa0, pa1, pa2, pa3);
}

template <int t>
__device__ __forceinline__ void attn_pass(const bf16* Qh, const bf16* __restrict__ Kh, const bf16* __restrict__ Vh, bf16* ONh, int q0, float lam, const float* gsub, float* stash, char* lds) {
  int tid = threadIdx.x; asm volatile("" : "+v"(tid));
  const int wid = tid >> 6, lane = tid & 63, r32 = lane & 31, hi = lane >> 5;
  char* V_lds = lds + OFF_V; char* K_lds = lds + OFF_K;
  float* ws = (float*)(lds + OFF_WS) + wid * 64; float* li_l = ws; float* al_l = ws + 32;
  bf16* stg = (bf16*)(lds + OFF_STG + wid * 8192);
  const int sr = tid >> 4, sc = (tid & 15) * 8, vst0 = v_st(sr, sc), vst1 = v_st(32 + sr, sc);
  const int kr = tid >> 3, kc = (tid & 7) * 8, kst = KSWZ64(kr, kc * 2);
  const int vb0 = (int)(uintptr_t)V_lds + v_rd_base(lane);
  constexpr int NT = SEQ / KVBLK;
  {
    const bf16* Kt = Kh + t * 64;
    float m_reg = -1e30f, l_reg = 0; f32x16 o[4] = {}; bf16x8 qr[4];
    const bf16* Qw = Qh + (long)(q0 + wid * QBLK + r32) * LD + t * 64 + hi * 8;
#pragma unroll
    for (int d0 = 0; d0 < 4; ++d0) qr[d0] = *reinterpret_cast<const bf16x8*>(Qw + d0 * 16);
    struct { bf16x8 vs0, vs1, ks0; } sr_[1];
#define SLOAD(i, k0) do { sr_[i].vs0 = *reinterpret_cast<const bf16x8*>(&Vh[(long)((k0) + sr) * LD + sc]); sr_[i].vs1 = *reinterpret_cast<const bf16x8*>(&Vh[(long)((k0) + 32 + sr) * LD + sc]); \
    sr_[i].ks0 = *reinterpret_cast<const bf16x8*>(&Kt[(long)((k0) + kr) * LD + kc]); } while (0)
#define SWRITE(b, i) do { *(bf16x8*)(V_lds + (b) * SHM_V + vst0) = sr_[i].vs0; *(bf16x8*)(V_lds + (b) * SHM_V + vst1) = sr_[i].vs1; \
    *(bf16x8*)(K_lds + (b) * SHM_K + kst) = sr_[i].ks0; } while (0)
#define SWAIT() asm volatile("s_waitcnt vmcnt(0)" ::: "memory")
#define RESC(a) do { if (__any((a) < 1.f)) { if (hi == 0) al_l[r32] = (a); asm volatile("s_waitcnt lgkmcnt(0)" ::: "memory"); \
    _Pragma("unroll") for (int d = 0; d < 4; ++d) _Pragma("unroll") for (int r = 0; r < 16; ++r) o[d][r] *= al_l[crow(r, hi)]; } } while (0)
    f32x16 pA0, pA1, pB0, pB1; float mnA, mnB, alA, alB; bf16x8 pa0, pa1, pa2, pa3;
    constexpr int SE = 0, SO = 0;
    SLOAD(SE, 0); asm volatile("s_waitcnt vmcnt(0)" ::: "memory"); SWRITE(0, SE); __syncthreads();
    qkt(pA0, pA1, K_lds, qr, r32, hi); partialSM(pA0, pA1, m_reg, mnA, alA);
    SLOAD(SO, KVBLK);
    SWAIT(); SWRITE(1, SO); __syncthreads();
    const bool ordB = __builtin_amdgcn_readfirstlane(wid) >= 4;
#define HALFSTEP_A(X0, X1, mnX, alX, Y0, Y1, alY, KOFF, VOFF, LOADSTMT) do { \
      SBAR(); qkt(X0, X1, K_lds + (KOFF), qr, r32, hi); finishSM(Y0, Y1, alY, l_reg, pa0, pa1, pa2, pa3); SBAR(); LOADSTMT; SBAR(); \
      pv_d0(o, vb0 + (VOFF), pa0, pa1, pa2, pa3); partialSM(X0, X1, m_reg, mnX, alX); } while (0)
#define HALFSTEP_B(X0, X1, mnX, alX, Y0, Y1, alY, KOFF, VOFF, LOADSTMT) do { \
      SBAR(); finishSM(Y0, Y1, alY, l_reg, pa0, pa1, pa2, pa3); SBAR(); qkt(X0, X1, K_lds + (KOFF), qr, r32, hi); SBAR(); LOADSTMT; SBAR(); \
      partialSM(X0, X1, m_reg, mnX, alX); SBAR(); pv_d0(o, vb0 + (VOFF), pa0, pa1, pa2, pa3); } while (0)
#define MAINLOOP(HS) \
    _Pragma("unroll 1") for (int j = 1; j + 1 < NT; j += 2) { \
      HS(pB0, pB1, mnB, alB, pA0, pA1, alA, SHM_K, 0, SLOAD(SO, (j + 1) * KVBLK)); \
      __syncthreads(); SWAIT(); SWRITE(0, SE); \
      RESC(alB); __syncthreads(); \
      HS(pA0, pA1, mnA, alA, pB0, pB1, alB, 0, SHM_V, SLOAD(SE, (j + 2) * KVBLK)); \
      __syncthreads(); SWAIT(); SWRITE(1, SO); \
      RESC(alA); __syncthreads(); \
    }
    if (!ordB) { MAINLOOP(HALFSTEP_A) } else { MAINLOOP(HALFSTEP_B) }
#undef MAINLOOP
#undef HALFSTEP_A
#undef HALFSTEP_B
    SBAR(); qkt(pB0, pB1, K_lds + SHM_K, qr, r32, hi);
    finishSM(pA0, pA1, alA, l_reg, pa0, pa1, pa2, pa3); SBAR();
    pv_d0(o, vb0, pa0, pa1, pa2, pa3); partialSM(pB0, pB1, m_reg, mnB, alB);
    __syncthreads(); RESC(alB);
    finishSM(pB0, pB1, alB, l_reg, pa0, pa1, pa2, pa3); SBAR();
    pv_d0(o, vb0 + SHM_V, pa0, pa1, pa2, pa3);
#undef SLOAD
#undef SWRITE
#undef SWAIT
#undef RESC
    if (hi == 0) li_l[r32] = l_reg; asm volatile("s_waitcnt lgkmcnt(0)" ::: "memory");
    float rli[16];
#pragma unroll
    for (int r = 0; r < 16; ++r) rli[r] = __builtin_amdgcn_rcpf(li_l[crow(r, hi)]);
    GAS float* sp = (GAS float*)(stash + (size_t)wid * 4096 + lane);
    asm volatile("" : "+v"(sp));
    if (t == 0) {
#pragma unroll
      for (int r = 0; r < 16; ++r)
#pragma unroll
        for (int d0 = 0; d0 < 4; ++d0) sp[(d0 * 16 + r) * 64] = o[d0][r] * rli[r];
    } else {
      float gs[4];
#pragma unroll
      for (int d0 = 0; d0 < 4; ++d0) gs[d0] = gsub[d0 * 32 + r32] * 0.8f;
#pragma unroll
      for (int r = 0; r < 16; ++r) { float oc[4]; float ss = 0.f;
#pragma unroll
        for (int d0 = 0; d0 < 4; ++d0) { oc[d0] = sp[(d0 * 16 + r) * 64] - lam * (o[d0][r] * rli[r]); ss += oc[d0] * oc[d0]; }
        ss += __shfl_xor(ss, 1); ss += __shfl_xor(ss, 2); ss += __shfl_xor(ss, 4); ss += __shfl_xor(ss, 8); ss += __shfl_xor(ss, 16);
        const float rs = 1.f / sqrtf(ss * (1.f / 128.f) + EPS); const int orow = crow(r, hi);
#pragma unroll
        for (int d0 = 0; d0 < 4; ++d0) stg[orow * 128 + d0 * 32 + r32] = (bf16)f2bf(oc[d0] * rs * gs[d0]); }
      asm volatile("s_waitcnt lgkmcnt(0)" ::: "memory");
      bf16* Ow = ONh + (long)(q0 + wid * QBLK) * LD;
#pragma unroll
      for (int i = 0; i < 8; ++i) { const int row = i * 4 + (lane >> 4), ch = lane & 15; const v4u v = *(const v4u*)(stg + row * 128 + ch * 8); *(v4u*)(Ow + (long)row * LD + ch * 8) = v; }
      asm volatile("s_waitcnt lgkmcnt(0)" ::: "memory");
    }
  }
}
__device__ __forceinline__ void attn_unit(const bf16* Qh, const bf16* __restrict__ Kh, const bf16* __restrict__ Vh, bf16* ONh, int q0, float lam, const float* gsub, float* stash, char* lds) {
  attn_pass<0>(Qh, Kh, Vh, ONh, q0, lam, gsub, stash, lds);
  asm volatile("s_waitcnt vmcnt(0) lgkmcnt(0)" ::: "memory"); SBAR();
  attn_pass<1>(Qh, Kh, Vh, ONh, q0, lam, gsub, stash, lds);
  asm volatile("s_waitcnt vmcnt(0) lgkmcnt(0)" ::: "memory"); SBAR();
}
}

__device__ __forceinline__ void p6_rows(const Frame& F, const float* x, float* io, const float* g_post, const float* g_pre2, const float* mod, bf16* H2) {
    const int gw = F.vcu * NWAVES + F.wave, NGW = F.G * NWAVES;
    for (int m = gw; m < M; m += NGW) { const int b = m >> 12; const float* mb = mod + b * NMOD;
        GAS f32x4* mr = (GAS f32x4*)(io + (size_t)m * D) + F.lane; const GAS f32x4* xr = (const GAS f32x4*)(x + (size_t)m * D) + F.lane;
        f32x4 v[4], xv[4]; float ss = 0.f;
#pragma unroll
        for (int j = 0; j < 4; ++j) { v[j] = mr[64 * j]; xv[j] = xr[64 * j]; ss += (v[j].x * v[j].x + v[j].y * v[j].y) + (v[j].z * v[j].z + v[j].w * v[j].w); }
        const float rs = 1.f / sqrtf(wave_sum(ss) * (1.f / D) + EPS); float s2 = 0.f;
#pragma unroll
        for (int j = 0; j < 4; ++j) { const int col = 256 * j + 4 * F.lane;
            const f32x4 g = *(const f32x4*)(g_post + col), gt = *(const f32x4*)(mb + 2 * D + col);
            v[j] = xv[j] + gt * (v[j] * rs * g); mr[64 * j] = v[j];
            s2 += (v[j].x * v[j].x + v[j].y * v[j].y) + (v[j].z * v[j].z + v[j].w * v[j].w); }
        const float rs2 = 1.f / sqrtf(wave_sum(s2) * (1.f / D) + EPS);
        GAS v2u* o8 = (GAS v2u*)(H2 + (size_t)m * D) + F.lane;
#pragma unroll
        for (int j = 0; j < 4; ++j) { const int col = 256 * j + 4 * F.lane;
            const f32x4 g = *(const f32x4*)(g_pre2 + col), sh = *(const f32x4*)(mb + 3 * D + col), sc = *(const f32x4*)(mb + 4 * D + col);
            const f32x4 h = v[j] * rs2 * g * (sc + 1.f) + sh; v2u w; w.x = pk2(h.x, h.y); w.y = pk2(h.z, h.w); o8[64 * j] = w; }
    }
}

__device__ __forceinline__ float vmaxf(float a, float b) { float r; asm("v_max_f32_e32 %0, %1, %2" : "=v"(r) : "v"(a), "v"(b)); return r; }
__device__ __forceinline__ float vminf(float a, float b) { float r; asm("v_min_f32_e32 %0, %1, %2" : "=v"(r) : "v"(a), "v"(b)); return r; }
#define CE_DESC(a, b) do { const float _mx = vmaxf(a, b), _mn = vminf(a, b); a = _mx; b = _mn; } while (0)
__device__ __forceinline__ void sort16_desc(float (&v)[16]) {
#pragma unroll
    for (int k = 2; k <= 16; k <<= 1)
#pragma unroll
        for (int j = k >> 1; j > 0; j >>= 1)
#pragma unroll
            for (int i = 0; i < 16; ++i) { const int l = i ^ j; if (l > i) { if ((i & k) == 0) CE_DESC(v[i], v[l]); else CE_DESC(v[l], v[i]); } }
}
__device__ __forceinline__ void merge16_desc(float (&a)[16], const float (&b)[16]) {
#pragma unroll
    for (int i = 0; i < 16; ++i) a[i] = vmaxf(a[i], b[15 - i]);
#pragma unroll
    for (int j = 8; j > 0; j >>= 1)
#pragma unroll
        for (int i = 0; i < 16; ++i) { const int l = i ^ j; if (l > i) CE_DESC(a[i], a[l]); }
}
#define FILL_ROUND0 bt[0] = CAND(0, 0); bt[1] = CAND(0, 1); bt[2] = CAND(1, 0); bt[3] = CAND(0, 2); bt[4] = CAND(2, 0); bt[5] = CAND(1, 1); bt[6] = CAND(0, 3); bt[7] = CAND(3, 0); bt[8] = CAND(0, 4); bt[9] = CAND(4, 0); bt[10] = CAND(1, 2); bt[11] = CAND(2, 1); bt[12] = CAND(0, 5); bt[13] = CAND(5, 0); bt[14] = CAND(0, 6); bt[15] = CAND(6, 0);
#define FILL_ROUND1 bt[0] = CAND(1, 3); bt[1] = CAND(3, 1); bt[2] = CAND(0, 7); bt[3] = CAND(7, 0); bt[4] = CAND(2, 2); bt[5] = CAND(0, 8); bt[6] = CAND(8, 0); bt[7] = CAND(1, 4); bt[8] = CAND(4, 1); bt[9] = CAND(0, 9); bt[10] = CAND(9, 0); bt[11] = CAND(0, 10); bt[12] = CAND(10, 0); bt[13] = CAND(2, 3); bt[14] = CAND(3, 2); bt[15] = CAND(1, 5);
#define FILL_ROUND2 bt[0] = CAND(5, 1); bt[1] = CAND(0, 11); bt[2] = CAND(11, 0); bt[3] = CAND(0, 12); bt[4] = CAND(12, 0); bt[5] = CAND(1, 6); bt[6] = CAND(6, 1); bt[7] = CAND(0, 13); bt[8] = CAND(13, 0); bt[9] = CAND(2, 4); bt[10] = CAND(4, 2); bt[11] = CAND(0, 14); bt[12] = CAND(14, 0); bt[13] = CAND(3, 3); bt[14] = CAND(1, 7); bt[15] = CAND(7, 1);
#define FILL_ROUND3 bt[0] = CAND(0, 15); bt[1] = CAND(15, 0); bt[2] = NEG_INF; bt[3] = NEG_INF; bt[4] = NEG_INF; bt[5] = NEG_INF; bt[6] = NEG_INF; bt[7] = NEG_INF; bt[8] = NEG_INF; bt[9] = NEG_INF; bt[10] = NEG_INF; bt[11] = NEG_INF; bt[12] = NEG_INF; bt[13] = NEG_INF; bt[14] = NEG_INF; bt[15] = NEG_INF;
struct RouteArgs { const bf16* QP; const bf16* keys; int* IDX; float* GATE; };
__device__ __forceinline__ void p8_route(const Frame& F, const RouteArgs& a) {
    const int lane = F.lane, L31 = lane & 31, hh = lane >> 5, h = F.wave;
    LAS unsigned char* tab = F.lds + F.wave * 2048 + lane * 32;
    for (int tb = F.vcu; tb < M / 32; tb += F.G) {
        const int tok = tb * 32 + L31;
        float st[2][16];
#pragma unroll
        for (int t = 0; t < 2; ++t) {
            bf16x8 bq[8];
#pragma unroll
            for (int ks = 0; ks < 8; ++ks) bq[ks] = *(const GAS bf16x8*)(a.QP + (size_t)tok * NPQ + h * 256 + t * 128 + 16 * ks + 8 * hh);
            const bf16* kb = a.keys + (size_t)((h * 2 + t) * 128 + L31) * 128 + 8 * hh;
            float top[16];
#pragma unroll 1
            for (int nb = 0; nb < 4; ++nb) {
                f32x16 acc = {};
#pragma unroll
                for (int ks = 0; ks < 8; ++ks) { const bf16x8 af = *(const GAS bf16x8*)(kb + (size_t)nb * 32 * 128 + 16 * ks);
                    acc = __builtin_amdgcn_mfma_f32_32x32x16_bf16(af, bq[ks], acc, 0, 0, 0); }
                float bt[16];
#pragma unroll
                for (int r = 0; r < 16; ++r) bt[r] = __uint_as_float((__float_as_uint(acc[r]) & 0xFFFFFF80u) | (unsigned)(nb * 32 + crow(r, hh)));
                sort16_desc(bt);
                if (nb == 0) {
#pragma unroll
                    for (int r = 0; r < 16; ++r) top[r] = bt[r];
                } else merge16_desc(top, bt);
            }
            { float pt[16];
#pragma unroll
              for (int r = 0; r < 16; ++r) { auto rr = __builtin_amdgcn_permlane32_swap(__float_as_uint(top[r]), __float_as_uint(top[r]), false, false); pt[r] = __uint_as_float(hh ? rr[0] : rr[1]); }
              merge16_desc(top, pt); }
#pragma unroll
            for (int r = 0; r < 16; ++r) st[t][r] = top[r];
        }
        { unsigned w[8];
#pragma unroll
          for (int d = 0; d < 4; ++d) { w[d] = 0u; w[4 + d] = 0u;
#pragma unroll
              for (int k = 0; k < 4; ++k) { w[d] |= (__float_as_uint(st[0][4 * d + k]) & 0x7Fu) << (8 * k); w[4 + d] |= (__float_as_uint(st[1][4 * d + k]) & 0x7Fu) << (8 * k); } }
          *(LAS v4u*)(tab) = (v4u){w[0], w[1], w[2], w[3]}; *(LAS v4u*)(tab + 16) = (v4u){w[4], w[5], w[6], w[7]}; }
        float top[16], bt[16];
        const float NEG_INF = -__builtin_inff();
#define CAND(i, j) __uint_as_float((__float_as_uint(st[0][i] + st[1][j]) & 0xFFFFFF00u) | (unsigned)((i) * 16 + (j)))
        FILL_ROUND0 sort16_desc(bt);
#pragma unroll
        for (int r = 0; r < 16; ++r) top[r] = bt[r];
        FILL_ROUND1 sort16_desc(bt); merge16_desc(top, bt);
        FILL_ROUND2 sort16_desc(bt); merge16_desc(top, bt);
        FILL_ROUND3 sort16_desc(bt); merge16_desc(top, bt);
#undef CAND
        float e[16], es = 0.f;
#pragma unroll
        for (int r = 0; r < 16; ++r) { e[r] = __builtin_amdgcn_exp2f((top[r] - top[0]) * 1.4426950408889634f); es += e[r]; }
        const float inv = 1.f / es;
        LDS_WAIT();
        int ex[16];
#pragma unroll
        for (int r = 0; r < 16; ++r) { const unsigned cell = __float_as_uint(top[r]) & 0xFFu; const unsigned n0 = tab[cell >> 4], n1 = tab[16 + (cell & 15u)]; ex[r] = (int)(n0 * 128u + n1); e[r] *= inv; }
        int oi[8]; float og[8];
#pragma unroll
        for (int k = 0; k < 8; ++k) { oi[k] = hh ? ex[8 + k] : ex[k]; og[k] = hh ? e[8 + k] : e[k]; }
        int* ip = a.IDX + (size_t)tok * 128 + h * 16 + 8 * hh; float* gp = a.GATE + (size_t)tok * 128 + h * 16 + 8 * hh;
        *(GAS v4u*)ip = (v4u){(unsigned)oi[0], (unsigned)oi[1], (unsigned)oi[2], (unsigned)oi[3]}; *(GAS v4u*)(ip + 4) = (v4u){(unsigned)oi[4], (unsigned)oi[5], (unsigned)oi[6], (unsigned)oi[7]};
        *(GAS f32x4*)gp = (f32x4){og[0], og[1], og[2], og[3]}; *(GAS f32x4*)(gp + 4) = (f32x4){og[4], og[5], og[6], og[7]};
        LDS_WAIT(); asm volatile("" ::: "memory");
    }
}

#ifndef TBL_FP8
#define TBL_FP8 1
#endif
constexpr int NSL = TBL_FP8 ? 8 : 16, CW = D / NSL, ESZ = TBL_FP8 ? 1 : 2, ROWB = CW * ESZ, CPL = 16 / ESZ;
static_assert(ROWB == 128 && CPL * 8 == CW, "one cache line per (expert, slice) row, 8 lanes per row");
constexpr float U_SCALE = TBL_FP8 ? 1024.f : 1.f, V_SCALE = TBL_FP8 ? 16.f : 1.f;
__device__ __forceinline__ float dot2bf(unsigned a, unsigned b, float c) { return __builtin_amdgcn_fdot2_f32_bf16(__builtin_bit_cast(bf16x2_t, a), __builtin_bit_cast(bf16x2_t, b), c, false); }
__device__ __forceinline__ float dot8(const v4u a, const v4u b, float c) {
    c = dot2bf(a.x, b.x, c); c = dot2bf(a.y, b.y, c); c = dot2bf(a.z, b.z, c); c = dot2bf(a.w, b.w, c); return c;
}
__device__ __forceinline__ void cvt_table(const Frame& F, const float* src, unsigned char* dst, float scale) {
    const long gt = (long)(F.vcu * NWAVES + F.wave) * 64 + F.lane, NT = (long)F.G * NWAVES * 64, n8 = (long)NEXP * D / 8;
    for (long i = gt; i < n8; i += NT) { const long e = i >> 7; const int c0 = (int)(i & 127) * 8, s = c0 / CW, cc = c0 % CW;
        const f32x4 a = *(const GAS f32x4*)(src + i * 8), b = *(const GAS f32x4*)(src + i * 8 + 4);
        unsigned char* d = dst + ((size_t)s * NEXP + e) * ROWB + cc * ESZ;
#if TBL_FP8
        int w0 = 0, w1 = 0;
        w0 = __builtin_amdgcn_cvt_pk_fp8_f32(a[0] * scale, a[1] * scale, w0, false); w0 = __builtin_amdgcn_cvt_pk_fp8_f32(a[2] * scale, a[3] * scale, w0, true);
        w1 = __builtin_amdgcn_cvt_pk_fp8_f32(b[0] * scale, b[1] * scale, w1, false); w1 = __builtin_amdgcn_cvt_pk_fp8_f32(b[2] * scale, b[3] * scale, w1, true);
        *(GAS v2u*)d = (v2u){(unsigned)w0, (unsigned)w1};
#else
        (void)scale; v4u o; o.x = pk2(a[0], a[1]); o.y = pk2(a[2], a[3]); o.z = pk2(b[0], b[1]); o.w = pk2(b[2], b[3]); *(GAS v4u*)d = o;
#endif
    }
}
template <int CTRL> __device__ __forceinline__ float dpp_mov(float v) { return __builtin_bit_cast(float, __builtin_amdgcn_update_dpp(0, __builtin_bit_cast(int, v), CTRL, 0xF, 0xF, true)); }
#ifndef PEER_OPT
#define PEER_OPT 7
#endif
__device__ __forceinline__ float red8(float v) {
#if PEER_OPT & 1
    v += dpp_mov<0xB1>(v); v += dpp_mov<0x4E>(v); v += dpp_mov<0x141>(v); return v;
#else
    v += __shfl_xor(v, 1); v += __shfl_xor(v, 2); v += __shfl_xor(v, 4); return v;
#endif
}
__device__ __forceinline__ float red_groups(float v) {
#if !(PEER_OPT & 4)
    v += __shfl_xor(v, 8); v += __shfl_xor(v, 16); v += __shfl_xor(v, 32); return v;
#endif
    v += dpp_mov<0x128>(v);
    { unsigned a = __float_as_uint(v), b = a; asm volatile("" : "+v"(a), "+v"(b)); auto r = __builtin_amdgcn_permlane16_swap(a, b, false, false); v = __uint_as_float(r[0]) + __uint_as_float(r[1]); }
    { unsigned a = __float_as_uint(v), b = a; asm volatile("" : "+v"(a), "+v"(b)); auto r = __builtin_amdgcn_permlane32_swap(a, b, false, false); v = __uint_as_float(r[0]) + __uint_as_float(r[1]); }
    return v;
}
#if TBL_FP8
__device__ __forceinline__ void tbl_unpack2(const v4u w, f32x2 (&f)[8]) {
    f[0] = __builtin_amdgcn_cvt_pk_f32_fp8((int)w.x, false); f[1] = __builtin_amdgcn_cvt_pk_f32_fp8((int)w.x, true); f[2] = __builtin_amdgcn_cvt_pk_f32_fp8((int)w.y, false); f[3] = __builtin_amdgcn_cvt_pk_f32_fp8((int)w.y, true);
    f[4] = __builtin_amdgcn_cvt_pk_f32_fp8((int)w.z, false); f[5] = __builtin_amdgcn_cvt_pk_f32_fp8((int)w.z, true); f[6] = __builtin_amdgcn_cvt_pk_f32_fp8((int)w.w, false); f[7] = __builtin_amdgcn_cvt_pk_f32_fp8((int)w.w, true);
}
#endif
__device__ __forceinline__ void tbl_unpack(const v4u w, float (&f)[CPL]) {
#if TBL_FP8
#pragma unroll
    for (int i = 0; i < 4; ++i) { const unsigned x = i == 0 ? w.x : i == 1 ? w.y : i == 2 ? w.z : w.w;
        const f32x2 lo = __builtin_amdgcn_cvt_pk_f32_fp8((int)x, false), hi = __builtin_amdgcn_cvt_pk_f32_fp8((int)x, true);
        f[4 * i] = lo[0]; f[4 * i + 1] = lo[1]; f[4 * i + 2] = hi[0]; f[4 * i + 3] = hi[1]; }
#else
    f[0] = bflo(w.x); f[1] = bfhi(w.x); f[2] = bflo(w.y); f[3] = bfhi(w.y); f[4] = bflo(w.z); f[5] = bfhi(w.z); f[6] = bflo(w.w); f[7] = bfhi(w.w);
#endif
}
struct PeerArgs { const bf16* H2; const int* IDX; const float* GATE; const unsigned char* PU; const unsigned char* PV; float* PART; float* A; float* Y; float* io; const float* g_post2; const float* mod; };
__device__ __forceinline__ void pk_issue8(const unsigned char* tab, const v4u ia, const v4u ib, v4u (&w)[8]) {
    w[0] = *(const GAS v4u*)(tab + (size_t)ia.x * ROWB); w[1] = *(const GAS v4u*)(tab + (size_t)ia.y * ROWB); w[2] = *(const GAS v4u*)(tab + (size_t)ia.z * ROWB); w[3] = *(const GAS v4u*)(tab + (size_t)ia.w * ROWB);
    w[4] = *(const GAS v4u*)(tab + (size_t)ib.x * ROWB); w[5] = *(const GAS v4u*)(tab + (size_t)ib.y * ROWB); w[6] = *(const GAS v4u*)(tab + (size_t)ib.z * ROWB); w[7] = *(const GAS v4u*)(tab + (size_t)ib.w * ROWB);
}
__device__ __forceinline__ void p9_half(const v4u (&w)[8], const v4u h0, const v4u h1, float* val  ) {
#if TBL_FP8
    const f32x2 hp[8] = {{bflo(h0.x), bfhi(h0.x)}, {bflo(h0.y), bfhi(h0.y)}, {bflo(h0.z), bfhi(h0.z)}, {bflo(h0.w), bfhi(h0.w)}, {bflo(h1.x), bfhi(h1.x)}, {bflo(h1.y), bfhi(h1.y)}, {bflo(h1.z), bfhi(h1.z)}, {bflo(h1.w), bfhi(h1.w)}};
#pragma unroll
    for (int i = 0; i < 8; ++i) { f32x2 f[8]; tbl_unpack2(w[i], f);
        f32x2 s0 = f[0] * hp[0], s1 = f[1] * hp[1];
        s0 = f[2] * hp[2] + s0; s1 = f[3] * hp[3] + s1; s0 = f[4] * hp[4] + s0; s1 = f[5] * hp[5] + s1; s0 = f[6] * hp[6] + s0; s1 = f[7] * hp[7] + s1;
        const f32x2 t = s0 + s1; val[i] = red8(t.x + t.y) * (1.f / U_SCALE); }
#else
    (void)h1;
#pragma unroll
    for (int i = 0; i < 8; ++i) val[i] = red8(dot8(w[i], h0, 0.f));
#endif
}
struct IdxSet { v4u i0, i1, i2, i3; };
__device__ __forceinline__ IdxSet ld_idx(const int* IDX, int tok, int g8) { const GAS v4u* ip = (const GAS v4u*)(IDX + (size_t)tok * 128 + 16 * g8); IdxSet r; r.i0 = ip[0]; r.i1 = ip[1]; r.i2 = ip[2]; r.i3 = ip[3]; return r; }
__device__ __forceinline__ void p9_store(float* part, int tok, int ps, int g8, int sub, const float (&val)[16]) {
    if (sub == 0) { GAS f32x4* pp = (GAS f32x4*)(part + (size_t)tok * 128 + 16 * g8);
#pragma unroll
        for (int q = 0; q < 4; ++q) { f32x4 v = {val[4 * q], val[4 * q + 1], val[4 * q + 2], val[4 * q + 3]}; if (ps > 0) v += pp[q]; pp[q] = v; } }
}
__device__ __forceinline__ void p9_udots(const Frame& F, const PeerArgs& a) {
    const int lane = F.lane, sub = lane & 7, g8 = lane >> 3, label = F.vcu >> 5, rank = F.vcu & 31;
    constexpr int TS = 32 * NWAVES, NT = M / TS;
#pragma unroll 1
    for (int ps = 0; ps < NSL / 8; ++ps) {
        const int s = label + 8 * ps;
        const unsigned char* tab = a.PU + (size_t)s * NEXP * ROWB + sub * 16;
        float* part = a.PART + (size_t)label * M * 128;
        const bf16* hbase = a.H2 + s * CW + sub * CPL;
        const int t0 = rank * NWAVES + F.wave;
        v4u wA0[8], wA1[8], wB0[8], wB1[8], hA0, hA1 = {0u, 0u, 0u, 0u}, hB0, hB1 = {0u, 0u, 0u, 0u};
        IdxSet ix = ld_idx(a.IDX, t0, g8), iy = ld_idx(a.IDX, t0 + TS, g8);
        pk_issue8(tab, ix.i0, ix.i1, wA0); pk_issue8(tab, ix.i2, ix.i3, wA1); { const bf16* hp = hbase + (size_t)t0 * D; hA0 = *(const GAS v4u*)hp; if (TBL_FP8) hA1 = *(const GAS v4u*)(hp + 8); }
        pk_issue8(tab, iy.i0, iy.i1, wB0); pk_issue8(tab, iy.i2, iy.i3, wB1); { const bf16* hp = hbase + (size_t)(t0 + TS) * D; hB0 = *(const GAS v4u*)hp; if (TBL_FP8) hB1 = *(const GAS v4u*)(hp + 8); }
        ix = ld_idx(a.IDX, t0 + 2 * TS, g8); iy = ld_idx(a.IDX, t0 + 3 * TS, g8);
#pragma unroll 1
        for (int k = 0; k < NT; k += 2) { const int tk = t0 + k * TS;
            const int t2 = (k + 2 < NT) ? tk + 2 * TS : tk, t3 = (k + 3 < NT) ? tk + 3 * TS : tk, t4 = (k + 4 < NT) ? tk + 4 * TS : tk, t5 = (k + 5 < NT) ? tk + 5 * TS : tk;
            float val[16];
            p9_half(wA0, hA0, hA1, val); p9_half(wA1, hA0, hA1, val + 8); SBAR();
            pk_issue8(tab, ix.i0, ix.i1, wA0); pk_issue8(tab, ix.i2, ix.i3, wA1); { const bf16* hp = hbase + (size_t)t2 * D; hA0 = *(const GAS v4u*)hp; if (TBL_FP8) hA1 = *(const GAS v4u*)(hp + 8); }
            ix = ld_idx(a.IDX, t4, g8); SBAR();
            p9_store(part, tk, ps, g8, sub, val); SBAR();
            p9_half(wB0, hB0, hB1, val); p9_half(wB1, hB0, hB1, val + 8); SBAR();
            pk_issue8(tab, iy.i0, iy.i1, wB0); pk_issue8(tab, iy.i2, iy.i3, wB1); { const bf16* hp = hbase + (size_t)t3 * D; hB0 = *(const GAS v4u*)hp; if (TBL_FP8) hB1 = *(const GAS v4u*)(hp + 8); }
            iy = ld_idx(a.IDX, t5, g8); SBAR();
            p9_store(part, tk + TS, ps, g8, sub, val); SBAR();
        }
    }
}
__device__ __forceinline__ void p10_acomb(const Frame& F, const PeerArgs& a) {
    const long gt = (long)(F.vcu * NWAVES + F.wave) * 64 + F.lane, NT = (long)F.G * NWAVES * 64, n4 = (long)M * 128 / 4;
    for (long i = gt; i < n4; i += NT) { f32x4 s = *(const GAS f32x4*)(a.PART + i * 4);
#pragma unroll
        for (int j = 1; j < 8; ++j) s += *(const GAS f32x4*)(a.PART + (size_t)j * M * 128 + i * 4);
        const f32x4 g = *(const GAS f32x4*)(a.GATE + i * 4);
        *(GAS f32x4*)(a.A + i * 4) = (f32x4){gelu_tanh(s[0]) * g[0], gelu_tanh(s[1]) * g[1], gelu_tanh(s[2]) * g[2], gelu_tanh(s[3]) * g[3]}; }
}
__device__ __forceinline__ void p11_half(const v4u (&w)[8], const f32x4 aa, const f32x4 ab, float (&acc)[CPL]) {
#pragma unroll
    for (int i = 0; i < 8; ++i) { const float ai = i == 0 ? aa.x : i == 1 ? aa.y : i == 2 ? aa.z : i == 3 ? aa.w : i == 4 ? ab.x : i == 5 ? ab.y : i == 6 ? ab.z : ab.w;
#if TBL_FP8
        f32x2 f[8]; tbl_unpack2(w[i], f); const f32x2 a2 = {ai, ai};
#pragma unroll
        for (int c = 0; c < 8; ++c) { f32x2 t = {acc[2 * c], acc[2 * c + 1]}; t = f[c] * a2 + t; acc[2 * c] = t.x; acc[2 * c + 1] = t.y; }
#else
        float f[CPL]; tbl_unpack(w[i], f);
#pragma unroll
        for (int c = 0; c < CPL; ++c) acc[c] += ai * f[c];
#endif
    }
}
struct AvSet { f32x4 a0, a1, a2, a3; };
__device__ __forceinline__ AvSet ld_av(const float* Ain, int tok, int g8) { const GAS f32x4* ap = (const GAS f32x4*)(Ain + (size_t)tok * 128 + 16 * g8); AvSet r; r.a0 = ap[0]; r.a1 = ap[1]; r.a2 = ap[2]; r.a3 = ap[3]; return r; }
__device__ __forceinline__ void p11_finish(const PeerArgs& a, int tok, int s, int g8, int sub, float (&acc)[CPL]) {
#pragma unroll
    for (int c = 0; c < CPL; ++c) acc[c] = red_groups(acc[c]) * (1.f / V_SCALE);
    if (g8 == 0) { GAS f32x4* yp = (GAS f32x4*)(a.Y + (size_t)tok * D + s * CW + sub * CPL);
#pragma unroll
        for (int q = 0; q < CPL / 4; ++q) yp[q] = (f32x4){acc[4 * q], acc[4 * q + 1], acc[4 * q + 2], acc[4 * q + 3]}; }
}
__device__ __forceinline__ void p11_vaxpy(const Frame& F, const PeerArgs& a) {
    const int lane = F.lane, sub = lane & 7, g8 = lane >> 3, label = F.vcu >> 5, rank = F.vcu & 31;
    constexpr int TS = 32 * NWAVES, NT = M / TS;
#pragma unroll 1
    for (int ps = 0; ps < NSL / 8; ++ps) {
        const int s = label + 8 * ps;
        const unsigned char* tab = a.PV + (size_t)s * NEXP * ROWB + sub * 16;
        const int t0 = rank * NWAVES + F.wave;
        v4u wA0[8], wA1[8], wB0[8], wB1[8];
        IdxSet ix = ld_idx(a.IDX, t0, g8), iy = ld_idx(a.IDX, t0 + TS, g8);
        AvSet avA = ld_av(a.A, t0, g8), avB = ld_av(a.A, t0 + TS, g8);
        pk_issue8(tab, ix.i0, ix.i1, wA0); pk_issue8(tab, ix.i2, ix.i3, wA1);
        pk_issue8(tab, iy.i0, iy.i1, wB0); pk_issue8(tab, iy.i2, iy.i3, wB1);
        ix = ld_idx(a.IDX, t0 + 2 * TS, g8); iy = ld_idx(a.IDX, t0 + 3 * TS, g8);
#pragma unroll 1
        for (int k = 0; k < NT; k += 2) { const int tk = t0 + k * TS;
            const int t2 = (k + 2 < NT) ? tk + 2 * TS : tk, t3 = (k + 3 < NT) ? tk + 3 * TS : tk, t4 = (k + 4 < NT) ? tk + 4 * TS : tk, t5 = (k + 5 < NT) ? tk + 5 * TS : tk;
            float acc[CPL];
#pragma unroll
            for (int c = 0; c < CPL; ++c) acc[c] = 0.f;
            p11_half(wA0, avA.a0, avA.a1, acc); p11_half(wA1, avA.a2, avA.a3, acc); SBAR();
            pk_issue8(tab, ix.i0, ix.i1, wA0); pk_issue8(tab, ix.i2, ix.i3, wA1); avA = ld_av(a.A, t2, g8); ix = ld_idx(a.IDX, t4, g8); SBAR();
            p11_finish(a, tk, s, g8, sub, acc); SBAR();
#pragma unroll
            for (int c = 0; c < CPL; ++c) acc[c] = 0.f;
            p11_half(wB0, avB.a0, avB.a1, acc); p11_half(wB1, avB.a2, avB.a3, acc); SBAR();
            pk_issue8(tab, iy.i0, iy.i1, wB0); pk_issue8(tab, iy.i2, iy.i3, wB1); avB = ld_av(a.A, t3, g8); iy = ld_idx(a.IDX, t5, g8); SBAR();
            p11_finish(a, tk + TS, s, g8, sub, acc); SBAR();
        }
    }
}
__device__ __forceinline__ void p12_final(const Frame& F, const PeerArgs& a) {
    const int gw = F.vcu * NWAVES + F.wave, NGW = F.G * NWAVES;
    for (int m = gw; m < M; m += NGW) { const int b = m >> 12; const float* gt2 = a.mod + b * NMOD + 5 * D;
        const GAS f32x4* yr = (const GAS f32x4*)(a.Y + (size_t)m * D) + F.lane; GAS f32x4* orow = (GAS f32x4*)(a.io + (size_t)m * D) + F.lane;
        f32x4 v[4]; float ss = 0.f;
#pragma unroll
        for (int j = 0; j < 4; ++j) { v[j] = yr[64 * j]; ss += (v[j].x * v[j].x + v[j].y * v[j].y) + (v[j].z * v[j].z + v[j].w * v[j].w); }
        const float rs = 1.f / sqrtf(wave_sum(ss) * (1.f / D) + EPS);
#pragma unroll
        for (int j = 0; j < 4; ++j) { const int col = 256 * j + 4 * F.lane; const f32x4 g = *(const f32x4*)(a.g_post2 + col), gt = *(const f32x4*)(gt2 + col);
            orow[64 * j] = orow[64 * j] + gt * (v[j] * rs * g); }
    }
}


#ifndef DBG_STOP
#define DBG_STOP 99
#endif
__device__ __forceinline__ void dbg_dump(const Frame& F, float* out, const bf16* b0, const bf16* b1, const bf16* b2, const bf16* b3, const bf16* b4) {
    const int gw = F.vcu * NWAVES + F.wave, NGW = F.G * NWAVES;
    for (int m = gw; m < M; m += NGW) {
#pragma unroll
        for (int j = 0; j < 4; ++j) { const size_t off = (size_t)m * D + 256 * j + 4 * F.lane; f32x4 s = {0.f, 0.f, 0.f, 0.f};
            const bf16* bs[5] = {b0, b1, b2, b3, b4};
#pragma unroll
            for (int k = 0; k < 5; ++k) if (bs[k]) { const v2u w = *(const GAS v2u*)(bs[k] + off); s += (f32x4){bflo(w.x), bfhi(w.x), bflo(w.y), bfhi(w.y)}; }
            *(GAS f32x4*)(out + off) = s; }
    }
}
struct Args { const void* in[26]; float* out; unsigned char* ws; int ph_lo, ph_hi; };
__global__ void __launch_bounds__(NWAVES * 64, 2) mk_fwd(Args args) {
    extern __shared__ __attribute__((aligned(16))) unsigned char lds[];
    Frame F;
    F.lds = (LAS unsigned char*)lds;
    F.tid = threadIdx.x; F.lane = F.tid & 63; F.wave = __builtin_amdgcn_readfirstlane(F.tid >> 6);
    F.G = gridDim.x; { const int bx = blockIdx.x; F.vcu = (F.G % 8 == 0) ? (bx % 8) * (F.G / 8) + bx / 8 : bx; }
    unsigned char* ws = args.ws;
    gu32* ctl = (gu32*)(ws + WS_CTL);
    volatile LAS unsigned* MISC = (volatile LAS unsigned*)(F.lds + MISC_OFF);
    for (int u = F.tid; u < (LDS_BYTES - LDSCTL_OFF) / 4; u += NWAVES * 64) ((LAS unsigned*)(F.lds + LDSCTL_OFF))[u] = 0u;
    __syncthreads();
    XcdBarrier bar; bar.bar = (unsigned*)(ctl + CW_BAR); bar.x = 0; bar.st = nullptr;
    if (N_LAUNCHES == 1) bar = xcd_barrier_post((unsigned*)(ctl + CW_BAR), MISC + 8);
#define GRID_BAR() do { if (N_LAUNCHES == 1) xcd_barrier(bar); } while (0)
    const int lo = args.ph_lo, hi = args.ph_hi;
#ifndef PH_MASK
#define PH_MASK 0x1FFF
#endif
#define IN(k) ((((PH_MASK) >> (k)) & 1) && (k) <= DBG_STOP && lo <= (k) && (k) < hi)
#define BOTH(k) (IN(k) && IN((k) + 1))
#ifndef REP_MASK
#define REP_MASK 0
#endif
#define NREP(k) ((((REP_MASK) >> (k)) & 1) ? 2 : 1)
    const float* x = (const float*)args.in[0]; const float* mod = (const float*)(ws + WS_MOD);
    float* out = args.out;
    bf16* GA = (bf16*)out; bf16* GG = (bf16*)out + (size_t)M * D;

    if (IN(0)) {
        P0Args a{(const float*)args.in[1], (const float*)args.in[3], (const float*)args.in[4], (const float*)args.in[7], (const float*)args.in[13], (const float*)args.in[18], (const float*)args.in[19],
                 (const float*)args.in[22], (const float*)args.in[23], (const float*)args.in[16], (const int*)args.in[2], ws};
        for (int rep = 0; rep < NREP(0); ++rep) p0_prologue(F, a); if (BOTH(0)) GRID_BAR();
    }
    if (IN(1)) { for (int rep = 0; rep < NREP(1); ++rep) p1_xn(F, x, (const float*)args.in[5], mod, (bf16*)(ws + WS_XN)); if (BOTH(1)) GRID_BAR(); }
    if (IN(2)) {
        pg8::Gemm g{(const bf16*)(ws + WS_XN), nullptr, (const bf16*)(ws + WS_WIN), nullptr, M, NIN, D}; pg8::StaticOrder S; S.init(M, NIN, F.G, (int)blockIdx.x);
        pg8::EpiInProj E{(bf16*)(ws + WS_Q), (bf16*)(ws + WS_K), (bf16*)(ws + WS_V), (bf16*)(ws + WS_U), (bf16*)(ws + WS_ZV), GA, GG, (const float*)(ws + WS_ROPE), (float*)(ws + WS_STATS)};
        for (int rep = 0; rep < NREP(2); ++rep) pg8::gemm_phase<pg8::EpiInProj, pg8::StaticOrder, true, true>(F.lds, g, S, E);
        if (BOTH(2)) GRID_BAR();
    }
    if (IN(3)) {
        GmlpArgs ga{(const bf16*)(ws + WS_ZV), (bf16*)(ws + WS_U), (const float*)(ws + WS_STATS), (const float*)args.in[14], (const float*)args.in[15], (const bf16*)(ws + WS_WSP), (const float*)args.in[17]};
#ifndef NO_GMLP
        p3_gmlp(F, ga);
#endif
        float lam;
        { const float* lq1 = (const float*)args.in[8]; const float* lk1 = (const float*)args.in[9]; const float* lq2 = (const float*)args.in[10]; const float* lk2 = (const float*)args.in[11];
          float s1 = 0.f, s2 = 0.f; for (int i = 0; i < 64; ++i) { s1 += lq1[i] * lk1[i]; s2 += lq2[i] * lk2[i]; }
          lam = __expf(s1) - __expf(s2) + 0.2f; }
        const bf16* Qb = (const bf16*)(ws + WS_Q); const bf16* Kb = (const bf16*)(ws + WS_K); const bf16* Vb = (const bf16*)(ws + WS_V);
        float* stash = (float*)(ws + WS_O0) + (size_t)blockIdx.x * 32768;
#ifndef NO_ATT
        for (int rep = 0; rep < NREP(3); ++rep)
        for (int uu = F.vcu; uu < 1024; uu += F.G) {
            const int bh = uu >> 4, qb = uu & 15, b = bh >> 3, h = bh & 7; const size_t ro = (size_t)b * SEQ * D + h * 128;
            att::attn_unit(Qb + ro, Kb + ro, Vb + ro, (rep + 1 < NREP(3) ? (bf16*)(ws + 424 * MiB) : (bf16*)(ws + WS_Q)) + ro, qb * 256, lam, (const float*)args.in[12], stash, (char*)lds); }
#endif
        if (BOTH(3)) GRID_BAR();
    }
    if (IN(4)) {
        pg8::Gemm g{(const bf16*)(ws + WS_Q), (const bf16*)(ws + WS_U), (const bf16*)(ws + WS_WA), (const bf16*)(ws + WS_WG), M, D, D}; pg8::StaticOrder S; S.init(M, D, F.G, (int)blockIdx.x, 2);
        pg8::EpiMerge E{GA, GG, (float*)(ws + WS_T1), (bf16*)(ws + WS_MIXIN)};
        for (int rep = 0; rep < NREP(4); ++rep) pg8::gemm_phase<pg8::EpiMerge, pg8::StaticOrder, true, true>(F.lds, g, S, E);
        if (BOTH(4)) GRID_BAR();
    }
    if (IN(5)) {
        pg8::Gemm g{(const bf16*)(ws + WS_MIXIN), nullptr, (const bf16*)(ws + WS_WOUT), nullptr, M, D, D}; pg8::StaticOrder S; S.init(M, D, F.G, (int)blockIdx.x);
        pg8::EpiF32 E{out, D};
        for (int rep = 0; rep < NREP(5); ++rep) pg8::gemm_phase<pg8::EpiF32, pg8::StaticOrder, true, true>(F.lds, g, S, E);
        if (BOTH(5)) GRID_BAR();
    }
    if (IN(6)) {
        p6_rows(F, x, out, (const float*)args.in[6], (const float*)args.in[20], mod, (bf16*)(ws + WS_H2));
        cvt_table(F, (const float*)args.in[24], ws + WS_PU, U_SCALE);
        cvt_table(F, (const float*)args.in[25], ws + WS_PV, V_SCALE);
        if (BOTH(6)) GRID_BAR();
    }
    if (IN(7)) {
        pg8::Gemm g{(const bf16*)(ws + WS_H2), nullptr, (const bf16*)(ws + WS_WPQ), nullptr, M, NPQ, D}; pg8::StaticOrder S; S.init(M, NPQ, F.G, (int)blockIdx.x);
        pg8::EpiBf16<0> E{(bf16*)(ws + WS_QP), NPQ, nullptr, 0, 0, 1.f};
        for (int rep = 0; rep < NREP(7); ++rep) pg8::gemm_phase<pg8::EpiBf16<0>, pg8::StaticOrder, true, true>(F.lds, g, S, E);
        if (BOTH(7)) GRID_BAR();
    }
    if (IN(8)) { RouteArgs ra{(const bf16*)(ws + WS_QP), (const bf16*)(ws + WS_KEYS), (int*)(ws + WS_IDX), (float*)(ws + WS_GATE)}; for (int rep = 0; rep < NREP(8); ++rep) p8_route(F, ra); if (BOTH(8)) GRID_BAR(); }
    PeerArgs pa{(const bf16*)(ws + WS_H2), (const int*)(ws + WS_IDX), (const float*)(ws + WS_GATE), ws + WS_PU, ws + WS_PV, (float*)(ws + WS_PART), (float*)(ws + WS_A), (float*)(ws + WS_Y), out, (const float*)args.in[21], mod};
    if (IN(9)) { for (int rep = 0; rep < NREP(9); ++rep) p9_udots(F, pa); if (BOTH(9)) GRID_BAR(); }
    if (IN(10)) { for (int rep = 0; rep < NREP(10); ++rep) p10_acomb(F, pa); if (BOTH(10)) GRID_BAR(); }
    if (IN(11)) { for (int rep = 0; rep < NREP(11); ++rep) p11_vaxpy(F, pa); if (BOTH(11)) GRID_BAR(); }
    if (IN(12)) { p12_final(F, pa); }
    if (DBG_STOP < 9 && lo <= DBG_STOP && DBG_STOP < hi) {
        if (N_LAUNCHES == 1) GRID_BAR();
        if (N_LAUNCHES != 1) {   }
    }
    if (DBG_STOP < 9 && ((N_LAUNCHES == 1 && hi > DBG_STOP) || (N_LAUNCHES != 1 && lo == DBG_STOP + 1))) {
        if (DBG_STOP == 2) dbg_dump(F, out, GA, nullptr, nullptr, nullptr, nullptr);
        if (DBG_STOP == 3) dbg_dump(F, out, (const bf16*)(ws + WS_Q), (const bf16*)(ws + WS_U), nullptr, nullptr, nullptr);
        if (DBG_STOP == 4) dbg_dump(F, out, (const bf16*)(ws + WS_MIXIN), nullptr, nullptr, nullptr, nullptr);

        if (DBG_STOP == 7) dbg_dump(F, out, (const bf16*)(ws + WS_QP), (const bf16*)(ws + WS_QP) + (size_t)M * D, nullptr, nullptr, nullptr);
        if (DBG_STOP == 8) dbg_dump(F, out, (const bf16*)(ws + WS_IDX), (const bf16*)(ws + WS_GATE), nullptr, nullptr, nullptr);
    }
#undef IN
#undef BOTH
}

extern "C" void kernel_launch(void* const* d_in, const int* in_sizes, int n_in, void* d_out, int out_size, void* d_ws, size_t ws_size, hipStream_t stream) {
    static int grid = 0;
    if (grid == 0) {
        if (n_in != 26 || in_sizes[0] != M * D || out_size != M * D || ws_size < WS_END) { fprintf(stderr, "kernel_launch: shape/workspace mismatch (n_in %d, in0 %d, out %d, ws %zu, need %zu)\n", n_in, n_in > 0 ? in_sizes[0] : -1, out_size, ws_size, (size_t)WS_END); grid = -1; return; }
        int dev = 0, cus = 0, per_cu = 0;
        if (hipGetDevice(&dev) != hipSuccess || hipDeviceGetAttribute(&cus, hipDeviceAttributeMultiprocessorCount, dev) != hipSuccess) { grid = -1; return; }
        if (hipFuncSetAttribute((const void*)mk_fwd, hipFuncAttributeMaxDynamicSharedMemorySize, LDS_BYTES) != hipSuccess) { fprintf(stderr, "kernel_launch: hipFuncSetAttribute failed\n"); grid = -1; return; }
        if (hipOccupancyMaxActiveBlocksPerMultiprocessor(&per_cu, (const void*)mk_fwd, NWAVES * 64, LDS_BYTES) != hipSuccess || per_cu < 1) { fprintf(stderr, "kernel_launch: occupancy query says %d\n", per_cu); per_cu = 1; }
        (void)hipGetLastError();
        grid = cus;
        if (grid % 8 != 0 || grid > 256) fprintf(stderr, "kernel_launch: note: grid %d\n", grid);
    }
    if (grid < 0) return;
    if (hipMemsetAsync((char*)d_ws + WS_CTL, 0, CTL_ZERO_BYTES, stream) != hipSuccess) { fprintf(stderr, "kernel_launch: memset failed\n"); return; }
    Args a{};
    for (int i = 0; i < 26; ++i) a.in[i] = d_in[i];
    a.out = (float*)d_out; a.ws = (unsigned char*)d_ws;
    for (int li = 0; li < N_LAUNCHES; ++li) {
        a.ph_lo = (N_LAUNCHES == 1) ? 0 : li; a.ph_hi = (N_LAUNCHES == 1) ? NPHASE : li + 1;
        hipLaunchKernelGGL(mk_fwd, dim3(grid), dim3(NWAVES * 64), LDS_BYTES, stream, a);
        const hipError_t le = hipPeekAtLastError();
        if (le != hipSuccess) { fprintf(stderr, "kernel_launch: launch %d failed: %s\n", li, hipGetErrorName(le)); break; }
    }
}
```

```cpp
#include <hip/hip_runtime.h>
#include <cstdio>
#include <cstdint>
namespace pg8 {
#define PG8_LAS __attribute__((address_space(3)))
typedef unsigned short bf16_t;
typedef short bf16x8 __attribute__((ext_vector_type(8)));
typedef float f32x4 __attribute__((ext_vector_type(4)));
typedef unsigned u32x4 __attribute__((ext_vector_type(4)));
constexpr int BM = 256, BK = 64, HALF = 128, HTB = HALF * BK * 2  , STAGE_BYTES = 8 * HTB, NXCD = 8, WGM = 8;

__host__ __device__ __forceinline__ int lds_byte(int r, int c) { const int st = (r >> 4) * 2 + (c >> 5), rr = r & 15, cc = c & 31, ob = rr * 64 + cc * 2; return st * 1024 + (ob ^ (((ob >> 9) & 1) << 5)); }
__host__ __device__ __forceinline__ void stage_rc(int b, int& R, int& C) { const int st = b / 1024, sb = b % 1024, swz = sb ^ (((sb >> 9) & 1) << 5); R = (st >> 1) * 16 + swz / 64; C = (st & 1) * 32 + (swz % 64) / 2; }
__host__ __device__ __forceinline__ int perm32(int rho) { const int n = rho >> 4, i = rho & 15; return 8 * (i >> 2) + 4 * n + (i & 3); }

struct Unit { int pm, pn, w; };
struct Gemm { const bf16_t* A0; const bf16_t* A1; const bf16_t* B0; const bf16_t* B1; int M, N, K; };

struct StaticOrder {
    int nM, nN, nwg, G, c, passes;
    __host__ __device__ void init(int M, int N, int G_, int c_, int passes_ = 1) { nM = M / BM; nN = N / BM; nwg = nM * nN; G = G_; c = c_; passes = passes_; }
    __host__ __device__ bool next(int i, Unit& u) const {
        const int ti = (passes == 2) ? (i >> 1) : i; u.w = (passes == 2) ? (i & 1) : 0;
        const long L = (long)ti * G + c; if (L >= nwg) return false;
        int wgid = (int)L; { const int q = nwg / NXCD, r = nwg % NXCD, xcd = wgid % NXCD, off = wgid / NXCD; wgid = (xcd < r ? xcd * (q + 1) : r * (q + 1) + (xcd - r) * q) + off; }
        const int nig = WGM * nN, gid = wgid / nig, fm = gid * WGM, gsz = (nM - fm) < WGM ? (nM - fm) : WGM;
        u.pm = fm + ((wgid % nig) % gsz); u.pn = (wgid % nig) / gsz; return true;
    }
    __device__ __forceinline__ void a_ready(const Unit&) const {}
    __device__ __forceinline__ void done(const Unit&) const {}
};

typedef float f32x2c __attribute__((ext_vector_type(2))); typedef __bf16 bf16x2c __attribute__((ext_vector_type(2)));
__device__ __forceinline__ unsigned cvt_pk_bf16(float lo, float hi) { f32x2c v = {lo, hi}; bf16x2c b = __builtin_convertvector(v, bf16x2c); return __builtin_bit_cast(unsigned, b); }
typedef float f32x2 __attribute__((ext_vector_type(2)));
__device__ __forceinline__ f32x2 gelu_pk(f32x2 v) {
    const f32x2 av = __builtin_elementwise_abs(v), d = av * 0.2316418882f + 1.0f;
    f32x2 t; t.x = __builtin_amdgcn_rcpf(d.x); t.y = __builtin_amdgcn_rcpf(d.y);
    f32x2 q = t * 0.5307027145f + (-0.7265760135f); q = q * t + 0.7107068705f; q = q * t + (-0.142248368f); q = q * t + 0.127414796f; q = q * t;
    const f32x2 s = (v * v) * (-0.72134752044f);
    f32x2 e; e.x = __builtin_amdgcn_exp2f(s.x); e.y = __builtin_amdgcn_exp2f(s.y);
    const f32x2 m = v * (q * e), r = v - m;
    f32x2 o; o.x = v.x < 0.f ? m.x : r.x; o.y = v.y < 0.f ? m.y : r.y; return o;
}

template <int ACT  > struct EpiBf16 {
    static constexpr bool PERM = true, AFTER_DRAIN = false; static_assert(ACT == 0 || ACT == 1, "EpiBf16: ACT is 0 (none) or 1 (gelu_pk)");
    bf16_t* O; int ldc; const float* bias; int split_cols; size_t split_stride; float scale0;
    __device__ __forceinline__ void operator()(const f32x4 (&acc)[2][2][4][2], const Unit& u, int wr, int wc, int fr, int fq) const {
        const int row0 = u.pm * BM + wr * 64 + fr; int colt = u.pn * BM; bf16_t* base = O;
        float sc = 1.f; if (split_cols) { const int t = colt / split_cols; base += (size_t)t * split_stride; colt -= t * split_cols; if (t == 0) sc = scale0; }
        const int col0 = colt + wc * 32 + 8 * fq, bcol0 = u.pn * BM + wc * 32 + 8 * fq;
        f32x4 bv[2][2];
#pragma unroll
        for (int bj = 0; bj < 2; ++bj)
#pragma unroll
            for (int n = 0; n < 2; ++n) bv[bj][n] = bias ? *(const f32x4*)(bias + bcol0 + bj * HALF + 4 * n) : (f32x4){0.f, 0.f, 0.f, 0.f};
#pragma unroll
        for (int ai = 0; ai < 2; ++ai)
#pragma unroll
            for (int m = 0; m < 4; ++m) { bf16_t* rowp = base + (size_t)(row0 + ai * HALF + m * 16) * ldc + col0;
#pragma unroll
                for (int bj = 0; bj < 2; ++bj) { f32x4 v0 = acc[ai][bj][m][0] + bv[bj][0], v1 = acc[ai][bj][m][1] + bv[bj][1];
                    if (ACT == 1) { f32x2 a = gelu_pk((f32x2){v0[0], v0[1]}), b = gelu_pk((f32x2){v0[2], v0[3]}), c = gelu_pk((f32x2){v1[0], v1[1]}), d = gelu_pk((f32x2){v1[2], v1[3]});
                        v0 = (f32x4){a.x, a.y, b.x, b.y}; v1 = (f32x4){c.x, c.y, d.x, d.y}; }
                    v0 = v0 * sc; v1 = v1 * sc; u32x4 w; w.x = cvt_pk_bf16(v0[0], v0[1]); w.y = cvt_pk_bf16(v0[2], v0[3]); w.z = cvt_pk_bf16(v1[0], v1[1]); w.w = cvt_pk_bf16(v1[2], v1[3]);
                    *(u32x4*)(rowp + bj * HALF) = w; } }
    }
};

template <class Epi, class Sched, bool ALIGN_EPI = false, bool SP2 = false>
__device__ __forceinline__ void gemm_phase(PG8_LAS unsigned char* lds, const Gemm g, const Sched& S, const Epi& E) {
    const int tid = threadIdx.x, wid = __builtin_amdgcn_readfirstlane(tid >> 6), lane = tid & 63, wr = wid >> 2, wc = wid & 3, fr = lane & 15, fq = lane >> 4;
    const int K = g.K, nt = K / BK;
    unsigned voffA[2], voffB[2];
#pragma unroll
    for (int i = 0; i < 2; ++i) { int R, C; stage_rc(tid * 16 + i * 8192, R, C); const int Rb = Epi::PERM ? ((R & ~31) + perm32(R & 31)) : R;
        voffA[i] = (unsigned)(R * K + C) * 2u; voffB[i] = (unsigned)(Rb * K + C) * 2u; }
    const size_t kstep = (size_t)(BK * 2);
    const size_t hstep = (size_t)HALF * K * 2;
    const size_t tstep = 2 * hstep;
    const unsigned ldsw = (unsigned)wid * 1024u;
    const int aoff = lds_byte(wr * 64 + fr, fq * 8), boff = lds_byte(wc * 32 + fr, fq * 8);
#define PG8_SA(b, h) (((b) * 2 + (h)) * HTB)
#define PG8_SB(b, h) ((4 + (b) * 2 + (h)) * HTB)
#define PG8_STAGE(bufoff, gbase, voff) do { _Pragma("unroll") for (int _i = 0; _i < 2; ++_i) \
        __builtin_amdgcn_global_load_lds((const unsigned*)((const char*)(gbase) + (voff)[_i]), (PG8_LAS unsigned*)(lds + (bufoff) + ldsw + _i * 8192), 16, 0, 0); } while (0)
#define PG8_LDA(dst, b, h) do { _Pragma("unroll") for (int m = 0; m < 4; ++m) _Pragma("unroll") for (int k = 0; k < 2; ++k) dst[m][k] = *(const PG8_LAS bf16x8*)(lds + PG8_SA(b, h) + aoff + m * 2048 + k * 1024); } while (0)
#define PG8_LDB(dst, b, h) do { _Pragma("unroll") for (int n = 0; n < 2; ++n) _Pragma("unroll") for (int k = 0; k < 2; ++k) dst[n][k] = *(const PG8_LAS bf16x8*)(lds + PG8_SB(b, h) + boff + n * 2048 + k * 1024); } while (0)
#define PG8_MMA(ai, bj, At, Bt) do { __builtin_amdgcn_s_setprio(1); _Pragma("unroll") for (int m = 0; m < 4; ++m) _Pragma("unroll") for (int n = 0; n < 2; ++n) _Pragma("unroll") for (int k = 0; k < 2; ++k) \
        acc[ai][bj][m][n] = __builtin_amdgcn_mfma_f32_16x16x32_bf16(Bt[n][k], At[m][k], acc[ai][bj][m][n], 0, 0, 0); __builtin_amdgcn_s_setprio(0); } while (0)
#define PG8_WAIT_V(n) asm volatile("s_waitcnt vmcnt(" #n ")" ::: "memory")
#define PG8_WAIT_L(n) asm volatile("s_waitcnt lgkmcnt(" #n ")" ::: "memory")
#define PG8_BAR __builtin_amdgcn_s_barrier()
#define PG8_SCHED __builtin_amdgcn_sched_barrier(0)
    Unit cur, nxt; int ui = 0;
    if (!S.next(0, cur)) return;
    f32x4 acc[2][2][4][2];
#pragma unroll
    for (int a = 0; a < 2; ++a)
#pragma unroll
        for (int b = 0; b < 2; ++b)
#pragma unroll
            for (int m = 0; m < 4; ++m)
#pragma unroll
                for (int n = 0; n < 2; ++n) acc[a][b][m][n] = (f32x4){0.f, 0.f, 0.f, 0.f};
    bf16x8 At[4][2], B0[2][2], B1[2][2];
    const char* cA = (const char*)(cur.w ? g.A1 : g.A0) + (size_t)cur.pm * tstep; const char* cB = (const char*)(cur.w ? g.B1 : g.B0) + (size_t)cur.pn * tstep;
    S.a_ready(cur);
    if constexpr (SP2) {
        PG8_STAGE(PG8_SB(0, 0), cB, voffB); PG8_STAGE(PG8_SB(0, 1), cB + hstep, voffB); PG8_STAGE(PG8_SA(0, 0), cA, voffA); PG8_STAGE(PG8_SA(0, 1), cA + hstep, voffA);
        if (wr == 1) PG8_BAR;
        PG8_WAIT_V(2); PG8_BAR;
        PG8_STAGE(PG8_SB(1, 0), cB + kstep, voffB); PG8_STAGE(PG8_SA(1, 0), cA + kstep, voffA); PG8_STAGE(PG8_SB(1, 1), cB + hstep + kstep, voffB);
        PG8_WAIT_V(6); PG8_BAR;
    } else {
        PG8_STAGE(PG8_SB(0, 0), cB, voffB); PG8_STAGE(PG8_SA(0, 0), cA, voffA); PG8_STAGE(PG8_SB(0, 1), cB + hstep, voffB); PG8_STAGE(PG8_SA(0, 1), cA + hstep, voffA);
        if (wr == 1) PG8_BAR;
        PG8_WAIT_V(4); PG8_BAR;
        PG8_STAGE(PG8_SB(1, 0), cB + kstep, voffB); PG8_STAGE(PG8_SA(1, 0), cA + kstep, voffA); PG8_STAGE(PG8_SB(1, 1), cB + hstep + kstep, voffB);
        PG8_WAIT_V(6); PG8_BAR;
    }
    for (;;) {
        const bool has_next = S.next(ui + 1, nxt);
        const char* nA = has_next ? (const char*)(nxt.w ? g.A1 : g.A0) + (size_t)nxt.pm * tstep : cA; const char* nB = has_next ? (const char*)(nxt.w ? g.B1 : g.B0) + (size_t)nxt.pn * tstep : cB;
        for (int t = 0; t < nt; t += 2) {
            const bool last = (t == nt - 2);
            const char* a1 = cA + (size_t)(t + 1) * kstep;
            const char* a2 = last ? nA : cA + (size_t)(t + 2) * kstep; const char* b2 = last ? nB : cB + (size_t)(t + 2) * kstep;
            const char* a3 = a2 + kstep; const char* b3 = b2 + kstep;
            if (last && has_next) S.a_ready(nxt);
            if constexpr (SP2) {
            PG8_LDB(B0, 0, 0); PG8_LDB(B1, 0, 1); PG8_SCHED; PG8_LDA(At, 0, 0); PG8_STAGE(PG8_SA(1, 1), a1 + hstep, voffA);
            PG8_WAIT_V(8); PG8_WAIT_L(0); PG8_BAR; PG8_MMA(0, 0, At, B0); PG8_MMA(0, 1, At, B1); PG8_BAR; PG8_SCHED;
            PG8_LDA(At, 0, 1); PG8_STAGE(PG8_SB(0, 0), b2, voffB); PG8_STAGE(PG8_SB(0, 1), b2 + hstep, voffB); PG8_STAGE(PG8_SA(0, 0), a2, voffA);
            PG8_WAIT_V(8); PG8_WAIT_L(0); PG8_BAR; PG8_MMA(1, 0, At, B0); PG8_MMA(1, 1, At, B1); PG8_BAR; PG8_SCHED;
            PG8_LDB(B0, 1, 0); PG8_LDB(B1, 1, 1); PG8_SCHED; PG8_LDA(At, 1, 0); PG8_STAGE(PG8_SA(0, 1), a2 + hstep, voffA);
            PG8_WAIT_V(8); PG8_WAIT_L(0); PG8_BAR; PG8_MMA(0, 0, At, B0); PG8_MMA(0, 1, At, B1); PG8_BAR; PG8_SCHED;
            PG8_LDA(At, 1, 1); PG8_STAGE(PG8_SB(1, 0), b3, voffB); PG8_STAGE(PG8_SB(1, 1), b3 + hstep, voffB); PG8_STAGE(PG8_SA(1, 0), a3, voffA);
            PG8_WAIT_V(8); PG8_WAIT_L(0); PG8_BAR; PG8_MMA(1, 0, At, B0); PG8_MMA(1, 1, At, B1); PG8_BAR; PG8_SCHED;
            } else {
            PG8_LDB(B0, 0, 0); PG8_SCHED; PG8_LDA(At, 0, 0); PG8_STAGE(PG8_SA(1, 1), a1 + hstep, voffA);
            PG8_WAIT_L(8); PG8_BAR; PG8_WAIT_L(0); PG8_MMA(0, 0, At, B0); PG8_BAR; PG8_SCHED;
            PG8_LDB(B1, 0, 1); PG8_STAGE(PG8_SB(0, 0), b2, voffB);
            PG8_BAR; PG8_WAIT_L(0); PG8_MMA(0, 1, At, B1); PG8_BAR;
            PG8_LDA(At, 0, 1); PG8_STAGE(PG8_SA(0, 0), a2, voffA);
            PG8_BAR; PG8_WAIT_L(0); PG8_MMA(1, 0, At, B0); PG8_BAR; PG8_SCHED;
            PG8_STAGE(PG8_SB(0, 1), b2 + hstep, voffB);
            PG8_WAIT_V(6); PG8_BAR; PG8_MMA(1, 1, At, B1); PG8_BAR;
            PG8_LDB(B0, 1, 0); PG8_SCHED; PG8_LDA(At, 1, 0); PG8_STAGE(PG8_SA(0, 1), a2 + hstep, voffA);
            PG8_WAIT_L(8); PG8_BAR; PG8_WAIT_L(0); PG8_MMA(0, 0, At, B0); PG8_BAR; PG8_SCHED;
            PG8_LDB(B1, 1, 1); PG8_STAGE(PG8_SB(1, 0), b3, voffB);
            PG8_BAR; PG8_WAIT_L(0); PG8_MMA(0, 1, At, B1); PG8_BAR;
            PG8_LDA(At, 1, 1); PG8_STAGE(PG8_SA(1, 0), a3, voffA);
            PG8_BAR; PG8_WAIT_L(0); PG8_MMA(1, 0, At, B0); PG8_BAR; PG8_SCHED;
            PG8_STAGE(PG8_SB(1, 1), b3 + hstep, voffB);
            PG8_WAIT_V(6); PG8_BAR; PG8_MMA(1, 1, At, B1); PG8_BAR;
            }
        }
        if constexpr (ALIGN_EPI) { if (wr == 0) PG8_BAR; }
        if constexpr (!Epi::AFTER_DRAIN) { E(acc, cur, wr, wc, fr, fq); S.done(cur); }
        if (!has_next) break;
#pragma unroll
        for (int a = 0; a < 2; ++a)
#pragma unroll
            for (int b = 0; b < 2; ++b)
#pragma unroll
                for (int m = 0; m < 4; ++m)
#pragma unroll
                    for (int n = 0; n < 2; ++n) acc[a][b][m][n] = (f32x4){0.f, 0.f, 0.f, 0.f};
        cur = nxt; cA = nA; cB = nB; ++ui;
        if constexpr (ALIGN_EPI) { if (wr == 1) PG8_BAR; }
    }
    PG8_WAIT_V(0);
    if constexpr (!ALIGN_EPI) { if (wr == 0) PG8_BAR; }
    PG8_BAR;
    if constexpr (Epi::AFTER_DRAIN) { E.fused(acc, cur, wr, wc, fr, fq, lds, wid, lane); S.done(cur); }
#undef PG8_SA
#undef PG8_SB
#undef PG8_STAGE
#undef PG8_LDA
#undef PG8_LDB
#undef PG8_MMA
#undef PG8_WAIT_V
#undef PG8_WAIT_L
#undef PG8_BAR
#undef PG8_SCHED
}
}

constexpr int BATCH = 8, SEQ = 4096, D = 1024, M = BATCH * SEQ, NIN = 7168, NMOD = 6 * D, NEXP = 16384, NPQ = 2048;
constexpr float EPS = 1e-6f;
constexpr int NWAVES = 8;
#ifndef MK_N_LAUNCHES
#define MK_N_LAUNCHES 1
#endif
#define DBG_STOP 99
#define PEER_OPT 7
constexpr int NPHASE = 13;
constexpr int N_LAUNCHES = MK_N_LAUNCHES;

constexpr size_t MiB = 1u << 20;
constexpr size_t WS_CTL = 0, CTL_ZERO_BYTES = 2 * MiB;
constexpr size_t WS_MOD = 1 * MiB;
constexpr size_t WS_ROPE = 2 * MiB;
constexpr size_t WS_STATS = 4 * MiB;
constexpr size_t WS_WIN = 8 * MiB, WS_WA = 22 * MiB, WS_WG = 24 * MiB, WS_WOUT = 26 * MiB, WS_WPQ = 28 * MiB, WS_KEYS = 32 * MiB, WS_WSP = 33 * MiB;
constexpr size_t WS_XN = 40 * MiB, WS_Q = 104 * MiB, WS_K = 168 * MiB, WS_V = 232 * MiB, WS_U = 296 * MiB, WS_ZV = 360 * MiB, WS_END = 424 * MiB;
constexpr size_t WS_O0 = WS_XN;
constexpr size_t WS_T1 = WS_K;
constexpr size_t WS_MIXIN = WS_ZV;
constexpr size_t WS_H2 = WS_XN;
constexpr size_t WS_QP = WS_K;
constexpr size_t WS_IDX = WS_U, WS_GATE = WS_U + 16 * MiB;
constexpr size_t WS_PU = WS_Q, WS_PV = WS_Q + 32 * MiB;
constexpr size_t WS_PART = WS_K;
constexpr size_t WS_A = WS_U + 32 * MiB;
constexpr size_t WS_Y = WS_K;
constexpr int CW_TMO = 0, CW_BAR = 4096;

constexpr int RING_BYTES = 131072, LDSCTL_OFF = RING_BYTES, MISC_OFF = LDSCTL_OFF + 320, LDS_BYTES = 147456;

#define GAS __attribute__((address_space(1)))
#define LAS __attribute__((address_space(3)))
typedef unsigned short bf16;
typedef unsigned v4u __attribute__((ext_vector_type(4)));
typedef unsigned v2u __attribute__((ext_vector_type(2)));
typedef float f32x4 __attribute__((ext_vector_type(4)));
typedef float f32x2 __attribute__((ext_vector_type(2)));
typedef float f32x16 __attribute__((ext_vector_type(16)));
typedef short bf16x8 __attribute__((ext_vector_type(8)));
typedef short s16x4 __attribute__((ext_vector_type(4)));
typedef __bf16 bf16x2_t __attribute__((ext_vector_type(2)));
typedef GAS unsigned gu32;
#define RLX_AGENT __ATOMIC_RELAXED, __HIP_MEMORY_SCOPE_AGENT
#define LDS_WAIT() asm volatile("s_waitcnt lgkmcnt(0)" ::: "memory")
#define VM_WAIT() asm volatile("s_waitcnt vmcnt(0)" ::: "memory")
#define SBAR() __builtin_amdgcn_sched_barrier(0)
__device__ __forceinline__ unsigned f2bf(float f) { unsigned u = __builtin_bit_cast(unsigned, f); return (u + 0x7fffu + ((u >> 16) & 1u)) >> 16; }
__device__ __forceinline__ unsigned pk2(float lo, float hi) { f32x2 v = {lo, hi}; bf16x2_t b = __builtin_convertvector(v, bf16x2_t); return __builtin_bit_cast(unsigned, b); }
__device__ __forceinline__ float bflo(unsigned w) { return __builtin_bit_cast(float, w << 16); }
__device__ __forceinline__ float bfhi(unsigned w) { return __builtin_bit_cast(float, w & 0xffff0000u); }
__device__ __forceinline__ float gelu_tanh(float x) {
    const float u = x * (0.7978845608f + 0.035677408137f * x * x);
    const float e = __builtin_amdgcn_exp2f(-2.885390081777927f * u);
    return x * __builtin_amdgcn_rcpf(1.f + e);
}
__device__ __forceinline__ float sigmoidf_(float x) { return __builtin_amdgcn_rcpf(1.f + __builtin_amdgcn_exp2f(-1.4426950408889634f * x)); }
__device__ __forceinline__ float wave_sum(float v) {
#pragma unroll
    for (int o = 1; o < 64; o <<= 1) v += __shfl_xor(v, o);
    return v;
}
__device__ __forceinline__ int crow(int r, int hi) { return (r & 3) + 8 * (r >> 2) + 4 * hi; }


namespace pg8 {
typedef float f32x2e __attribute__((ext_vector_type(2)));
__device__ __forceinline__ float bf_lo(unsigned w) { return __builtin_bit_cast(float, w << 16); }
__device__ __forceinline__ float bf_hi(unsigned w) { return __builtin_bit_cast(float, w & 0xffff0000u); }
__device__ __forceinline__ float gelu_t(float x) { const float u = x * (0.7978845608f + 0.035677408137f * x * x); const float e = __builtin_amdgcn_exp2f(-2.885390081777927f * u); return x * __builtin_amdgcn_rcpf(1.f + e); }
__device__ __forceinline__ float sigm(float x) { return __builtin_amdgcn_rcpf(1.f + __builtin_amdgcn_exp2f(-1.4426950408889634f * x)); }
__device__ __forceinline__ u32x4 pack8(const f32x4& a, const f32x4& b) { u32x4 w; w.x = cvt_pk_bf16(a[0], a[1]); w.y = cvt_pk_bf16(a[2], a[3]); w.z = cvt_pk_bf16(b[0], b[1]); w.w = cvt_pk_bf16(b[2], b[3]); return w; }

struct EpiInProj {
    static constexpr bool PERM = true, AFTER_DRAIN = false;
    bf16_t* Q; bf16_t* K; bf16_t* V; bf16_t* U; bf16_t* ZV; bf16_t* GA; bf16_t* GG; const float* rope; float* stats;
    __device__ __forceinline__ void operator()(const f32x4 (&acc)[2][2][4][2], const Unit& u, int wr, int wc, int fr, int fq) const {
        const int ty = u.pn >> 2;
        const int row0 = u.pm * BM + wr * 64 + fr;
        const int cc0 = (u.pn & 3) * BM + wc * 32 + 8 * fq;
        bf16_t* base = ty == 0 ? Q : ty == 1 ? K : ty == 2 ? V : ty == 3 ? U : ty == 4 ? ZV : ty == 5 ? GA : GG;
        if (ty <= 1) {
            const bool even = (wc & 1) == 0;
            const bool part = even && fq < 2;
            const float sg = (fq == 0) ? -1.f : 1.f;
#pragma unroll
            for (int ai = 0; ai < 2; ++ai)
#pragma unroll
                for (int m = 0; m < 4; ++m) {
                    const int row = row0 + ai * HALF + m * 16;
                    f32x4 c0 = {1.f, 1.f, 1.f, 1.f}, c1 = c0, s0 = {0.f, 0.f, 0.f, 0.f}, s1 = s0;
                    if (even) { const f32x4* rp = (const f32x4*)(rope + (size_t)row * 16); c0 = rp[0]; c1 = rp[1]; s0 = rp[2]; s1 = rp[3]; }
#pragma unroll
                    for (int bj = 0; bj < 2; ++bj) {
                        f32x4 v0 = acc[ai][bj][m][0], v1 = acc[ai][bj][m][1];
                        if (even) {
                            f32x4 p0, p1;
#pragma unroll
                            for (int j = 0; j < 4; ++j) { p0[j] = __shfl_xor(v0[j], 16); p1[j] = __shfl_xor(v1[j], 16); }
                            if (part) { v0 = v0 * c0 + (p0 * s0) * sg; v1 = v1 * c1 + (p1 * s1) * sg; }
                        }
                        *(u32x4*)(base + (size_t)row * 1024 + cc0 + bj * HALF) = pack8(v0, v1);
                    }
                }
        } else if (ty == 2) {
#pragma unroll
            for (int ai = 0; ai < 2; ++ai)
#pragma unroll
                for (int m = 0; m < 4; ++m) { const int row = row0 + ai * HALF + m * 16;
#pragma unroll
                    for (int bj = 0; bj < 2; ++bj) *(u32x4*)(base + (size_t)row * 1024 + cc0 + bj * HALF) = pack8(acc[ai][bj][m][0], acc[ai][bj][m][1]); }
        } else if (ty <= 4) {
#pragma unroll
            for (int ai = 0; ai < 2; ++ai)
#pragma unroll
                for (int m = 0; m < 4; ++m) { const int row = row0 + ai * HALF + m * 16; float s = 0.f, q = 0.f;
#pragma unroll
                    for (int bj = 0; bj < 2; ++bj) { f32x4 v0 = acc[ai][bj][m][0], v1 = acc[ai][bj][m][1];
#pragma unroll
                        for (int j = 0; j < 4; ++j) { v0[j] = gelu_t(v0[j]); v1[j] = gelu_t(v1[j]); }
                        const u32x4 w = pack8(v0, v1);
                        *(u32x4*)(base + (size_t)row * 1024 + cc0 + bj * HALF) = w;
                        if (ty == 4) {
#pragma unroll
                            for (int j = 0; j < 4; ++j) { const float a = bf_lo(w[j]), b = bf_hi(w[j]); s += a + b; q += a * a + b * b; } }
                    }
                    if (ty == 4) { s += __shfl_xor(s, 16); s += __shfl_xor(s, 32); q += __shfl_xor(q, 16); q += __shfl_xor(q, 32);
                        if (fq == 0) { f32x2e o = {s, q}; *(f32x2e*)(stats + ((size_t)row * 16 + (u.pn & 3) * 4 + wc) * 2) = o; } }
                }
        } else {
#pragma unroll
            for (int ai = 0; ai < 2; ++ai)
#pragma unroll
                for (int m = 0; m < 4; ++m) { const int row = row0 + ai * HALF + m * 16;
#pragma unroll
                    for (int bj = 0; bj < 2; ++bj) { f32x4 v0 = acc[ai][bj][m][0], v1 = acc[ai][bj][m][1];
#pragma unroll
                        for (int j = 0; j < 4; ++j) { v0[j] = sigm(v0[j]); v1[j] = sigm(v1[j]); }
                        *(u32x4*)(base + (size_t)row * 1024 + cc0 + bj * HALF) = pack8(v0, v1); } }
        }
    }
};

struct EpiMerge {
    static constexpr bool PERM = true, AFTER_DRAIN = false;
    const bf16_t* GA; const bf16_t* GG; float* T1; bf16_t* O;
    __device__ __forceinline__ void operator()(const f32x4 (&acc)[2][2][4][2], const Unit& u, int wr, int wc, int fr, int fq) const {
        const int row0 = u.pm * BM + wr * 64 + fr, col0 = u.pn * BM + wc * 32 + 8 * fq;
        const bf16_t* G = u.w == 0 ? GA : GG;
#pragma unroll
        for (int ai = 0; ai < 2; ++ai)
#pragma unroll
            for (int m = 0; m < 4; ++m) { const size_t ro = (size_t)(row0 + ai * HALF + m * 16) * 1024 + col0;
#pragma unroll
                for (int bj = 0; bj < 2; ++bj) { const size_t off = ro + bj * HALF;
                    const u32x4 g = *(const u32x4*)(G + off);
                    f32x4 v0 = acc[ai][bj][m][0], v1 = acc[ai][bj][m][1];
                    v0[0] *= bf_lo(g.x); v0[1] *= bf_hi(g.x); v0[2] *= bf_lo(g.y); v0[3] *= bf_hi(g.y);
                    v1[0] *= bf_lo(g.z); v1[1] *= bf_hi(g.z); v1[2] *= bf_lo(g.w); v1[3] *= bf_hi(g.w);
                    if (u.w == 0) { *(f32x4*)(T1 + off) = v0; *(f32x4*)(T1 + off + 4) = v1; }
                    else { const f32x4 t0 = *(const f32x4*)(T1 + off), t1 = *(const f32x4*)(T1 + off + 4); *(u32x4*)(O + off) = pack8(v0 + t0, v1 + t1); } } }
    }
};

struct EpiF32 {
    static constexpr bool PERM = true, AFTER_DRAIN = false;
    float* O; int ldc;
    __device__ __forceinline__ void operator()(const f32x4 (&acc)[2][2][4][2], const Unit& u, int wr, int wc, int fr, int fq) const {
        const int row0 = u.pm * BM + wr * 64 + fr, col0 = u.pn * BM + wc * 32 + 8 * fq;
#pragma unroll
        for (int ai = 0; ai < 2; ++ai)
#pragma unroll
            for (int m = 0; m < 4; ++m) { float* rowp = O + (size_t)(row0 + ai * HALF + m * 16) * ldc + col0;
#pragma unroll
                for (int bj = 0; bj < 2; ++bj) { *(f32x4*)(rowp + bj * HALF) = acc[ai][bj][m][0]; *(f32x4*)(rowp + bj * HALF + 4) = acc[ai][bj][m][1]; } }
    }
};
}
#define XB_TMO      128
#define XB_XCNT(j)  (256  + 64 * (j))
#define XB_XSUB(j)  (1280 + 64 * (j))
#define XB_XGEN(j)  (2304 + 64 * (j))
#define XB_TOP      3328
#define XB_TOPGEN   3392
#define XCD_BAR_WORDS 3456
#define XB_SPIN_CAP (1u << 18)

__device__ __forceinline__ unsigned xb_ld(unsigned* p)              { return __hip_atomic_load(p, __ATOMIC_RELAXED, __HIP_MEMORY_SCOPE_AGENT); }
__device__ __forceinline__ unsigned xb_add(unsigned* p, unsigned v) { return __hip_atomic_fetch_add(p, v, __ATOMIC_RELAXED, __HIP_MEMORY_SCOPE_AGENT); }
__device__ __forceinline__ unsigned xb_xcc_id() { return (unsigned)__builtin_amdgcn_s_getreg((3 << 11) | 20) & 0xFu; }
#define XB_SPIN(cond, bar) do { unsigned _sp = 0; while (cond) { __builtin_amdgcn_s_sleep(1); \
    if ((++_sp & 255u) == 0u) { if (xb_ld(&(bar)[XB_TMO])) break; if (_sp > XB_SPIN_CAP) { atomicAdd(&(bar)[XB_TMO], 1u); break; } } } } while (0)

struct XcdBarrier {
    unsigned* bar; unsigned x;
    volatile LAS unsigned* st;
};

__device__ __forceinline__ XcdBarrier xcd_barrier_post(unsigned* bar, volatile LAS unsigned* st) {
    XcdBarrier b; b.bar = bar; b.x = xb_xcc_id(); b.st = st;
    if (threadIdx.x == 0) (void)xb_add(&bar[XB_XCNT(b.x)], 1u);
    return b;
}
__device__ __forceinline__ void xcd_barrier_complete(unsigned* bar, unsigned x, unsigned& nloc, unsigned& nx) {
    const unsigned G = gridDim.x * gridDim.y * gridDim.z;
    unsigned sum, cnt, mine, sp = 0u;
    for (;;) {
        sum = 0u; cnt = 0u; mine = 0u;
#pragma unroll
        for (unsigned j = 0; j < 16; ++j) { const unsigned c = xb_ld(&bar[XB_XCNT(j)]); sum += c; cnt += (c > 0u) ? 1u : 0u; mine = (j == x) ? c : mine; }
        if (sum == G) break;
        __builtin_amdgcn_s_sleep(1);
        if ((++sp & 255u) == 0u) { if (xb_ld(&bar[XB_TMO])) break; if (sp > XB_SPIN_CAP) { atomicAdd(&bar[XB_TMO], 1u); break; } }
    }
    nloc = mine > 0u ? mine : 1u; nx = cnt > 0u ? cnt : 1u;
}

__device__ __forceinline__ void xcd_barrier(const XcdBarrier& b) {
    asm volatile("s_waitcnt vmcnt(0)" ::: "memory");
    __syncthreads();
    if (threadIdx.x == 0) {
        unsigned* bar = b.bar;
        __builtin_amdgcn_s_waitcnt(0);
        unsigned nloc = b.st[0], nx = b.st[1];
        if (nloc == 0u) { xcd_barrier_complete(bar, b.x, nloc, nx); b.st[0] = nloc; b.st[1] = nx; }
        const unsigned old = xb_add(&bar[XB_XSUB(b.x)], 1u);
        const unsigned gen = old / nloc;
        if (old + 1u == (gen + 1u) * nloc) {
            __builtin_amdgcn_fence(__ATOMIC_RELEASE, "agent");
            asm volatile("s_waitcnt vmcnt(0)" ::: "memory");
            const unsigned og = xb_add(&bar[XB_TOP], 1u);
            const unsigned tg = og / nx;
            if (og + 1u == (tg + 1u) * nx) xb_add(&bar[XB_TOPGEN], 1u);
            else XB_SPIN(xb_ld(&bar[XB_TOPGEN]) == tg, bar);
            __builtin_amdgcn_fence(__ATOMIC_ACQUIRE, "agent");
            xb_add(&bar[XB_XGEN(b.x)], 1u);
            asm volatile("s_waitcnt vmcnt(0)" ::: "memory");
        } else {
            XB_SPIN(xb_ld(&bar[XB_XGEN(b.x)]) == gen, bar);
            __builtin_amdgcn_fence(__ATOMIC_ACQUIRE, "agent");
            asm volatile("s_waitcnt vmcnt(0)" ::: "memory");
        }
    }
    __syncthreads();
}

struct Frame {
    LAS unsigned char* lds; int tid, lane, wave, vcu, G;
};

__device__ __forceinline__ void p0_transpose_item(const float* W, int K, int N, bf16* WT, LAS float* scr, int item, int lane) {
    const int nblk = N / 32, kb = item / nblk, nb = item % nblk, k0 = 64 * kb, n0 = 32 * nb;
#pragma unroll 8
    for (int i = 0; i < 32; ++i) { const int kk = 2 * i + (lane >> 5); scr[kk * 33 + (lane & 31)] = W[(size_t)(k0 + kk) * N + n0 + (lane & 31)]; }
    LDS_WAIT(); asm volatile("" ::: "memory");
    const int c = lane & 7;
#pragma unroll
    for (int j = 0; j < 4; ++j) { const int n = (lane >> 3) + 8 * j; const LAS float* s = scr + (8 * c) * 33 + n;
        v4u o; o.x = pk2(s[0 * 33], s[1 * 33]); o.y = pk2(s[2 * 33], s[3 * 33]); o.z = pk2(s[4 * 33], s[5 * 33]); o.w = pk2(s[6 * 33], s[7 * 33]);
        *(GAS v4u*)(WT + (size_t)(n0 + n) * K + k0 + 8 * c) = o; }
    LDS_WAIT(); asm volatile("" ::: "memory");
}
__device__ __forceinline__ void cvt_plain(const Frame& F, const float* src, bf16* dst, long n8) {
    const long gt = (long)(F.vcu * NWAVES + F.wave) * 64 + F.lane, NT = (long)F.G * NWAVES * 64;
    for (long i = gt; i < n8; i += NT) { const f32x4 a = *(const GAS f32x4*)(src + i * 8), b = *(const GAS f32x4*)(src + i * 8 + 4);
        v4u o; o.x = pk2(a[0], a[1]); o.y = pk2(a[2], a[3]); o.z = pk2(b[0], b[1]); o.w = pk2(b[2], b[3]); *(GAS v4u*)(dst + i * 8) = o; }
}
__device__ __forceinline__ void sincos_d(double r, float& s, float& c) {
    const double z = r * r;
    double ps = 1.9572941063391263e-20; ps = ps * z + -8.22063524662433e-18; ps = ps * z + 2.8114572543455206e-15; ps = ps * z + -7.647163731819816e-13; ps = ps * z + 1.6059043836821613e-10;
    ps = ps * z + -2.505210838544172e-08; ps = ps * z + 2.7557319223985893e-06; ps = ps * z + -0.0001984126984126984; ps = ps * z + 0.008333333333333333; ps = ps * z + -0.16666666666666666; ps = ps * z + 1.0;
    double pc = -8.896791392450574e-22; pc = pc * z + 4.110317623312165e-19; pc = pc * z + -1.5619206968586225e-16; pc = pc * z + 4.779477332387385e-14; pc = pc * z + -1.1470745597729725e-11; pc = pc * z + 2.08767569878681e-09;
    pc = pc * z + -2.755731922398589e-07; pc = pc * z + 2.48015873015873e-05; pc = pc * z + -0.001388888888888889; pc = pc * z + 0.041666666666666664; pc = pc * z + -0.5; pc = pc * z + 1.0;
    s = (float)(r * ps); c = (float)pc;
}
struct P0Args { const float *c, *w_ada, *b_ada, *w_in, *w_a, *w_g, *w_out, *w_pq, *keys, *wsp; const int* pos; unsigned char* ws; };
__device__ __forceinline__ void p0_prologue(const Frame& F, const P0Args& a) {
    LAS float* scr = (LAS float*)(F.lds + F.wave * 16384);
    const int gw = F.vcu * NWAVES + F.wave, NGW = F.G * NWAVES;
    constexpr int I_IN = (D / 64) * (NIN / 32), I_SQ = (D / 64) * (D / 32), I_PQ = (D / 64) * (NPQ / 32), NITEMS = I_IN + 3 * I_SQ + I_PQ;
    for (int it = gw; it < NITEMS; it += NGW) {
        int r = it;
        if (r < I_IN) { p0_transpose_item(a.w_in, D, NIN, (bf16*)(a.ws + WS_WIN), scr, r, F.lane); continue; } r -= I_IN;
        if (r < I_SQ) { p0_transpose_item(a.w_a, D, D, (bf16*)(a.ws + WS_WA), scr, r, F.lane); continue; } r -= I_SQ;
        if (r < I_SQ) { p0_transpose_item(a.w_g, D, D, (bf16*)(a.ws + WS_WG), scr, r, F.lane); continue; } r -= I_SQ;
        if (r < I_SQ) { p0_transpose_item(a.w_out, D, D, (bf16*)(a.ws + WS_WOUT), scr, r, F.lane); continue; } r -= I_SQ;
        p0_transpose_item(a.w_pq, D, NPQ, (bf16*)(a.ws + WS_WPQ), scr, r, F.lane);
    }
    cvt_plain(F, a.keys, (bf16*)(a.ws + WS_KEYS), 8 * 2 * 128 * 128 / 8);
    cvt_plain(F, a.wsp, (bf16*)(a.ws + WS_WSP), 8 * 128 * 128 / 8);
    { const long gt = (long)gw * 64 + F.lane, NT = (long)NGW * 64; float* rope = (float*)(a.ws + WS_ROPE);
      for (long m = gt; m < M; m += NT) { const double p = (double)a.pos[m];
          const double invf[8] = {1.0, 0.19392274474868576, 0.03760603093086393, 0.007292664737217109, 0.001414213562373095, 0.0002742481756762073, 5.318295896944988e-05, 1.031338537721246e-05};
          float cs[8], sn[8];
#pragma unroll
          for (int i = 0; i < 8; ++i) { const double ang = p * invf[i]; const double k = __builtin_rint(ang * 0.15915494309189535); const double r = ang - k * 6.283185307179586; sincos_d(r, sn[i], cs[i]); }
          f32x4* o = (f32x4*)(rope + m * 16);
          o[0] = (f32x4){cs[0], cs[1], cs[2], cs[3]}; o[1] = (f32x4){cs[4], cs[5], cs[6], cs[7]}; o[2] = (f32x4){sn[0], sn[1], sn[2], sn[3]}; o[3] = (f32x4){sn[4], sn[5], sn[6], sn[7]}; } }
    { float* mod = (float*)(a.ws + WS_MOD); LAS float* red = (LAS float*)F.lds;
      __syncthreads();
      for (int it = F.vcu; it < NMOD / 32; it += F.G) { const int col = it * 32 + (F.lane & 31), kh = F.lane >> 5, k0 = F.wave * 128 + kh * 64;
          float acc[8];
#pragma unroll
          for (int b = 0; b < 8; ++b) acc[b] = 0.f;
#pragma unroll 8
          for (int kk = 0; kk < 64; ++kk) { const int k = k0 + kk; const float w = a.w_ada[(size_t)k * NMOD + col];
#pragma unroll
              for (int b = 0; b < 8; ++b) { const float cv = a.c[b * D + k]; const float sl = cv * __builtin_amdgcn_rcpf(1.f + __expf(-cv)); acc[b] += sl * w; } }
#pragma unroll
          for (int b = 0; b < 8; ++b) red[((F.wave * 2 + kh) * 8 + b) * 32 + (F.lane & 31)] = acc[b];
          __syncthreads();
          if (F.tid < 256) { const int b = F.tid >> 5, c = F.tid & 31; float s = a.b_ada[it * 32 + c];
#pragma unroll
              for (int p = 0; p < 16; ++p) s += red[(p * 8 + b) * 32 + c];
              mod[b * NMOD + it * 32 + c] = s; }
          __syncthreads(); } }
}

__device__ __forceinline__ void p1_xn(const Frame& F, const float* x, const float* g_pre, const float* mod, bf16* XN) {
    const int gw = F.vcu * NWAVES + F.wave, NGW = F.G * NWAVES;
    for (int m = gw; m < M; m += NGW) { const int b = m >> 12;
        const GAS f32x4* xr = (const GAS f32x4*)(x + (size_t)m * D) + F.lane;
        f32x4 v[4]; float ss = 0.f;
#pragma unroll
        for (int j = 0; j < 4; ++j) { v[j] = xr[64 * j]; ss += (v[j].x * v[j].x + v[j].y * v[j].y) + (v[j].z * v[j].z + v[j].w * v[j].w); }
        const float rs = 1.f / sqrtf(wave_sum(ss) * (1.f / D) + EPS);
        GAS v2u* o8 = (GAS v2u*)(XN + (size_t)m * D) + F.lane;
#pragma unroll
        for (int j = 0; j < 4; ++j) { const int col = 256 * j + 4 * F.lane;
            const f32x4 g = *(const f32x4*)(g_pre + col), sh = *(const f32x4*)(mod + b * NMOD + col), sc = *(const f32x4*)(mod + b * NMOD + D + col);
            const f32x4 h = v[j] * rs * g * (sc + 1.f) + sh; v2u w; w.x = pk2(h.x, h.y); w.y = pk2(h.z, h.w); o8[64 * j] = w; }
    }
}

__device__ __forceinline__ s16x4 tr_read_dyn(unsigned addr) { s16x4 r; asm volatile("ds_read_b64_tr_b16 %0, %1" : "=&v"(r) : "v"(addr) : "memory"); return r; }
struct GmlpArgs { const bf16* ZV; bf16* U; const float* stats; const float* ln_g; const float* ln_b; const bf16* wsp; const float* b_s; };
__device__ __forceinline__ void p3_gmlp(const Frame& F, const GmlpArgs& a) {
    LAS unsigned char* T = F.lds + F.wave * 16384;
    LAS float* MR = (LAS float*)(F.lds + LDSCTL_OFF + 1024);
    const int g = F.wave, lane = F.lane, L31 = lane & 31, hh = lane >> 5;
    const unsigned Tb = (unsigned)(uintptr_t)T;
    const int qq = (lane & 15) >> 2, p4 = lane & 3, g16 = (lane >> 4) & 1, sw = (qq >> 1) & 1;
    const unsigned rb0 = Tb + (8 * hh + qq) * 128 + 64 * (0 ^ sw) + (16 * g16 + 4 * p4) * 2;
    const unsigned rb1 = Tb + (8 * hh + qq) * 128 + 64 * (1 ^ sw) + (16 * g16 + 4 * p4) * 2;
    for (int ck = F.vcu; ck < M / 128; ck += F.G) {
        const size_t rowc = (size_t)ck * 128;
        __syncthreads();
        if (F.tid < 128) { const f32x4* sp = (const f32x4*)(a.stats + (rowc + F.tid) * 32); float s = 0.f, q = 0.f;
#pragma unroll
            for (int j = 0; j < 8; ++j) { const f32x4 t = sp[j]; s += t.x + t.z; q += t.y + t.w; }
            const float mu = s * (1.f / 1024.f), var = q * (1.f / 1024.f) - mu * mu;
            MR[2 * F.tid] = mu; MR[2 * F.tid + 1] = 1.f / sqrtf(fmaxf(var, 0.f) + EPS); }
        __syncthreads();
#pragma unroll 1
        for (int half = 0; half < 2; ++half) {
            const int cbase = g * 128 + half * 64;
            { const int c0 = 8 * (lane & 7);
              const f32x4 ga = *(const f32x4*)(a.ln_g + cbase + c0), gb = *(const f32x4*)(a.ln_g + cbase + c0 + 4), ba = *(const f32x4*)(a.ln_b + cbase + c0), bb = *(const f32x4*)(a.ln_b + cbase + c0 + 4);
#pragma unroll 4
              for (int i = 0; i < 16; ++i) { const int q = (lane >> 3) + 8 * i;
                  const v4u w = *(const GAS v4u*)(a.ZV + (rowc + q) * 1024 + cbase + c0);
                  const float mu = MR[2 * q], rs = MR[2 * q + 1];
                  f32x4 x0 = {bflo(w.x), bfhi(w.x), bflo(w.y), bfhi(w.y)}, x1 = {bflo(w.z), bfhi(w.z), bflo(w.w), bfhi(w.w)};
                  x0 = (x0 - mu) * rs * ga + ba; x1 = (x1 - mu) * rs * gb + bb;
                  v4u o; o.x = pk2(x0[0], x0[1]); o.y = pk2(x0[2], x0[3]); o.z = pk2(x1[0], x1[1]); o.w = pk2(x1[2], x1[3]);
                  *(LAS v4u*)(T + q * 128 + ((c0 * 2) ^ (((q >> 1) & 1) << 6))) = o; } }
            LDS_WAIT(); asm volatile("" ::: "memory");
#pragma unroll 1
            for (int pb = 0; pb < 4; ++pb) {
                bf16x8 af[8];
#pragma unroll
                for (int ks = 0; ks < 8; ++ks) af[ks] = *(const GAS bf16x8*)(a.wsp + ((size_t)(g * 128 + pb * 32 + L31)) * 128 + 16 * ks + 8 * hh);
                f32x16 acc0 = {}, acc1 = {};
#pragma unroll
                for (int ks = 0; ks < 8; ++ks) {
                    const s16x4 l0 = tr_read_dyn(rb0 + ks * 2048), h0 = tr_read_dyn(rb0 + ks * 2048 + 512), l1 = tr_read_dyn(rb1 + ks * 2048), h1 = tr_read_dyn(rb1 + ks * 2048 + 512);
                    asm volatile("s_waitcnt lgkmcnt(0)" ::: "memory"); SBAR();
                    const bf16x8 b0 = {l0[0], l0[1], l0[2], l0[3], h0[0], h0[1], h0[2], h0[3]}, b1 = {l1[0], l1[1], l1[2], l1[3], h1[0], h1[1], h1[2], h1[3]};
                    acc0 = __builtin_amdgcn_mfma_f32_32x32x16_bf16(af[ks], b0, acc0, 0, 0, 0);
                    acc1 = __builtin_amdgcn_mfma_f32_32x32x16_bf16(af[ks], b1, acc1, 0, 0, 0);
                }
#pragma unroll
                for (int r = 0; r < 16; ++r) { const int p = pb * 32 + crow(r, hh); const float bs = a.b_s[g * 128 + p];
                    bf16* up = a.U + (rowc + p) * 1024 + cbase + L31;
                    const float u0 = bflo((unsigned)up[0]), u1 = bflo((unsigned)up[32]);
                    up[0] = (bf16)f2bf(u0 * (acc0[r] + bs)); up[32] = (bf16)f2bf(u1 * (acc1[r] + bs)); }
            }
            LDS_WAIT(); asm volatile("" ::: "memory");
        }
    }
    __syncthreads();
}

namespace att {
constexpr int NW = 8, QBLK = 32, KVBLK = 64, LD = 1024;
constexpr float SCALE = 0.125f, THR = 8.f;
constexpr int SHM_V = 16384, SHM_K = 8192, OFF_V = 0, OFF_K = 2 * SHM_V, OFF_WS = OFF_K + 2 * SHM_K, OFF_STG = OFF_WS + NW * 64 * 4, ATT_LDS = OFF_STG + NW * 8192;
static_assert(ATT_LDS <= 131072, "attention LDS");
#define KSWZ64(row, colB) ((row) * 128 + ((colB) ^ ((((row) >> 1) & 7) << 4)))
__device__ __forceinline__ unsigned cvtpk(float lo, float hi) { return pk2(lo, hi); }
__device__ __forceinline__ void partialSM(f32x16& p0, f32x16& p1, float& m_reg, float& mn, float& alpha) {
  constexpr float C = SCALE * 1.4426950408889634f;
  float pmax = p0[0];
#pragma unroll
  for (int r = 1; r < 16; ++r) pmax = fmaxf(pmax, p0[r]);
#pragma unroll
  for (int r = 0; r < 16; ++r) pmax = fmaxf(pmax, p1[r]);
  { auto rr = __builtin_amdgcn_permlane32_swap(__float_as_uint(pmax), __float_as_uint(pmax), false, false);
    pmax = fmaxf(__uint_as_float(rr[0]), __uint_as_float(rr[1])); }
  if (__builtin_expect(__all(pmax - m_reg <= THR / SCALE), 1)) { mn = m_reg; alpha = 1.f; }
  else { mn = fmaxf(m_reg, pmax); alpha = __builtin_amdgcn_exp2f((m_reg - mn) * C); m_reg = mn; }
  float mnC = -mn * C;
#pragma unroll
  for (int r = 0; r < 16; ++r) p0[r] = fmaf(p0[r], C, mnC);
#pragma unroll
  for (int r = 0; r < 16; ++r) p1[r] = fmaf(p1[r], C, mnC);
#pragma unroll
  for (int r = 0; r < 16; ++r) p0[r] = __builtin_amdgcn_exp2f(p0[r]);
}
__device__ __forceinline__ void finishSM(f32x16& p0, f32x16& p1, float alpha, float& l_reg, bf16x8& pa0, bf16x8& pa1, bf16x8& pa2, bf16x8& pa3) {
#pragma unroll
  for (int r = 0; r < 16; ++r) p1[r] = __builtin_amdgcn_exp2f(p1[r]);
  float ps = 0;
#pragma unroll
  for (int r = 0; r < 16; ++r) ps += p0[r];
#pragma unroll
  for (int r = 0; r < 16; ++r) ps += p1[r];
  { auto rr = __builtin_amdgcn_permlane32_swap(__float_as_uint(ps), __float_as_uint(ps), false, false);
    ps = __uint_as_float(rr[0]) + __uint_as_float(rr[1]); }
  l_reg = l_reg * alpha + ps;
#define PK4(P, BASE, OUT) do { unsigned a0 = cvtpk(P[BASE + 0], P[BASE + 1]), a1 = cvtpk(P[BASE + 2], P[BASE + 3]);   \
    unsigned b0 = cvtpk(P[BASE + 4], P[BASE + 5]), b1 = cvtpk(P[BASE + 6], P[BASE + 7]);                              \
    auto r0 = __builtin_amdgcn_permlane32_swap(a0, b0, false, false); auto r1 = __builtin_amdgcn_permlane32_swap(a1, b1, false, false); \
    v4u w = {r0[0], r1[0], r0[1], r1[1]}; OUT = *reinterpret_cast<bf16x8*>(&w); } while (0)
  PK4(p0, 0, pa0); PK4(p0, 8, pa1); PK4(p1, 0, pa2); PK4(p1, 8, pa3);
#undef PK4
}
__device__ __forceinline__ void qkt(f32x16& p0, f32x16& p1, const char* Ks, const bf16x8* qr, int r32, int hi) {
  p0 = f32x16{}; p1 = f32x16{};
#pragma unroll
  for (int d0 = 0; d0 < 4; ++d0) { const int cb = (d0 * 16 + hi * 8) * 2;
    bf16x8 b0 = *reinterpret_cast<const bf16x8*>(Ks + KSWZ64(r32, cb));
    bf16x8 b1 = *reinterpret_cast<const bf16x8*>(Ks + KSWZ64(32 + r32, cb));
    p0 = __builtin_amdgcn_mfma_f32_32x32x16_bf16(b0, qr[d0], p0, 0, 0, 0);
    p1 = __builtin_amdgcn_mfma_f32_32x32x16_bf16(b1, qr[d0], p1, 0, 0, 0); }
}
__device__ __forceinline__ int v_st(int k, int c) { const int kk = (k & ~0xC) | ((k & 4) << 1) | ((k & 8) >> 1); return ((kk >> 3) * 4 + (c >> 5)) * 512 + ((kk & 7) * 32 + (c & 31)) * 2; }
__device__ __forceinline__ int v_rd_base(int lane) { return ((lane & 3) << 3) | (((lane >> 2) & 3) << 6) | (((lane >> 4) & 1) << 5) | (((lane >> 5) & 1) << 8); }
constexpr int v_rd_off(int d0, int ks, int half) { return d0 * 512 + ks * 4096 + half * 2048; }
template <int OFF> __device__ __forceinline__ s16x4 tr_read(int vb) {
  s16x4 r; asm volatile("ds_read_b64_tr_b16 %0, %1 offset:%2" : "=&v"(r) : "v"(vb), "i"(OFF) : "memory"); return r;
}
template <int D0> __device__ __forceinline__ void pv_one(f32x16& od, int vb, bf16x8 pa0, bf16x8 pa1, bf16x8 pa2, bf16x8 pa3) {
  const s16x4 l0 = tr_read<v_rd_off(D0, 0, 0)>(vb), h0 = tr_read<v_rd_off(D0, 0, 1)>(vb), l1 = tr_read<v_rd_off(D0, 1, 0)>(vb), h1 = tr_read<v_rd_off(D0, 1, 1)>(vb);
  const s16x4 l2 = tr_read<v_rd_off(D0, 2, 0)>(vb), h2 = tr_read<v_rd_off(D0, 2, 1)>(vb), l3 = tr_read<v_rd_off(D0, 3, 0)>(vb), h3 = tr_read<v_rd_off(D0, 3, 1)>(vb);
  asm volatile("s_waitcnt lgkmcnt(0)" ::: "memory"); SBAR();
#define PK(L, H) (bf16x8){L[0], L[1], L[2], L[3], H[0], H[1], H[2], H[3]}
  od = __builtin_amdgcn_mfma_f32_32x32x16_bf16(pa0, PK(l0, h0), od, 0, 0, 0);
  od = __builtin_amdgcn_mfma_f32_32x32x16_bf16(pa1, PK(l1, h1), od, 0, 0, 0);
  od = __builtin_amdgcn_mfma_f32_32x32x16_bf16(pa2, PK(l2, h2), od, 0, 0, 0);
  od = __builtin_amdgcn_mfma_f32_32x32x16_bf16(pa3, PK(l3, h3), od, 0, 0, 0);
#undef PK
}
__device__ __forceinline__ void pv_d0(f32x16* o, int vb, bf16x8 pa0, bf16x8 pa1, bf16x8 pa2, bf16x8 pa3) {
  pv_one<0>(o[0], vb, pa0, pa1, pa2, pa3); pv_one<1>(o[1], vb, pa0, pa1, pa2, pa3); pv_one<2>(o[2], vb, pa0, pa1, pa2, pa3); pv_one<3>(o[3], vb, pa0, pa1, pa2, pa3);
}

template <int t>
__device__ __forceinline__ void attn_pass(const bf16* Qh, const bf16* __restrict__ Kh, const bf16* __restrict__ Vh, bf16* ONh, int q0, float lam, const float* gsub, float* stash, char* lds) {
  int tid = threadIdx.x; asm volatile("" : "+v"(tid));
  const int wid = tid >> 6, lane = tid & 63, r32 = lane & 31, hi = lane >> 5;
  char* V_lds = lds + OFF_V; char* K_lds = lds + OFF_K;
  float* ws = (float*)(lds + OFF_WS) + wid * 64; float* li_l = ws; float* al_l = ws + 32;
  bf16* stg = (bf16*)(lds + OFF_STG + wid * 8192);
  const int sr = tid >> 4, sc = (tid & 15) * 8, vst0 = v_st(sr, sc), vst1 = v_st(32 + sr, sc);
  const int kr = tid >> 3, kc = (tid & 7) * 8, kst = KSWZ64(kr, kc * 2);
  const int vb0 = (int)(uintptr_t)V_lds + v_rd_base(lane);
  constexpr int NT = SEQ / KVBLK;
  {
    const bf16* Kt = Kh + t * 64;
    float m_reg = -1e30f, l_reg = 0; f32x16 o[4] = {}; bf16x8 qr[4];
    const bf16* Qw = Qh + (long)(q0 + wid * QBLK + r32) * LD + t * 64 + hi * 8;
#pragma unroll
    for (int d0 = 0; d0 < 4; ++d0) qr[d0] = *reinterpret_cast<const bf16x8*>(Qw + d0 * 16);
    struct { bf16x8 vs0, vs1, ks0; } sr_[2];
#define SLOAD(i, k0) do { sr_[i].vs0 = *reinterpret_cast<const bf16x8*>(&Vh[(long)((k0) + sr) * LD + sc]); sr_[i].vs1 = *reinterpret_cast<const bf16x8*>(&Vh[(long)((k0) + 32 + sr) * LD + sc]); \
    sr_[i].ks0 = *reinterpret_cast<const bf16x8*>(&Kt[(long)((k0) + kr) * LD + kc]); } while (0)
#define SWRITE(b, i) do { *(bf16x8*)(V_lds + (b) * SHM_V + vst0) = sr_[i].vs0; *(bf16x8*)(V_lds + (b) * SHM_V + vst1) = sr_[i].vs1; \
    *(bf16x8*)(K_lds + (b) * SHM_K + kst) = sr_[i].ks0; } while (0)
#define SWAIT() asm volatile("s_waitcnt vmcnt(3)" ::: "memory")
#define RESC(a) do { if (__any((a) < 1.f)) { if (hi == 0) al_l[r32] = (a); asm volatile("s_waitcnt lgkmcnt(0)" ::: "memory"); \
    _Pragma("unroll") for (int d = 0; d < 4; ++d) _Pragma("unroll") for (int r = 0; r < 16; ++r) o[d][r] *= al_l[crow(r, hi)]; } } while (0)
    f32x16 pA0, pA1, pB0, pB1; float mnA, mnB, alA, alB; bf16x8 pa0, pa1, pa2, pa3;
    constexpr int SE = 0, SO = 1;
    SLOAD(SE, 0); asm volatile("s_waitcnt vmcnt(0)" ::: "memory"); SWRITE(0, SE); __syncthreads();
    qkt(pA0, pA1, K_lds, qr, r32, hi); partialSM(pA0, pA1, m_reg, mnA, alA);
    SLOAD(SO, KVBLK); SLOAD(SE, 2 * KVBLK);
    SWAIT(); SWRITE(1, SO); __syncthreads();
#pragma unroll 1
    for (int j = 1; j + 1 < NT; j += 2) {
      SBAR(); qkt(pB0, pB1, K_lds + SHM_K, qr, r32, hi);
      finishSM(pA0, pA1, alA, l_reg, pa0, pa1, pa2, pa3); SBAR();
      SLOAD(SO, (j + 2) * KVBLK); SBAR();
      pv_d0(o, vb0, pa0, pa1, pa2, pa3); partialSM(pB0, pB1, m_reg, mnB, alB);
      __syncthreads(); SWAIT(); SWRITE(0, SE);
      RESC(alB); __syncthreads();
      SBAR(); qkt(pA0, pA1, K_lds, qr, r32, hi);
      finishSM(pB0, pB1, alB, l_reg, pa0, pa1, pa2, pa3); SBAR();
      if (j + 3 < NT) SLOAD(SE, (j + 3) * KVBLK); SBAR();
      pv_d0(o, vb0 + SHM_V, pa0, pa1, pa2, pa3); partialSM(pA0, pA1, m_reg, mnA, alA);
      __syncthreads(); SWAIT(); SWRITE(1, SO);
      RESC(alA); __syncthreads();
    }
    SBAR(); qkt(pB0, pB1, K_lds + SHM_K, qr, r32, hi);
    finishSM(pA0, pA1, alA, l_reg, pa0, pa1, pa2, pa3); SBAR();
    pv_d0(o, vb0, pa0, pa1, pa2, pa3); partialSM(pB0, pB1, m_reg, mnB, alB);
    __syncthreads(); RESC(alB);
    finishSM(pB0, pB1, alB, l_reg, pa0, pa1, pa2, pa3); SBAR();
    pv_d0(o, vb0 + SHM_V, pa0, pa1, pa2, pa3);
#undef SLOAD
#undef SWRITE
#undef SWAIT
#undef RESC
    if (hi == 0) li_l[r32] = l_reg; asm volatile("s_waitcnt lgkmcnt(0)" ::: "memory");
    float rli[16];
#pragma unroll
    for (int r = 0; r < 16; ++r) rli[r] = __builtin_amdgcn_rcpf(li_l[crow(r, hi)]);
    GAS float* sp = (GAS float*)(stash + (size_t)wid * 4096 + lane);
    asm volatile("" : "+v"(sp));
    if (t == 0) {
#pragma unroll
      for (int r = 0; r < 16; ++r)
#pragma unroll
        for (int d0 = 0; d0 < 4; ++d0) sp[(d0 * 16 + r) * 64] = o[d0][r] * rli[r];
    } else {
      float gs[4];
#pragma unroll
      for (int d0 = 0; d0 < 4; ++d0) gs[d0] = gsub[d0 * 32 + r32] * 0.8f;
#pragma unroll
      for (int r = 0; r < 16; ++r) { float oc[4]; float ss = 0.f;
#pragma unroll
        for (int d0 = 0; d0 < 4; ++d0) { oc[d0] = sp[(d0 * 16 + r) * 64] - lam * (o[d0][r] * rli[r]); ss += oc[d0] * oc[d0]; }
        ss += __shfl_xor(ss, 1); ss += __shfl_xor(ss, 2); ss += __shfl_xor(ss, 4); ss += __shfl_xor(ss, 8); ss += __shfl_xor(ss, 16);
        const float rs = 1.f / sqrtf(ss * (1.f / 128.f) + EPS); const int orow = crow(r, hi);
#pragma unroll
        for (int d0 = 0; d0 < 4; ++d0) stg[orow * 128 + d0 * 32 + r32] = (bf16)f2bf(oc[d0] * rs * gs[d0]); }
      asm volatile("s_waitcnt lgkmcnt(0)" ::: "memory");
      bf16* Ow = ONh + (long)(q0 + wid * QBLK) * LD;
#pragma unroll
      for (int i = 0; i < 8; ++i) { const int row = i * 4 + (lane >> 4), ch = lane & 15; const v4u v = *(const v4u*)(stg + row * 128 + ch * 8); *(v4u*)(Ow + (long)row * LD + ch * 8) = v; }
      asm volatile("s_waitcnt lgkmcnt(0)" ::: "memory");
    }
  }
}
__device__ __forceinline__ void attn_unit(const bf16* Qh, const bf16* __restrict__ Kh, const bf16* __restrict__ Vh, bf16* ONh, int q0, float lam, const float* gsub, float* stash, char* lds) {
  attn_pass<0>(Qh, Kh, Vh, ONh, q0, lam, gsub, stash, lds);
  asm volatile("s_waitcnt vmcnt(0) lgkmcnt(0)" ::: "memory"); SBAR();
  attn_pass<1>(Qh, Kh, Vh, ONh, q0, lam, gsub, stash, lds);
  asm volatile("s_waitcnt vmcnt(0) lgkmcnt(0)" ::: "memory"); SBAR();
}
}

__device__ __forceinline__ void p6_rows(const Frame& F, const float* x, float* io, const float* g_post, const float* g_pre2, const float* mod, bf16* H2) {
    const int gw = F.vcu * NWAVES + F.wave, NGW = F.G * NWAVES;
    for (int m = gw; m < M; m += NGW) { const int b = m >> 12; const float* mb = mod + b * NMOD;
        GAS f32x4* mr = (GAS f32x4*)(io + (size_t)m * D) + F.lane; const GAS f32x4* xr = (const GAS f32x4*)(x + (size_t)m * D) + F.lane;
        f32x4 v[4], xv[4]; float ss = 0.f;
#pragma unroll
        for (int j = 0; j < 4; ++j) { v[j] = mr[64 * j]; xv[j] = xr[64 * j]; ss += (v[j].x * v[j].x + v[j].y * v[j].y) + (v[j].z * v[j].z + v[j].w * v[j].w); }
        const float rs = 1.f / sqrtf(wave_sum(ss) * (1.f / D) + EPS); float s2 = 0.f;
#pragma unroll
        for (int j = 0; j < 4; ++j) { const int col = 256 * j + 4 * F.lane;
            const f32x4 g = *(const f32x4*)(g_post + col), gt = *(const f32x4*)(mb + 2 * D + col);
            v[j] = xv[j] + gt * (v[j] * rs * g); mr[64 * j] = v[j];
            s2 += (v[j].x * v[j].x + v[j].y * v[j].y) + (v[j].z * v[j].z + v[j].w * v[j].w); }
        const float rs2 = 1.f / sqrtf(wave_sum(s2) * (1.f / D) + EPS);
        GAS v2u* o8 = (GAS v2u*)(H2 + (size_t)m * D) + F.lane;
#pragma unroll
        for (int j = 0; j < 4; ++j) { const int col = 256 * j + 4 * F.lane;
            const f32x4 g = *(const f32x4*)(g_pre2 + col), sh = *(const f32x4*)(mb + 3 * D + col), sc = *(const f32x4*)(mb + 4 * D + col);
            const f32x4 h = v[j] * rs2 * g * (sc + 1.f) + sh; v2u w; w.x = pk2(h.x, h.y); w.y = pk2(h.z, h.w); o8[64 * j] = w; }
    }
}

__device__ __forceinline__ float vmaxf(float a, float b) { float r; asm("v_max_f32_e32 %0, %1, %2" : "=v"(r) : "v"(a), "v"(b)); return r; }
__device__ __forceinline__ float vminf(float a, float b) { float r; asm("v_min_f32_e32 %0, %1, %2" : "=v"(r) : "v"(a), "v"(b)); return r; }
#define CE_DESC(a, b) do { const float _mx = vmaxf(a, b), _mn = vminf(a, b); a = _mx; b = _mn; } while (0)
__device__ __forceinline__ void sort16_desc(float (&v)[16]) {
#pragma unroll
    for (int k = 2; k <= 16; k <<= 1)
#pragma unroll
        for (int j = k >> 1; j > 0; j >>= 1)
#pragma unroll
            for (int i = 0; i < 16; ++i) { const int l = i ^ j; if (l > i) { if ((i & k) == 0) CE_DESC(v[i], v[l]); else CE_DESC(v[l], v[i]); } }
}
__device__ __forceinline__ void merge16_desc(float (&a)[16], const float (&b)[16]) {
#pragma unroll
    for (int i = 0; i < 16; ++i) a[i] = vmaxf(a[i], b[15 - i]);
#pragma unroll
    for (int j = 8; j > 0; j >>= 1)
#pragma unroll
        for (int i = 0; i < 16; ++i) { const int l = i ^ j; if (l > i) CE_DESC(a[i], a[l]); }
}
#define FILL_ROUND0 bt[0] = CAND(0, 0); bt[1] = CAND(0, 1); bt[2] = CAND(1, 0); bt[3] = CAND(0, 2); bt[4] = CAND(2, 0); bt[5] = CAND(1, 1); bt[6] = CAND(0, 3); bt[7] = CAND(3, 0); bt[8] = CAND(0, 4); bt[9] = CAND(4, 0); bt[10] = CAND(1, 2); bt[11] = CAND(2, 1); bt[12] = CAND(0, 5); bt[13] = CAND(5, 0); bt[14] = CAND(0, 6); bt[15] = CAND(6, 0);
#define FILL_ROUND1 bt[0] = CAND(1, 3); bt[1] = CAND(3, 1); bt[2] = CAND(0, 7); bt[3] = CAND(7, 0); bt[4] = CAND(2, 2); bt[5] = CAND(0, 8); bt[6] = CAND(8, 0); bt[7] = CAND(1, 4); bt[8] = CAND(4, 1); bt[9] = CAND(0, 9); bt[10] = CAND(9, 0); bt[11] = CAND(0, 10); bt[12] = CAND(10, 0); bt[13] = CAND(2, 3); bt[14] = CAND(3, 2); bt[15] = CAND(1, 5);
#define FILL_ROUND2 bt[0] = CAND(5, 1); bt[1] = CAND(0, 11); bt[2] = CAND(11, 0); bt[3] = CAND(0, 12); bt[4] = CAND(12, 0); bt[5] = CAND(1, 6); bt[6] = CAND(6, 1); bt[7] = CAND(0, 13); bt[8] = CAND(13, 0); bt[9] = CAND(2, 4); bt[10] = CAND(4, 2); bt[11] = CAND(0, 14); bt[12] = CAND(14, 0); bt[13] = CAND(3, 3); bt[14] = CAND(1, 7); bt[15] = CAND(7, 1);
#define FILL_ROUND3 bt[0] = CAND(0, 15); bt[1] = CAND(15, 0); bt[2] = NEG_INF; bt[3] = NEG_INF; bt[4] = NEG_INF; bt[5] = NEG_INF; bt[6] = NEG_INF; bt[7] = NEG_INF; bt[8] = NEG_INF; bt[9] = NEG_INF; bt[10] = NEG_INF; bt[11] = NEG_INF; bt[12] = NEG_INF; bt[13] = NEG_INF; bt[14] = NEG_INF; bt[15] = NEG_INF;
struct RouteArgs { const bf16* QP; const bf16* keys; int* IDX; float* GATE; };
__device__ __forceinline__ void p8_route(const Frame& F, const RouteArgs& a) {
    const int lane = F.lane, L31 = lane & 31, hh = lane >> 5, h = F.wave;
    LAS unsigned char* tab = F.lds + F.wave * 2048 + lane * 32;
    for (int tb = F.vcu; tb < M / 32; tb += F.G) {
        const int tok = tb * 32 + L31;
        float st[2][16];
#pragma unroll
        for (int t = 0; t < 2; ++t) {
            bf16x8 bq[8];
#pragma unroll
            for (int ks = 0; ks < 8; ++ks) bq[ks] = *(const GAS bf16x8*)(a.QP + (size_t)tok * NPQ + h * 256 + t * 128 + 16 * ks + 8 * hh);
            const bf16* kb = a.keys + (size_t)((h * 2 + t) * 128 + L31) * 128 + 8 * hh;
            float top[16];
#pragma unroll 1
            for (int nb = 0; nb < 4; ++nb) {
                f32x16 acc = {};
#pragma unroll
                for (int ks = 0; ks < 8; ++ks) { const bf16x8 af = *(const GAS bf16x8*)(kb + (size_t)nb * 32 * 128 + 16 * ks);
                    acc = __builtin_amdgcn_mfma_f32_32x32x16_bf16(af, bq[ks], acc, 0, 0, 0); }
                float bt[16];
#pragma unroll
                for (int r = 0; r < 16; ++r) bt[r] = __uint_as_float((__float_as_uint(acc[r]) & 0xFFFFFF80u) | (unsigned)(nb * 32 + crow(r, hh)));
                sort16_desc(bt);
                if (nb == 0) {
#pragma unroll
                    for (int r = 0; r < 16; ++r) top[r] = bt[r];
                } else merge16_desc(top, bt);
            }
            { float pt[16];
#pragma unroll
              for (int r = 0; r < 16; ++r) { auto rr = __builtin_amdgcn_permlane32_swap(__float_as_uint(top[r]), __float_as_uint(top[r]), false, false); pt[r] = __uint_as_float(hh ? rr[0] : rr[1]); }
              merge16_desc(top, pt); }
#pragma unroll
            for (int r = 0; r < 16; ++r) st[t][r] = top[r];
        }
        { unsigned w[8];
#pragma unroll
          for (int d = 0; d < 4; ++d) { w[d] = 0u; w[4 + d] = 0u;
#pragma unroll
              for (int k = 0; k < 4; ++k) { w[d] |= (__float_as_uint(st[0][4 * d + k]) & 0x7Fu) << (8 * k); w[4 + d] |= (__float_as_uint(st[1][4 * d + k]) & 0x7Fu) << (8 * k); } }
          *(LAS v4u*)(tab) = (v4u){w[0], w[1], w[2], w[3]}; *(LAS v4u*)(tab + 16) = (v4u){w[4], w[5], w[6], w[7]}; }
        float top[16], bt[16];
        const float NEG_INF = -__builtin_inff();
#define CAND(i, j) __uint_as_float((__float_as_uint(st[0][i] + st[1][j]) & 0xFFFFFF00u) | (unsigned)((i) * 16 + (j)))
        FILL_ROUND0 sort16_desc(bt);
#pragma unroll
        for (int r = 0; r < 16; ++r) top[r] = bt[r];
        FILL_ROUND1 sort16_desc(bt); merge16_desc(top, bt);
        FILL_ROUND2 sort16_desc(bt); merge16_desc(top, bt);
        FILL_ROUND3 sort16_desc(bt); merge16_desc(top, bt);
#undef CAND
        float e[16], es = 0.f;
#pragma unroll
        for (int r = 0; r < 16; ++r) { e[r] = __builtin_amdgcn_exp2f((top[r] - top[0]) * 1.4426950408889634f); es += e[r]; }
        const float inv = 1.f / es;
        LDS_WAIT();
        int ex[16];
#pragma unroll
        for (int r = 0; r < 16; ++r) { const unsigned cell = __float_as_uint(top[r]) & 0xFFu; const unsigned n0 = tab[cell >> 4], n1 = tab[16 + (cell & 15u)]; ex[r] = (int)(n0 * 128u + n1); e[r] *= inv; }
        int oi[8]; float og[8];
#pragma unroll
        for (int k = 0; k < 8; ++k) { oi[k] = hh ? ex[8 + k] : ex[k]; og[k] = hh ? e[8 + k] : e[k]; }
        int* ip = a.IDX + (size_t)tok * 128 + h * 16 + 8 * hh; float* gp = a.GATE + (size_t)tok * 128 + h * 16 + 8 * hh;
        *(GAS v4u*)ip = (v4u){(unsigned)oi[0], (unsigned)oi[1], (unsigned)oi[2], (unsigned)oi[3]}; *(GAS v4u*)(ip + 4) = (v4u){(unsigned)oi[4], (unsigned)oi[5], (unsigned)oi[6], (unsigned)oi[7]};
        *(GAS f32x4*)gp = (f32x4){og[0], og[1], og[2], og[3]}; *(GAS f32x4*)(gp + 4) = (f32x4){og[4], og[5], og[6], og[7]};
        LDS_WAIT(); asm volatile("" ::: "memory");
    }
}

#ifndef TBL_FP8
#define TBL_FP8 1
#endif
constexpr int NSL = TBL_FP8 ? 8 : 16, CW = D / NSL, ESZ = TBL_FP8 ? 1 : 2, ROWB = CW * ESZ, CPL = 16 / ESZ;
static_assert(ROWB == 128 && CPL * 8 == CW, "one cache line per (expert, slice) row, 8 lanes per row");
constexpr float U_SCALE = TBL_FP8 ? 1024.f : 1.f, V_SCALE = TBL_FP8 ? 16.f : 1.f;
__device__ __forceinline__ float dot2bf(unsigned a, unsigned b, float c) { return __builtin_amdgcn_fdot2_f32_bf16(__builtin_bit_cast(bf16x2_t, a), __builtin_bit_cast(bf16x2_t, b), c, false); }
__device__ __forceinline__ float dot8(const v4u a, const v4u b, float c) {
    c = dot2bf(a.x, b.x, c); c = dot2bf(a.y, b.y, c); c = dot2bf(a.z, b.z, c); c = dot2bf(a.w, b.w, c); return c;
}
__device__ __forceinline__ void cvt_table(const Frame& F, const float* src, unsigned char* dst, float scale) {
    const long gt = (long)(F.vcu * NWAVES + F.wave) * 64 + F.lane, NT = (long)F.G * NWAVES * 64, n8 = (long)NEXP * D / 8;
    for (long i = gt; i < n8; i += NT) { const long e = i >> 7; const int c0 = (int)(i & 127) * 8, s = c0 / CW, cc = c0 % CW;
        const f32x4 a = *(const GAS f32x4*)(src + i * 8), b = *(const GAS f32x4*)(src + i * 8 + 4);
        unsigned char* d = dst + ((size_t)s * NEXP + e) * ROWB + cc * ESZ;
#if TBL_FP8
        int w0 = 0, w1 = 0;
        w0 = __builtin_amdgcn_cvt_pk_fp8_f32(a[0] * scale, a[1] * scale, w0, false); w0 = __builtin_amdgcn_cvt_pk_fp8_f32(a[2] * scale, a[3] * scale, w0, true);
        w1 = __builtin_amdgcn_cvt_pk_fp8_f32(b[0] * scale, b[1] * scale, w1, false); w1 = __builtin_amdgcn_cvt_pk_fp8_f32(b[2] * scale, b[3] * scale, w1, true);
        *(GAS v2u*)d = (v2u){(unsigned)w0, (unsigned)w1};
#else
        (void)scale; v4u o; o.x = pk2(a[0], a[1]); o.y = pk2(a[2], a[3]); o.z = pk2(b[0], b[1]); o.w = pk2(b[2], b[3]); *(GAS v4u*)d = o;
#endif
    }
}
template <int CTRL> __device__ __forceinline__ float dpp_mov(float v) { return __builtin_bit_cast(float, __builtin_amdgcn_update_dpp(0, __builtin_bit_cast(int, v), CTRL, 0xF, 0xF, true)); }
#ifndef PEER_OPT
#define PEER_OPT 7
#endif
__device__ __forceinline__ float red8(float v) {
#if PEER_OPT & 1
    v += dpp_mov<0xB1>(v); v += dpp_mov<0x4E>(v); v += dpp_mov<0x141>(v); return v;
#else
    v += __shfl_xor(v, 1); v += __shfl_xor(v, 2); v += __shfl_xor(v, 4); return v;
#endif
}
__device__ __forceinline__ float red_groups(float v) {
#if !(PEER_OPT & 4)
    v += __shfl_xor(v, 8); v += __shfl_xor(v, 16); v += __shfl_xor(v, 32); return v;
#endif
    v += dpp_mov<0x128>(v);
    { unsigned a = __float_as_uint(v), b = a; asm volatile("" : "+v"(a), "+v"(b)); auto r = __builtin_amdgcn_permlane16_swap(a, b, false, false); v = __uint_as_float(r[0]) + __uint_as_float(r[1]); }
    { unsigned a = __float_as_uint(v), b = a; asm volatile("" : "+v"(a), "+v"(b)); auto r = __builtin_amdgcn_permlane32_swap(a, b, false, false); v = __uint_as_float(r[0]) + __uint_as_float(r[1]); }
    return v;
}
#if TBL_FP8
__device__ __forceinline__ void tbl_unpack2(const v4u w, f32x2 (&f)[8]) {
    f[0] = __builtin_amdgcn_cvt_pk_f32_fp8((int)w.x, false); f[1] = __builtin_amdgcn_cvt_pk_f32_fp8((int)w.x, true); f[2] = __builtin_amdgcn_cvt_pk_f32_fp8((int)w.y, false); f[3] = __builtin_amdgcn_cvt_pk_f32_fp8((int)w.y, true);
    f[4] = __builtin_amdgcn_cvt_pk_f32_fp8((int)w.z, false); f[5] = __builtin_amdgcn_cvt_pk_f32_fp8((int)w.z, true); f[6] = __builtin_amdgcn_cvt_pk_f32_fp8((int)w.w, false); f[7] = __builtin_amdgcn_cvt_pk_f32_fp8((int)w.w, true);
}
#endif
__device__ __forceinline__ void tbl_unpack(const v4u w, float (&f)[CPL]) {
#if TBL_FP8
#pragma unroll
    for (int i = 0; i < 4; ++i) { const unsigned x = i == 0 ? w.x : i == 1 ? w.y : i == 2 ? w.z : w.w;
        const f32x2 lo = __builtin_amdgcn_cvt_pk_f32_fp8((int)x, false), hi = __builtin_amdgcn_cvt_pk_f32_fp8((int)x, true);
        f[4 * i] = lo[0]; f[4 * i + 1] = lo[1]; f[4 * i + 2] = hi[0]; f[4 * i + 3] = hi[1]; }
#else
    f[0] = bflo(w.x); f[1] = bfhi(w.x); f[2] = bflo(w.y); f[3] = bfhi(w.y); f[4] = bflo(w.z); f[5] = bfhi(w.z); f[6] = bflo(w.w); f[7] = bfhi(w.w);
#endif
}
struct PeerArgs { const bf16* H2; const int* IDX; const float* GATE; const unsigned char* PU; const unsigned char* PV; float* PART; float* A; float* Y; float* io; const float* g_post2; const float* mod; };
__device__ __forceinline__ void pk_issue8(const unsigned char* tab, const v4u ia, const v4u ib, v4u (&w)[8]) {
    w[0] = *(const GAS v4u*)(tab + (size_t)ia.x * ROWB); w[1] = *(const GAS v4u*)(tab + (size_t)ia.y * ROWB); w[2] = *(const GAS v4u*)(tab + (size_t)ia.z * ROWB); w[3] = *(const GAS v4u*)(tab + (size_t)ia.w * ROWB);
    w[4] = *(const GAS v4u*)(tab + (size_t)ib.x * ROWB); w[5] = *(const GAS v4u*)(tab + (size_t)ib.y * ROWB); w[6] = *(const GAS v4u*)(tab + (size_t)ib.z * ROWB); w[7] = *(const GAS v4u*)(tab + (size_t)ib.w * ROWB);
}
__device__ __forceinline__ void p9_half(const v4u (&w)[8], const v4u h0, const v4u h1, float* val  ) {
#if TBL_FP8
    const f32x2 hp[8] = {{bflo(h0.x), bfhi(h0.x)}, {bflo(h0.y), bfhi(h0.y)}, {bflo(h0.z), bfhi(h0.z)}, {bflo(h0.w), bfhi(h0.w)}, {bflo(h1.x), bfhi(h1.x)}, {bflo(h1.y), bfhi(h1.y)}, {bflo(h1.z), bfhi(h1.z)}, {bflo(h1.w), bfhi(h1.w)}};
#pragma unroll
    for (int i = 0; i < 8; ++i) { f32x2 f[8]; tbl_unpack2(w[i], f);
        f32x2 s0 = f[0] * hp[0], s1 = f[1] * hp[1];
        s0 = f[2] * hp[2] + s0; s1 = f[3] * hp[3] + s1; s0 = f[4] * hp[4] + s0; s1 = f[5] * hp[5] + s1; s0 = f[6] * hp[6] + s0; s1 = f[7] * hp[7] + s1;
        const f32x2 t = s0 + s1; val[i] = red8(t.x + t.y) * (1.f / U_SCALE); }
#else
    (void)h1;
#pragma unroll
    for (int i = 0; i < 8; ++i) val[i] = red8(dot8(w[i], h0, 0.f));
#endif
}
__device__ __forceinline__ void p9_udots(const Frame& F, const PeerArgs& a) {
    const int lane = F.lane, sub = lane & 7, g8 = lane >> 3, label = F.vcu >> 5, rank = F.vcu & 31;
    constexpr int TS = 32 * NWAVES, NT = M / TS;
#pragma unroll 1
    for (int ps = 0; ps < NSL / 8; ++ps) {
        const int s = label + 8 * ps;
        const unsigned char* tab = a.PU + (size_t)s * NEXP * ROWB + sub * 16;
        float* part = a.PART + (size_t)label * M * 128;
        const int t0 = rank * NWAVES + F.wave;
        v4u wA[8], wB[8], ix0, ix1, ix2, ix3, h0, h1 = {0u, 0u, 0u, 0u}, n0, n1 = {0u, 0u, 0u, 0u};
        { const GAS v4u* ip = (const GAS v4u*)(a.IDX + (size_t)t0 * 128 + 16 * g8); ix0 = ip[0]; ix1 = ip[1]; ix2 = ip[2]; ix3 = ip[3]; }
        pk_issue8(tab, ix0, ix1, wA); pk_issue8(tab, ix2, ix3, wB);
        { const bf16* hp = a.H2 + (size_t)t0 * D + s * CW + sub * CPL; h0 = *(const GAS v4u*)hp; if (TBL_FP8) h1 = *(const GAS v4u*)(hp + 8); }
        { const GAS v4u* ip = (const GAS v4u*)(a.IDX + (size_t)(t0 + TS) * 128 + 16 * g8); ix0 = ip[0]; ix1 = ip[1]; ix2 = ip[2]; ix3 = ip[3]; }
#pragma unroll 1
        for (int k = 0; k < NT; ++k) { const int tk = t0 + k * TS, tn = (k + 1 < NT) ? tk + TS : tk, tnn = (k + 2 < NT) ? tk + 2 * TS : tk;
            float val[16];
            p9_half(wA, h0, h1, val); SBAR();
            pk_issue8(tab, ix0, ix1, wA); SBAR();
            p9_half(wB, h0, h1, val + 8); SBAR();
            pk_issue8(tab, ix2, ix3, wB); { const bf16* hp = a.H2 + (size_t)tn * D + s * CW + sub * CPL; n0 = *(const GAS v4u*)hp; if (TBL_FP8) n1 = *(const GAS v4u*)(hp + 8); }
            { const GAS v4u* ip = (const GAS v4u*)(a.IDX + (size_t)tnn * 128 + 16 * g8); ix0 = ip[0]; ix1 = ip[1]; ix2 = ip[2]; ix3 = ip[3]; } SBAR();
            if (sub == 0) { GAS f32x4* pp = (GAS f32x4*)(part + (size_t)tk * 128 + 16 * g8);
#pragma unroll
                for (int q = 0; q < 4; ++q) { f32x4 v = {val[4 * q], val[4 * q + 1], val[4 * q + 2], val[4 * q + 3]}; if (ps > 0) v += pp[q]; pp[q] = v; } }
            h0 = n0; h1 = n1;
        }
    }
}
__device__ __forceinline__ void p10_acomb(const Frame& F, const PeerArgs& a) {
    const long gt = (long)(F.vcu * NWAVES + F.wave) * 64 + F.lane, NT = (long)F.G * NWAVES * 64, n4 = (long)M * 128 / 4;
    for (long i = gt; i < n4; i += NT) { f32x4 s = *(const GAS f32x4*)(a.PART + i * 4);
#pragma unroll
        for (int j = 1; j < 8; ++j) s += *(const GAS f32x4*)(a.PART + (size_t)j * M * 128 + i * 4);
        const f32x4 g = *(const GAS f32x4*)(a.GATE + i * 4);
        *(GAS f32x4*)(a.A + i * 4) = (f32x4){gelu_tanh(s[0]) * g[0], gelu_tanh(s[1]) * g[1], gelu_tanh(s[2]) * g[2], gelu_tanh(s[3]) * g[3]}; }
}
__device__ __forceinline__ void p11_half(const v4u (&w)[8], const f32x4 aa, const f32x4 ab, float (&acc)[CPL]) {
#pragma unroll
    for (int i = 0; i < 8; ++i) { const float ai = i == 0 ? aa.x : i == 1 ? aa.y : i == 2 ? aa.z : i == 3 ? aa.w : i == 4 ? ab.x : i == 5 ? ab.y : i == 6 ? ab.z : ab.w;
#if TBL_FP8
        f32x2 f[8]; tbl_unpack2(w[i], f); const f32x2 a2 = {ai, ai};
#pragma unroll
        for (int c = 0; c < 8; ++c) { f32x2 t = {acc[2 * c], acc[2 * c + 1]}; t = f[c] * a2 + t; acc[2 * c] = t.x; acc[2 * c + 1] = t.y; }
#else
        float f[CPL]; tbl_unpack(w[i], f);
#pragma unroll
        for (int c = 0; c < CPL; ++c) acc[c] += ai * f[c];
#endif
    }
}
__device__ __forceinline__ void p11_vaxpy(const Frame& F, const PeerArgs& a) {
    const int lane = F.lane, sub = lane & 7, g8 = lane >> 3, label = F.vcu >> 5, rank = F.vcu & 31;
    constexpr int TS = 32 * NWAVES, NT = M / TS;
#pragma unroll 1
    for (int ps = 0; ps < NSL / 8; ++ps) {
        const int s = label + 8 * ps;
        const unsigned char* tab = a.PV + (size_t)s * NEXP * ROWB + sub * 16;
        const int t0 = rank * NWAVES + F.wave;
        v4u wA[8], wB[8], ix0, ix1, ix2, ix3; f32x4 a0, a1, a2, a3, m0, m1, m2, m3;
        { const GAS v4u* ip = (const GAS v4u*)(a.IDX + (size_t)t0 * 128 + 16 * g8); ix0 = ip[0]; ix1 = ip[1]; ix2 = ip[2]; ix3 = ip[3]; }
        pk_issue8(tab, ix0, ix1, wA); pk_issue8(tab, ix2, ix3, wB);
        { const GAS f32x4* ap = (const GAS f32x4*)(a.A + (size_t)t0 * 128 + 16 * g8); a0 = ap[0]; a1 = ap[1]; a2 = ap[2]; a3 = ap[3]; }
        { const GAS v4u* ip = (const GAS v4u*)(a.IDX + (size_t)(t0 + TS) * 128 + 16 * g8); ix0 = ip[0]; ix1 = ip[1]; ix2 = ip[2]; ix3 = ip[3]; }
        m0 = a0; m1 = a1; m2 = a2; m3 = a3;
#pragma unroll 1
        for (int k = 0; k < NT; ++k) { const int tk = t0 + k * TS, tn = (k + 1 < NT) ? tk + TS : tk, tnn = (k + 2 < NT) ? tk + 2 * TS : tk;
            float acc[CPL];
#pragma unroll
            for (int c = 0; c < CPL; ++c) acc[c] = 0.f;
            p11_half(wA, a0, a1, acc); SBAR();
            pk_issue8(tab, ix0, ix1, wA); SBAR();
            p11_half(wB, a2, a3, acc); SBAR();
            pk_issue8(tab, ix2, ix3, wB); { const GAS f32x4* ap = (const GAS f32x4*)(a.A + (size_t)tn * 128 + 16 * g8); m0 = ap[0]; m1 = ap[1]; m2 = ap[2]; m3 = ap[3]; }
            { const GAS v4u* ip = (const GAS v4u*)(a.IDX + (size_t)tnn * 128 + 16 * g8); ix0 = ip[0]; ix1 = ip[1]; ix2 = ip[2]; ix3 = ip[3]; } SBAR();
#pragma unroll
            for (int c = 0; c < CPL; ++c) acc[c] = red_groups(acc[c]) * (1.f / V_SCALE);
            if (g8 == 0) { GAS f32x4* yp = (GAS f32x4*)(a.Y + (size_t)tk * D + s * CW + sub * CPL);
#pragma unroll
                for (int q = 0; q < CPL / 4; ++q) yp[q] = (f32x4){acc[4 * q], acc[4 * q + 1], acc[4 * q + 2], acc[4 * q + 3]}; }
            a0 = m0; a1 = m1; a2 = m2; a3 = m3;
        }
    }
}
__device__ __forceinline__ void p12_final(const Frame& F, const PeerArgs& a) {
    const int gw = F.vcu * NWAVES + F.wave, NGW = F.G * NWAVES;
    for (int m = gw; m < M; m += NGW) { const int b = m >> 12; const float* gt2 = a.mod + b * NMOD + 5 * D;
        const GAS f32x4* yr = (const GAS f32x4*)(a.Y + (size_t)m * D) + F.lane; GAS f32x4* orow = (GAS f32x4*)(a.io + (size_t)m * D) + F.lane;
        f32x4 v[4]; float ss = 0.f;
#pragma unroll
        for (int j = 0; j < 4; ++j) { v[j] = yr[64 * j]; ss += (v[j].x * v[j].x + v[j].y * v[j].y) + (v[j].z * v[j].z + v[j].w * v[j].w); }
        const float rs = 1.f / sqrtf(wave_sum(ss) * (1.f / D) + EPS);
#pragma unroll
        for (int j = 0; j < 4; ++j) { const int col = 256 * j + 4 * F.lane; const f32x4 g = *(const f32x4*)(a.g_post2 + col), gt = *(const f32x4*)(gt2 + col);
            orow[64 * j] = orow[64 * j] + gt * (v[j] * rs * g); }
    }
}


#ifndef DBG_STOP
#define DBG_STOP 99
#endif
__device__ __forceinline__ void dbg_dump(const Frame& F, float* out, const bf16* b0, const bf16* b1, const bf16* b2, const bf16* b3, const bf16* b4) {
    const int gw = F.vcu * NWAVES + F.wave, NGW = F.G * NWAVES;
    for (int m = gw; m < M; m += NGW) {
#pragma unroll
        for (int j = 0; j < 4; ++j) { const size_t off = (size_t)m * D + 256 * j + 4 * F.lane; f32x4 s = {0.f, 0.f, 0.f, 0.f};
            const bf16* bs[5] = {b0, b1, b2, b3, b4};
#pragma unroll
            for (int k = 0; k < 5; ++k) if (bs[k]) { const v2u w = *(const GAS v2u*)(bs[k] + off); s += (f32x4){bflo(w.x), bfhi(w.x), bflo(w.y), bfhi(w.y)}; }
            *(GAS f32x4*)(out + off) = s; }
    }
}
struct Args { const void* in[26]; float* out; unsigned char* ws; int ph_lo, ph_hi; };
__global__ void __launch_bounds__(NWAVES * 64, 2) mk_fwd(Args args) {
    extern __shared__ __attribute__((aligned(16))) unsigned char lds[];
    Frame F;
    F.lds = (LAS unsigned char*)lds;
    F.tid = threadIdx.x; F.lane = F.tid & 63; F.wave = __builtin_amdgcn_readfirstlane(F.tid >> 6);
    F.G = gridDim.x; { const int bx = blockIdx.x; F.vcu = (F.G % 8 == 0) ? (bx % 8) * (F.G / 8) + bx / 8 : bx; }
    unsigned char* ws = args.ws;
    gu32* ctl = (gu32*)(ws + WS_CTL);
    volatile LAS unsigned* MISC = (volatile LAS unsigned*)(F.lds + MISC_OFF);
    for (int u = F.tid; u < (LDS_BYTES - LDSCTL_OFF) / 4; u += NWAVES * 64) ((LAS unsigned*)(F.lds + LDSCTL_OFF))[u] = 0u;
    __syncthreads();
    XcdBarrier bar; bar.bar = (unsigned*)(ctl + CW_BAR); bar.x = 0; bar.st = nullptr;
    if (N_LAUNCHES == 1) bar = xcd_barrier_post((unsigned*)(ctl + CW_BAR), MISC + 8);
#define GRID_BAR() do { if (N_LAUNCHES == 1) xcd_barrier(bar); } while (0)
    const int lo = args.ph_lo, hi = args.ph_hi;
#ifndef PH_MASK
#define PH_MASK 0x1FFF
#endif
#define IN(k) ((((PH_MASK) >> (k)) & 1) && (k) <= DBG_STOP && lo <= (k) && (k) < hi)
#define BOTH(k) (IN(k) && IN((k) + 1))
#ifndef REP_MASK
#define REP_MASK 0
#endif
#define NREP(k) ((((REP_MASK) >> (k)) & 1) ? 2 : 1)
    const float* x = (const float*)args.in[0]; const float* mod = (const float*)(ws + WS_MOD);
    float* out = args.out;
    bf16* GA = (bf16*)out; bf16* GG = (bf16*)out + (size_t)M * D;

    if (IN(0)) {
        P0Args a{(const float*)args.in[1], (const float*)args.in[3], (const float*)args.in[4], (const float*)args.in[7], (const float*)args.in[13], (const float*)args.in[18], (const float*)args.in[19],
                 (const float*)args.in[22], (const float*)args.in[23], (const float*)args.in[16], (const int*)args.in[2], ws};
        for (int rep = 0; rep < NREP(0); ++rep) p0_prologue(F, a); if (BOTH(0)) GRID_BAR();
    }
    if (IN(1)) { for (int rep = 0; rep < NREP(1); ++rep) p1_xn(F, x, (const float*)args.in[5], mod, (bf16*)(ws + WS_XN)); if (BOTH(1)) GRID_BAR(); }
    if (IN(2)) {
        pg8::Gemm g{(const bf16*)(ws + WS_XN), nullptr, (const bf16*)(ws + WS_WIN), nullptr, M, NIN, D}; pg8::StaticOrder S; S.init(M, NIN, F.G, (int)blockIdx.x);
        pg8::EpiInProj E{(bf16*)(ws + WS_Q), (bf16*)(ws + WS_K), (bf16*)(ws + WS_V), (bf16*)(ws + WS_U), (bf16*)(ws + WS_ZV), GA, GG, (const float*)(ws + WS_ROPE), (float*)(ws + WS_STATS)};
        for (int rep = 0; rep < NREP(2); ++rep) pg8::gemm_phase<pg8::EpiInProj, pg8::StaticOrder, true, true>(F.lds, g, S, E);
        if (BOTH(2)) GRID_BAR();
    }
    if (IN(3)) {
        GmlpArgs ga{(const bf16*)(ws + WS_ZV), (bf16*)(ws + WS_U), (const float*)(ws + WS_STATS), (const float*)args.in[14], (const float*)args.in[15], (const bf16*)(ws + WS_WSP), (const float*)args.in[17]};
#ifndef NO_GMLP
        p3_gmlp(F, ga);
#endif
        float lam;
        { const float* lq1 = (const float*)args.in[8]; const float* lk1 = (const float*)args.in[9]; const float* lq2 = (const float*)args.in[10]; const float* lk2 = (const float*)args.in[11];
          float s1 = 0.f, s2 = 0.f; for (int i = 0; i < 64; ++i) { s1 += lq1[i] * lk1[i]; s2 += lq2[i] * lk2[i]; }
          lam = __expf(s1) - __expf(s2) + 0.2f; }
        const bf16* Qb = (const bf16*)(ws + WS_Q); const bf16* Kb = (const bf16*)(ws + WS_K); const bf16* Vb = (const bf16*)(ws + WS_V);
        float* stash = (float*)(ws + WS_O0) + (size_t)blockIdx.x * 32768;
#ifndef NO_ATT
#ifndef ATT_VAR
#define ATT_VAR 0
#endif
        if (NREP(3) == 2)
        for (int uu = F.vcu; uu < 1024; uu += F.G) {
            const int bh = uu >> 4, qb = uu & 15, b = bh >> 3, h = bh & 7; const size_t ro = (size_t)b * SEQ * D + h * 128;
            att::attn_unit(Qb + ro, Kb + ro, Vb + ro, (bf16*)(ws + 424 * MiB) + ro, qb * 256, lam, (const float*)args.in[12], stash, (char*)lds); }
        for (int uu = F.vcu; uu < 1024; uu += F.G) {
            const int bh = uu >> 4, qb = uu & 15, b = bh >> 3, h = bh & 7; const size_t ro = (size_t)b * SEQ * D + h * 128;
            att::attn_unit(Qb + ro, Kb + ro, Vb + ro, (bf16*)(ws + WS_Q) + ro, qb * 256, lam, (const float*)args.in[12], stash, (char*)lds); }
#endif
        if (BOTH(3)) GRID_BAR();
    }
    if (IN(4)) {
        pg8::Gemm g{(const bf16*)(ws + WS_Q), (const bf16*)(ws + WS_U), (const bf16*)(ws + WS_WA), (const bf16*)(ws + WS_WG), M, D, D}; pg8::StaticOrder S; S.init(M, D, F.G, (int)blockIdx.x, 2);
        pg8::EpiMerge E{GA, GG, (float*)(ws + WS_T1), (bf16*)(ws + WS_MIXIN)};
        for (int rep = 0; rep < NREP(4); ++rep) pg8::gemm_phase<pg8::EpiMerge, pg8::StaticOrder, true, true>(F.lds, g, S, E);
        if (BOTH(4)) GRID_BAR();
    }
    if (IN(5)) {
        pg8::Gemm g{(const bf16*)(ws + WS_MIXIN), nullptr, (const bf16*)(ws + WS_WOUT), nullptr, M, D, D}; pg8::StaticOrder S; S.init(M, D, F.G, (int)blockIdx.x);
        pg8::EpiF32 E{out, D};
        for (int rep = 0; rep < NREP(5); ++rep) pg8::gemm_phase<pg8::EpiF32, pg8::StaticOrder, true, true>(F.lds, g, S, E);
        if (BOTH(5)) GRID_BAR();
    }
    if (IN(6)) {
        p6_rows(F, x, out, (const float*)args.in[6], (const float*)args.in[20], mod, (bf16*)(ws + WS_H2));
        cvt_table(F, (const float*)args.in[24], ws + WS_PU, U_SCALE);
        cvt_table(F, (const float*)args.in[25], ws + WS_PV, V_SCALE);
        if (BOTH(6)) GRID_BAR();
    }
    if (IN(7)) {
        pg8::Gemm g{(const bf16*)(ws + WS_H2), nullptr, (const bf16*)(ws + WS_WPQ), nullptr, M, NPQ, D}; pg8::StaticOrder S; S.init(M, NPQ, F.G, (int)blockIdx.x);
        pg8::EpiBf16<0> E{(bf16*)(ws + WS_QP), NPQ, nullptr, 0, 0, 1.f};
        for (int rep = 0; rep < NREP(7); ++rep) pg8::gemm_phase<pg8::EpiBf16<0>, pg8::StaticOrder, true, true>(F.lds, g, S, E);
        if (BOTH(7)) GRID_BAR();
    }
    if (IN(8)) { RouteArgs ra{(const bf16*)(ws + WS_QP), (const bf16*)(ws + WS_KEYS), (int*)(ws + WS_IDX), (float*)(ws + WS_GATE)}; for (int rep = 0; rep < NREP(8); ++rep) p8_route(F, ra); if (BOTH(8)) GRID_BAR(); }
    PeerArgs pa{(const bf16*)(ws + WS_H2), (const int*)(ws + WS_IDX), (const float*)(ws + WS_GATE), ws + WS_PU, ws + WS_PV, (float*)(ws + WS_PART), (float*)(ws + WS_A), (float*)(ws + WS_Y), out, (const float*)args.in[21], mod};
    if (IN(9)) { for (int rep = 0; rep < NREP(9); ++rep) p9_udots(F, pa); if (BOTH(9)) GRID_BAR(); }
    if (IN(10)) { for (int rep = 0; rep < NREP(10); ++rep) p10_acomb(F, pa); if (BOTH(10)) GRID_BAR(); }
    if (IN(11)) { for (int rep = 0; rep < NREP(11); ++rep) p11_vaxpy(F, pa); if (BOTH(11)) GRID_BAR(); }
    if (IN(12)) { p12_final(F, pa); }
    if (DBG_STOP < 9 && lo <= DBG_STOP && DBG_STOP < hi) {
        if (N_LAUNCHES == 1) GRID_BAR();
        if (N_LAUNCHES != 1) {   }
    }
    if (DBG_STOP < 9 && ((N_LAUNCHES == 1 && hi > DBG_STOP) || (N_LAUNCHES != 1 && lo == DBG_STOP + 1))) {
        if (DBG_STOP == 2) dbg_dump(F, out, GA, nullptr, nullptr, nullptr, nullptr);
        if (DBG_STOP == 3) dbg_dump(F, out, (const bf16*)(ws + WS_Q), (const bf16*)(ws + WS_U), nullptr, nullptr, nullptr);
        if (DBG_STOP == 4) dbg_dump(F, out, (const bf16*)(ws + WS_MIXIN), nullptr, nullptr, nullptr, nullptr);

        if (DBG_STOP == 7) dbg_dump(F, out, (const bf16*)(ws + WS_QP), (const bf16*)(ws + WS_QP) + (size_t)M * D, nullptr, nullptr, nullptr);
        if (DBG_STOP == 8) dbg_dump(F, out, (const bf16*)(ws + WS_IDX), (const bf16*)(ws + WS_GATE), nullptr, nullptr, nullptr);
    }
#undef IN
#undef BOTH
}

extern "C" void kernel_launch(void* const* d_in, const int* in_sizes, int n_in, void* d_out, int out_size, void* d_ws, size_t ws_size, hipStream_t stream) {
    static int grid = 0;
    if (grid == 0) {
        if (n_in != 26 || in_sizes[0] != M * D || out_size != M * D || ws_size < WS_END) { fprintf(stderr, "kernel_launch: shape/workspace mismatch (n_in %d, in0 %d, out %d, ws %zu, need %zu)\n", n_in, n_in > 0 ? in_sizes[0] : -1, out_size, ws_size, (size_t)WS_END); grid = -1; return; }
        int dev = 0, cus = 0, per_cu = 0;
        if (hipGetDevice(&dev) != hipSuccess || hipDeviceGetAttribute(&cus, hipDeviceAttributeMultiprocessorCount, dev) != hipSuccess) { grid = -1; return; }
        if (hipFuncSetAttribute((const void*)mk_fwd, hipFuncAttributeMaxDynamicSharedMemorySize, LDS_BYTES) != hipSuccess) { fprintf(stderr, "kernel_launch: hipFuncSetAttribute failed\n"); grid = -1; return; }
        if (hipOccupancyMaxActiveBlocksPerMultiprocessor(&per_cu, (const void*)mk_fwd, NWAVES * 64, LDS_BYTES) != hipSuccess || per_cu < 1) { fprintf(stderr, "kernel_launch: occupancy query says %d\n", per_cu); per_cu = 1; }
        (void)hipGetLastError();
        grid = cus;
        if (grid % 8 != 0 || grid > 256) fprintf(stderr, "kernel_launch: note: grid %d\n", grid);
    }
    if (grid < 0) return;
    if (hipMemsetAsync((char*)d_ws + WS_CTL, 0, CTL_ZERO_BYTES, stream) != hipSuccess) { fprintf(stderr, "kernel_launch: memset failed\n"); return; }
    Args a{};
    for (int i = 0; i < 26; ++i) a.in[i] = d_in[i];
    a.out = (float*)d_out; a.ws = (unsigned char*)d_ws;
    for (int li = 0; li < N_LAUNCHES; ++li) {
        a.ph_lo = (N_LAUNCHES == 1) ? 0 : li; a.ph_hi = (N_LAUNCHES == 1) ? NPHASE : li + 1;
        hipLaunchKernelGGL(mk_fwd, dim3(grid), dim3(NWAVES * 64), LDS_BYTES, stream, a);
        const hipError_t le = hipPeekAtLastError();
        if (le != hipSuccess) { fprintf(stderr, "kernel_launch: launch %d failed: %s\n", li, hipGetErrorName(le)); break; }
    }
}
```

```cpp
#include <hip/hip_runtime.h>
#include <cstdio>
#include <cstdint>
namespace pg8 {
#define PG8_LAS __attribute__((address_space(3)))
typedef unsigned short bf16_t;
typedef short bf16x8 __attribute__((ext_vector_type(8)));
typedef float f32x4 __attribute__((ext_vector_type(4)));
typedef unsigned u32x4 __attribute__((ext_vector_type(4)));
constexpr int BM = 256, BK = 64, HALF = 128, HTB = HALF * BK * 2  , STAGE_BYTES = 8 * HTB, NXCD = 8, WGM = 8;

__host__ __device__ __forceinline__ int lds_byte(int r, int c) { const int st = (r >> 4) * 2 + (c >> 5), rr = r & 15, cc = c & 31, ob = rr * 64 + cc * 2; return st * 1024 + (ob ^ (((ob >> 9) & 1) << 5)); }
__host__ __device__ __forceinline__ void stage_rc(int b, int& R, int& C) { const int st = b / 1024, sb = b % 1024, swz = sb ^ (((sb >> 9) & 1) << 5); R = (st >> 1) * 16 + swz / 64; C = (st & 1) * 32 + (swz % 64) / 2; }
__host__ __device__ __forceinline__ int perm32(int rho) { const int n = rho >> 4, i = rho & 15; return 8 * (i >> 2) + 4 * n + (i & 3); }

struct Unit { int pm, pn, w; };
struct Gemm { const bf16_t* A0; const bf16_t* A1; const bf16_t* B0; const bf16_t* B1; int M, N, K; };

struct StaticOrder {
    int nM, nN, nwg, G, c, passes;
    __host__ __device__ void init(int M, int N, int G_, int c_, int passes_ = 1) { nM = M / BM; nN = N / BM; nwg = nM * nN; G = G_; c = c_; passes = passes_; }
    __host__ __device__ bool next(int i, Unit& u) const {
        const int ti = (passes == 2) ? (i >> 1) : i; u.w = (passes == 2) ? (i & 1) : 0;
        const long L = (long)ti * G + c; if (L >= nwg) return false;
        int wgid = (int)L; { const int q = nwg / NXCD, r = nwg % NXCD, xcd = wgid % NXCD, off = wgid / NXCD; wgid = (xcd < r ? xcd * (q + 1) : r * (q + 1) + (xcd - r) * q) + off; }
        const int nig = WGM * nN, gid = wgid / nig, fm = gid * WGM, gsz = (nM - fm) < WGM ? (nM - fm) : WGM;
        u.pm = fm + ((wgid % nig) % gsz); u.pn = (wgid % nig) / gsz; return true;
    }
    __device__ __forceinline__ void a_ready(const Unit&) const {}
    __device__ __forceinline__ void done(const Unit&) const {}
};

typedef float f32x2c __attribute__((ext_vector_type(2))); typedef __bf16 bf16x2c __attribute__((ext_vector_type(2)));
__device__ __forceinline__ unsigned cvt_pk_bf16(float lo, float hi) { f32x2c v = {lo, hi}; bf16x2c b = __builtin_convertvector(v, bf16x2c); return __builtin_bit_cast(unsigned, b); }
typedef float f32x2 __attribute__((ext_vector_type(2)));
__device__ __forceinline__ f32x2 gelu_pk(f32x2 v) {
    const f32x2 av = __builtin_elementwise_abs(v), d = av * 0.2316418882f + 1.0f;
    f32x2 t; t.x = __builtin_amdgcn_rcpf(d.x); t.y = __builtin_amdgcn_rcpf(d.y);
    f32x2 q = t * 0.5307027145f + (-0.7265760135f); q = q * t + 0.7107068705f; q = q * t + (-0.142248368f); q = q * t + 0.127414796f; q = q * t;
    const f32x2 s = (v * v) * (-0.72134752044f);
    f32x2 e; e.x = __builtin_amdgcn_exp2f(s.x); e.y = __builtin_amdgcn_exp2f(s.y);
    const f32x2 m = v * (q * e), r = v - m;
    f32x2 o; o.x = v.x < 0.f ? m.x : r.x; o.y = v.y < 0.f ? m.y : r.y; return o;
}

template <int ACT  > struct EpiBf16 {
    static constexpr bool PERM = true, AFTER_DRAIN = false; static_assert(ACT == 0 || ACT == 1, "EpiBf16: ACT is 0 (none) or 1 (gelu_pk)");
    bf16_t* O; int ldc; const float* bias; int split_cols; size_t split_stride; float scale0;
    __device__ __forceinline__ void operator()(const f32x4 (&acc)[2][2][4][2], const Unit& u, int wr, int wc, int fr, int fq) const {
        const int row0 = u.pm * BM + wr * 64 + fr; int colt = u.pn * BM; bf16_t* base = O;
        float sc = 1.f; if (split_cols) { const int t = colt / split_cols; base += (size_t)t * split_stride; colt -= t * split_cols; if (t == 0) sc = scale0; }
        const int col0 = colt + wc * 32 + 8 * fq, bcol0 = u.pn * BM + wc * 32 + 8 * fq;
        f32x4 bv[2][2];
#pragma unroll
        for (int bj = 0; bj < 2; ++bj)
#pragma unroll
            for (int n = 0; n < 2; ++n) bv[bj][n] = bias ? *(const f32x4*)(bias + bcol0 + bj * HALF + 4 * n) : (f32x4){0.f, 0.f, 0.f, 0.f};
#pragma unroll
        for (int ai = 0; ai < 2; ++ai)
#pragma unroll
            for (int m = 0; m < 4; ++m) { bf16_t* rowp = base + (size_t)(row0 + ai * HALF + m * 16) * ldc + col0;
#pragma unroll
                for (int bj = 0; bj < 2; ++bj) { f32x4 v0 = acc[ai][bj][m][0] + bv[bj][0], v1 = acc[ai][bj][m][1] + bv[bj][1];
                    if (ACT == 1) { f32x2 a = gelu_pk((f32x2){v0[0], v0[1]}), b = gelu_pk((f32x2){v0[2], v0[3]}), c = gelu_pk((f32x2){v1[0], v1[1]}), d = gelu_pk((f32x2){v1[2], v1[3]});
                        v0 = (f32x4){a.x, a.y, b.x, b.y}; v1 = (f32x4){c.x, c.y, d.x, d.y}; }
                    v0 = v0 * sc; v1 = v1 * sc; u32x4 w; w.x = cvt_pk_bf16(v0[0], v0[1]); w.y = cvt_pk_bf16(v0[2], v0[3]); w.z = cvt_pk_bf16(v1[0], v1[1]); w.w = cvt_pk_bf16(v1[2], v1[3]);
                    *(u32x4*)(rowp + bj * HALF) = w; } }
    }
};

template <class Epi, class Sched, bool ALIGN_EPI = false, bool SP2 = false>
__device__ __forceinline__ void gemm_phase(PG8_LAS unsigned char* lds, const Gemm g, const Sched& S, const Epi& E) {
    const int tid = threadIdx.x, wid = __builtin_amdgcn_readfirstlane(tid >> 6), lane = tid & 63, wr = wid >> 2, wc = wid & 3, fr = lane & 15, fq = lane >> 4;
    const int K = g.K, nt = K / BK;
    unsigned voffA[2], voffB[2];
#pragma unroll
    for (int i = 0; i < 2; ++i) { int R, C; stage_rc(tid * 16 + i * 8192, R, C); const int Rb = Epi::PERM ? ((R & ~31) + perm32(R & 31)) : R;
        voffA[i] = (unsigned)(R * K + C) * 2u; voffB[i] = (unsigned)(Rb * K + C) * 2u; }
    const size_t kstep = (size_t)(BK * 2);
    const size_t hstep = (size_t)HALF * K * 2;
    const size_t tstep = 2 * hstep;
    const unsigned ldsw = (unsigned)wid * 1024u;
    const int aoff = lds_byte(wr * 64 + fr, fq * 8), boff = lds_byte(wc * 32 + fr, fq * 8);
#define PG8_SA(b, h) (((b) * 2 + (h)) * HTB)
#define PG8_SB(b, h) ((4 + (b) * 2 + (h)) * HTB)
#define PG8_STAGE(bufoff, gbase, voff) do { _Pragma("unroll") for (int _i = 0; _i < 2; ++_i) \
        __builtin_amdgcn_global_load_lds((const unsigned*)((const char*)(gbase) + (voff)[_i]), (PG8_LAS unsigned*)(lds + (bufoff) + ldsw + _i * 8192), 16, 0, 0); } while (0)
#define PG8_LDA(dst, b, h) do { _Pragma("unroll") for (int m = 0; m < 4; ++m) _Pragma("unroll") for (int k = 0; k < 2; ++k) dst[m][k] = *(const PG8_LAS bf16x8*)(lds + PG8_SA(b, h) + aoff + m * 2048 + k * 1024); } while (0)
#define PG8_LDB(dst, b, h) do { _Pragma("unroll") for (int n = 0; n < 2; ++n) _Pragma("unroll") for (int k = 0; k < 2; ++k) dst[n][k] = *(const PG8_LAS bf16x8*)(lds + PG8_SB(b, h) + boff + n * 2048 + k * 1024); } while (0)
#define PG8_MMA(ai, bj, At, Bt) do { __builtin_amdgcn_s_setprio(1); _Pragma("unroll") for (int m = 0; m < 4; ++m) _Pragma("unroll") for (int n = 0; n < 2; ++n) _Pragma("unroll") for (int k = 0; k < 2; ++k) \
        acc[ai][bj][m][n] = __builtin_amdgcn_mfma_f32_16x16x32_bf16(Bt[n][k], At[m][k], acc[ai][bj][m][n], 0, 0, 0); __builtin_amdgcn_s_setprio(0); } while (0)
#define PG8_WAIT_V(n) asm volatile("s_waitcnt vmcnt(" #n ")" ::: "memory")
#define PG8_WAIT_L(n) asm volatile("s_waitcnt lgkmcnt(" #n ")" ::: "memory")
#define PG8_BAR __builtin_amdgcn_s_barrier()
#define PG8_SCHED __builtin_amdgcn_sched_barrier(0)
    Unit cur, nxt; int ui = 0;
    if (!S.next(0, cur)) return;
    f32x4 acc[2][2][4][2];
#pragma unroll
    for (int a = 0; a < 2; ++a)
#pragma unroll
        for (int b = 0; b < 2; ++b)
#pragma unroll
            for (int m = 0; m < 4; ++m)
#pragma unroll
                for (int n = 0; n < 2; ++n) acc[a][b][m][n] = (f32x4){0.f, 0.f, 0.f, 0.f};
    bf16x8 At[4][2], B0[2][2], B1[2][2];
    const char* cA = (const char*)(cur.w ? g.A1 : g.A0) + (size_t)cur.pm * tstep; const char* cB = (const char*)(cur.w ? g.B1 : g.B0) + (size_t)cur.pn * tstep;
    S.a_ready(cur);
    if constexpr (SP2) {
        PG8_STAGE(PG8_SB(0, 0), cB, voffB); PG8_STAGE(PG8_SB(0, 1), cB + hstep, voffB); PG8_STAGE(PG8_SA(0, 0), cA, voffA); PG8_STAGE(PG8_SA(0, 1), cA + hstep, voffA);
        if (wr == 1) PG8_BAR;
        PG8_WAIT_V(2); PG8_BAR;
        PG8_STAGE(PG8_SB(1, 0), cB + kstep, voffB); PG8_STAGE(PG8_SA(1, 0), cA + kstep, voffA); PG8_STAGE(PG8_SB(1, 1), cB + hstep + kstep, voffB);
        PG8_WAIT_V(6); PG8_BAR;
    } else {
        PG8_STAGE(PG8_SB(0, 0), cB, voffB); PG8_STAGE(PG8_SA(0, 0), cA, voffA); PG8_STAGE(PG8_SB(0, 1), cB + hstep, voffB); PG8_STAGE(PG8_SA(0, 1), cA + hstep, voffA);
        if (wr == 1) PG8_BAR;
        PG8_WAIT_V(4); PG8_BAR;
        PG8_STAGE(PG8_SB(1, 0), cB + kstep, voffB); PG8_STAGE(PG8_SA(1, 0), cA + kstep, voffA); PG8_STAGE(PG8_SB(1, 1), cB + hstep + kstep, voffB);
        PG8_WAIT_V(6); PG8_BAR;
    }
    for (;;) {
        const bool has_next = S.next(ui + 1, nxt);
        const char* nA = has_next ? (const char*)(nxt.w ? g.A1 : g.A0) + (size_t)nxt.pm * tstep : cA; const char* nB = has_next ? (const char*)(nxt.w ? g.B1 : g.B0) + (size_t)nxt.pn * tstep : cB;
        for (int t = 0; t < nt; t += 2) {
            const bool last = (t == nt - 2);
            const char* a1 = cA + (size_t)(t + 1) * kstep;
            const char* a2 = last ? nA : cA + (size_t)(t + 2) * kstep; const char* b2 = last ? nB : cB + (size_t)(t + 2) * kstep;
            const char* a3 = a2 + kstep; const char* b3 = b2 + kstep;
            if (last && has_next) S.a_ready(nxt);
            if constexpr (SP2) {
            PG8_LDB(B0, 0, 0); PG8_LDB(B1, 0, 1); PG8_SCHED; PG8_LDA(At, 0, 0); PG8_STAGE(PG8_SA(1, 1), a1 + hstep, voffA);
            PG8_WAIT_V(8); PG8_WAIT_L(0); PG8_BAR; PG8_MMA(0, 0, At, B0); PG8_MMA(0, 1, At, B1); PG8_BAR; PG8_SCHED;
            PG8_LDA(At, 0, 1); PG8_STAGE(PG8_SB(0, 0), b2, voffB); PG8_STAGE(PG8_SB(0, 1), b2 + hstep, voffB); PG8_STAGE(PG8_SA(0, 0), a2, voffA);
            PG8_WAIT_V(8); PG8_WAIT_L(0); PG8_BAR; PG8_MMA(1, 0, At, B0); PG8_MMA(1, 1, At, B1); PG8_BAR; PG8_SCHED;
            PG8_LDB(B0, 1, 0); PG8_LDB(B1, 1, 1); PG8_SCHED; PG8_LDA(At, 1, 0); PG8_STAGE(PG8_SA(0, 1), a2 + hstep, voffA);
            PG8_WAIT_V(8); PG8_WAIT_L(0); PG8_BAR; PG8_MMA(0, 0, At, B0); PG8_MMA(0, 1, At, B1); PG8_BAR; PG8_SCHED;
            PG8_LDA(At, 1, 1); PG8_STAGE(PG8_SB(1, 0), b3, voffB); PG8_STAGE(PG8_SB(1, 1), b3 + hstep, voffB); PG8_STAGE(PG8_SA(1, 0), a3, voffA);
            PG8_WAIT_V(8); PG8_WAIT_L(0); PG8_BAR; PG8_MMA(1, 0, At, B0); PG8_MMA(1, 1, At, B1); PG8_BAR; PG8_SCHED;
            } else {
            PG8_LDB(B0, 0, 0); PG8_SCHED; PG8_LDA(At, 0, 0); PG8_STAGE(PG8_SA(1, 1), a1 + hstep, voffA);
            PG8_WAIT_L(8); PG8_BAR; PG8_WAIT_L(0); PG8_MMA(0, 0, At, B0); PG8_BAR; PG8_SCHED;
            PG8_LDB(B1, 0, 1); PG8_STAGE(PG8_SB(0, 0), b2, voffB);
            PG8_BAR; PG8_WAIT_L(0); PG8_MMA(0, 1, At, B1); PG8_BAR;
            PG8_LDA(At, 0, 1); PG8_STAGE(PG8_SA(0, 0), a2, voffA);
            PG8_BAR; PG8_WAIT_L(0); PG8_MMA(1, 0, At, B0); PG8_BAR; PG8_SCHED;
            PG8_STAGE(PG8_SB(0, 1), b2 + hstep, voffB);
            PG8_WAIT_V(6); PG8_BAR; PG8_MMA(1, 1, At, B1); PG8_BAR;
            PG8_LDB(B0, 1, 0); PG8_SCHED; PG8_LDA(At, 1, 0); PG8_STAGE(PG8_SA(0, 1), a2 + hstep, voffA);
            PG8_WAIT_L(8); PG8_BAR; PG8_WAIT_L(0); PG8_MMA(0, 0, At, B0); PG8_BAR; PG8_SCHED;
            PG8_LDB(B1, 1, 1); PG8_STAGE(PG8_SB(1, 0), b3, voffB);
            PG8_BAR; PG8_WAIT_L(0); PG8_MMA(0, 1, At, B1); PG8_BAR;
            PG8_LDA(At, 1, 1); PG8_STAGE(PG8_SA(1, 0), a3, voffA);
            PG8_BAR; PG8_WAIT_L(0); PG8_MMA(1, 0, At, B0); PG8_BAR; PG8_SCHED;
            PG8_STAGE(PG8_SB(1, 1), b3 + hstep, voffB);
            PG8_WAIT_V(6); PG8_BAR; PG8_MMA(1, 1, At, B1); PG8_BAR;
            }
        }
        if constexpr (ALIGN_EPI) { if (wr == 0) PG8_BAR; }
        if constexpr (!Epi::AFTER_DRAIN) { E(acc, cur, wr, wc, fr, fq); S.done(cur); }
        if (!has_next) break;
#pragma unroll
        for (int a = 0; a < 2; ++a)
#pragma unroll
            for (int b = 0; b < 2; ++b)
#pragma unroll
                for (int m = 0; m < 4; ++m)
#pragma unroll
                    for (int n = 0; n < 2; ++n) acc[a][b][m][n] = (f32x4){0.f, 0.f, 0.f, 0.f};
        cur = nxt; cA = nA; cB = nB; ++ui;
        if constexpr (ALIGN_EPI) { if (wr == 1) PG8_BAR; }
    }
    PG8_WAIT_V(0);
    if constexpr (!ALIGN_EPI) { if (wr == 0) PG8_BAR; }
    PG8_BAR;
    if constexpr (Epi::AFTER_DRAIN) { E.fused(acc, cur, wr, wc, fr, fq, lds, wid, lane); S.done(cur); }
#undef PG8_SA
#undef PG8_SB
#undef PG8_STAGE
#undef PG8_LDA
#undef PG8_LDB
#undef PG8_MMA
#undef PG8_WAIT_V
#undef PG8_WAIT_L
#undef PG8_BAR
#undef PG8_SCHED
}
}

constexpr int BATCH = 8, SEQ = 4096, D = 1024, M = BATCH * SEQ, NIN = 7168, NMOD = 6 * D, NEXP = 16384, NPQ = 2048;
constexpr float EPS = 1e-6f;
constexpr int NWAVES = 8;
#ifndef MK_N_LAUNCHES
#define MK_N_LAUNCHES 1
#endif
#define DBG_STOP 99
#define PEER_OPT 7
constexpr int NPHASE = 13;
constexpr int N_LAUNCHES = MK_N_LAUNCHES;

constexpr size_t MiB = 1u << 20;
constexpr size_t WS_CTL = 0, CTL_ZERO_BYTES = 2 * MiB;
constexpr size_t WS_MOD = 1 * MiB;
constexpr size_t WS_ROPE = 2 * MiB;
constexpr size_t WS_STATS = 4 * MiB;
constexpr size_t WS_WIN = 8 * MiB, WS_WA = 22 * MiB, WS_WG = 24 * MiB, WS_WOUT = 26 * MiB, WS_WPQ = 28 * MiB, WS_KEYS = 32 * MiB, WS_WSP = 33 * MiB;
constexpr size_t WS_XN = 40 * MiB, WS_Q = 104 * MiB, WS_K = 168 * MiB, WS_V = 232 * MiB, WS_U = 296 * MiB, WS_ZV = 360 * MiB, WS_END = 424 * MiB;
constexpr size_t WS_O0 = WS_XN;
constexpr size_t WS_T1 = WS_K;
constexpr size_t WS_MIXIN = WS_ZV;
constexpr size_t WS_H2 = WS_XN;
constexpr size_t WS_QP = WS_K;
constexpr size_t WS_IDX = WS_U, WS_GATE = WS_U + 16 * MiB;
constexpr size_t WS_PU = WS_Q, WS_PV = WS_Q + 32 * MiB;
constexpr size_t WS_PART = WS_K;
constexpr size_t WS_A = WS_U + 32 * MiB;
constexpr size_t WS_Y = WS_K;
constexpr int CW_TMO = 0, CW_BAR = 4096;

constexpr int RING_BYTES = 131072, LDSCTL_OFF = RING_BYTES, MISC_OFF = LDSCTL_OFF + 320, LDS_BYTES = 147456;

#define GAS __attribute__((address_space(1)))
#define LAS __attribute__((address_space(3)))
typedef unsigned short bf16;
typedef unsigned v4u __attribute__((ext_vector_type(4)));
typedef unsigned v2u __attribute__((ext_vector_type(2)));
typedef float f32x4 __attribute__((ext_vector_type(4)));
typedef float f32x2 __attribute__((ext_vector_type(2)));
typedef float f32x16 __attribute__((ext_vector_type(16)));
typedef short bf16x8 __attribute__((ext_vector_type(8)));
typedef short s16x4 __attribute__((ext_vector_type(4)));
typedef __bf16 bf16x2_t __attribute__((ext_vector_type(2)));
typedef GAS unsigned gu32;
#define RLX_AGENT __ATOMIC_RELAXED, __HIP_MEMORY_SCOPE_AGENT
#define LDS_WAIT() asm volatile("s_waitcnt lgkmcnt(0)" ::: "memory")
#define VM_WAIT() asm volatile("s_waitcnt vmcnt(0)" ::: "memory")
#define SBAR() __builtin_amdgcn_sched_barrier(0)
__device__ __forceinline__ unsigned f2bf(float f) { unsigned u = __builtin_bit_cast(unsigned, f); return (u + 0x7fffu + ((u >> 16) & 1u)) >> 16; }
__device__ __forceinline__ unsigned pk2(float lo, float hi) { f32x2 v = {lo, hi}; bf16x2_t b = __builtin_convertvector(v, bf16x2_t); return __builtin_bit_cast(unsigned, b); }
__device__ __forceinline__ float bflo(unsigned w) { return __builtin_bit_cast(float, w << 16); }
__device__ __forceinline__ float bfhi(unsigned w) { return __builtin_bit_cast(float, w & 0xffff0000u); }
__device__ __forceinline__ float gelu_tanh(float x) {
    const float u = x * (0.7978845608f + 0.035677408137f * x * x);
    const float e = __builtin_amdgcn_exp2f(-2.885390081777927f * u);
    return x * __builtin_amdgcn_rcpf(1.f + e);
}
__device__ __forceinline__ float sigmoidf_(float x) { return __builtin_amdgcn_rcpf(1.f + __builtin_amdgcn_exp2f(-1.4426950408889634f * x)); }
__device__ __forceinline__ float wave_sum(float v) {
#pragma unroll
    for (int o = 1; o < 64; o <<= 1) v += __shfl_xor(v, o);
    return v;
}
__device__ __forceinline__ int crow(int r, int hi) { return (r & 3) + 8 * (r >> 2) + 4 * hi; }


namespace pg8 {
typedef float f32x2e __attribute__((ext_vector_type(2)));
__device__ __forceinline__ float bf_lo(unsigned w) { return __builtin_bit_cast(float, w << 16); }
__device__ __forceinline__ float bf_hi(unsigned w) { return __builtin_bit_cast(float, w & 0xffff0000u); }
__device__ __forceinline__ float gelu_t(float x) { const float u = x * (0.7978845608f + 0.035677408137f * x * x); const float e = __builtin_amdgcn_exp2f(-2.885390081777927f * u); return x * __builtin_amdgcn_rcpf(1.f + e); }
__device__ __forceinline__ float sigm(float x) { return __builtin_amdgcn_rcpf(1.f + __builtin_amdgcn_exp2f(-1.4426950408889634f * x)); }
__device__ __forceinline__ u32x4 pack8(const f32x4& a, const f32x4& b) { u32x4 w; w.x = cvt_pk_bf16(a[0], a[1]); w.y = cvt_pk_bf16(a[2], a[3]); w.z = cvt_pk_bf16(b[0], b[1]); w.w = cvt_pk_bf16(b[2], b[3]); return w; }

struct EpiInProj {
    static constexpr bool PERM = true, AFTER_DRAIN = false;
    bf16_t* Q; bf16_t* K; bf16_t* V; bf16_t* U; bf16_t* ZV; bf16_t* GA; bf16_t* GG; const float* rope; float* stats;
    __device__ __forceinline__ void operator()(const f32x4 (&acc)[2][2][4][2], const Unit& u, int wr, int wc, int fr, int fq) const {
        const int ty = u.pn >> 2;
        const int row0 = u.pm * BM + wr * 64 + fr;
        const int cc0 = (u.pn & 3) * BM + wc * 32 + 8 * fq;
        bf16_t* base = ty == 0 ? Q : ty == 1 ? K : ty == 2 ? V : ty == 3 ? U : ty == 4 ? ZV : ty == 5 ? GA : GG;
        if (ty <= 1) {
            const bool even = (wc & 1) == 0;
            const bool part = even && fq < 2;
            const float sg = (fq == 0) ? -1.f : 1.f;
#pragma unroll
            for (int ai = 0; ai < 2; ++ai)
#pragma unroll
                for (int m = 0; m < 4; ++m) {
                    const int row = row0 + ai * HALF + m * 16;
                    f32x4 c0 = {1.f, 1.f, 1.f, 1.f}, c1 = c0, s0 = {0.f, 0.f, 0.f, 0.f}, s1 = s0;
                    if (even) { const f32x4* rp = (const f32x4*)(rope + (size_t)row * 16); c0 = rp[0]; c1 = rp[1]; s0 = rp[2]; s1 = rp[3]; }
#pragma unroll
                    for (int bj = 0; bj < 2; ++bj) {
                        f32x4 v0 = acc[ai][bj][m][0], v1 = acc[ai][bj][m][1];
                        if (even) {
                            f32x4 p0, p1;
#pragma unroll
                            for (int j = 0; j < 4; ++j) { p0[j] = __shfl_xor(v0[j], 16); p1[j] = __shfl_xor(v1[j], 16); }
                            if (part) { v0 = v0 * c0 + (p0 * s0) * sg; v1 = v1 * c1 + (p1 * s1) * sg; }
                        }
                        *(u32x4*)(base + (size_t)row * 1024 + cc0 + bj * HALF) = pack8(v0, v1);
                    }
                }
        } else if (ty == 2) {
#pragma unroll
            for (int ai = 0; ai < 2; ++ai)
#pragma unroll
                for (int m = 0; m < 4; ++m) { const int row = row0 + ai * HALF + m * 16;
#pragma unroll
                    for (int bj = 0; bj < 2; ++bj) *(u32x4*)(base + (size_t)row * 1024 + cc0 + bj * HALF) = pack8(acc[ai][bj][m][0], acc[ai][bj][m][1]); }
        } else if (ty <= 4) {
#pragma unroll
            for (int ai = 0; ai < 2; ++ai)
#pragma unroll
                for (int m = 0; m < 4; ++m) { const int row = row0 + ai * HALF + m * 16; float s = 0.f, q = 0.f;
#pragma unroll
                    for (int bj = 0; bj < 2; ++bj) { f32x4 v0 = acc[ai][bj][m][0], v1 = acc[ai][bj][m][1];
#pragma unroll
                        for (int j = 0; j < 4; ++j) { v0[j] = gelu_t(v0[j]); v1[j] = gelu_t(v1[j]); }
                        const u32x4 w = pack8(v0, v1);
                        *(u32x4*)(base + (size_t)row * 1024 + cc0 + bj * HALF) = w;
                        if (ty == 4) {
#pragma unroll
                            for (int j = 0; j < 4; ++j) { const float a = bf_lo(w[j]), b = bf_hi(w[j]); s += a + b; q += a * a + b * b; } }
                    }
                    if (ty == 4) { s += __shfl_xor(s, 16); s += __shfl_xor(s, 32); q += __shfl_xor(q, 16); q += __shfl_xor(q, 32);
                        if (fq == 0) { f32x2e o = {s, q}; *(f32x2e*)(stats + ((size_t)row * 16 + (u.pn & 3) * 4 + wc) * 2) = o; } }
                }
        } else {
#pragma unroll
            for (int ai = 0; ai < 2; ++ai)
#pragma unroll
                for (int m = 0; m < 4; ++m) { const int row = row0 + ai * HALF + m * 16;
#pragma unroll
                    for (int bj = 0; bj < 2; ++bj) { f32x4 v0 = acc[ai][bj][m][0], v1 = acc[ai][bj][m][1];
#pragma unroll
                        for (int j = 0; j < 4; ++j) { v0[j] = sigm(v0[j]); v1[j] = sigm(v1[j]); }
                        *(u32x4*)(base + (size_t)row * 1024 + cc0 + bj * HALF) = pack8(v0, v1); } }
        }
    }
};

struct EpiMerge {
    static constexpr bool PERM = true, AFTER_DRAIN = false;
    const bf16_t* GA; const bf16_t* GG; bf16_t* O;
    __device__ __forceinline__ void operator()(const f32x4 (&acc)[2][2][4][2], const Unit& u, int wr, int wc, int fr, int fq) const {
        const int row0 = u.pm * BM + wr * 64 + fr, col0 = u.pn * BM + wc * 32 + 8 * fq;
        const bf16_t* G = u.w == 0 ? GA : GG;
#pragma unroll
        for (int ai = 0; ai < 2; ++ai)
#pragma unroll
            for (int m = 0; m < 4; ++m) { const size_t ro = (size_t)(row0 + ai * HALF + m * 16) * 1024 + col0;
#pragma unroll
                for (int bj = 0; bj < 2; ++bj) { const size_t off = ro + bj * HALF;
                    const u32x4 g = *(const u32x4*)(G + off);
                    f32x4 v0 = acc[ai][bj][m][0], v1 = acc[ai][bj][m][1];
                    v0[0] *= bf_lo(g.x); v0[1] *= bf_hi(g.x); v0[2] *= bf_lo(g.y); v0[3] *= bf_hi(g.y);
                    v1[0] *= bf_lo(g.z); v1[1] *= bf_hi(g.z); v1[2] *= bf_lo(g.w); v1[3] *= bf_hi(g.w);
                    if (u.w != 0) { const u32x4 t = *(const u32x4*)(O + off);
                        v0[0] += bf_lo(t.x); v0[1] += bf_hi(t.x); v0[2] += bf_lo(t.y); v0[3] += bf_hi(t.y); v1[0] += bf_lo(t.z); v1[1] += bf_hi(t.z); v1[2] += bf_lo(t.w); v1[3] += bf_hi(t.w); }
                    *(u32x4*)(O + off) = pack8(v0, v1); } }
    }
};

struct EpiF32 {
    static constexpr bool PERM = true, AFTER_DRAIN = false;
    float* O; int ldc;
    __device__ __forceinline__ void operator()(const f32x4 (&acc)[2][2][4][2], const Unit& u, int wr, int wc, int fr, int fq) const {
        const int row0 = u.pm * BM + wr * 64 + fr, col0 = u.pn * BM + wc * 32 + 8 * fq;
#pragma unroll
        for (int ai = 0; ai < 2; ++ai)
#pragma unroll
            for (int m = 0; m < 4; ++m) { float* rowp = O + (size_t)(row0 + ai * HALF + m * 16) * ldc + col0;
#pragma unroll
                for (int bj = 0; bj < 2; ++bj) { *(f32x4*)(rowp + bj * HALF) = acc[ai][bj][m][0]; *(f32x4*)(rowp + bj * HALF + 4) = acc[ai][bj][m][1]; } }
    }
};
}
#define XB_TMO      128
#define XB_XCNT(j)  (256  + 64 * (j))
#define XB_XSUB(j)  (1280 + 64 * (j))
#define XB_XGEN(j)  (2304 + 64 * (j))
#define XB_TOP      3328
#define XB_TOPGEN   3392
#define XCD_BAR_WORDS 3456
#define XB_SPIN_CAP (1u << 18)

__device__ __forceinline__ unsigned xb_ld(unsigned* p)              { return __hip_atomic_load(p, __ATOMIC_RELAXED, __HIP_MEMORY_SCOPE_AGENT); }
__device__ __forceinline__ unsigned xb_add(unsigned* p, unsigned v) { return __hip_atomic_fetch_add(p, v, __ATOMIC_RELAXED, __HIP_MEMORY_SCOPE_AGENT); }
__device__ __forceinline__ unsigned xb_xcc_id() { return (unsigned)__builtin_amdgcn_s_getreg((3 << 11) | 20) & 0xFu; }
#define XB_SPIN(cond, bar) do { unsigned _sp = 0; while (cond) { __builtin_amdgcn_s_sleep(1); \
    if ((++_sp & 255u) == 0u) { if (xb_ld(&(bar)[XB_TMO])) break; if (_sp > XB_SPIN_CAP) { atomicAdd(&(bar)[XB_TMO], 1u); break; } } } } while (0)

struct XcdBarrier {
    unsigned* bar; unsigned x;
    volatile LAS unsigned* st;
};

__device__ __forceinline__ XcdBarrier xcd_barrier_post(unsigned* bar, volatile LAS unsigned* st) {
    XcdBarrier b; b.bar = bar; b.x = xb_xcc_id(); b.st = st;
    if (threadIdx.x == 0) (void)xb_add(&bar[XB_XCNT(b.x)], 1u);
    return b;
}
__device__ __forceinline__ void xcd_barrier_complete(unsigned* bar, unsigned x, unsigned& nloc, unsigned& nx) {
    const unsigned G = gridDim.x * gridDim.y * gridDim.z;
    unsigned sum, cnt, mine, sp = 0u;
    for (;;) {
        sum = 0u; cnt = 0u; mine = 0u;
#pragma unroll
        for (unsigned j = 0; j < 16; ++j) { const unsigned c = xb_ld(&bar[XB_XCNT(j)]); sum += c; cnt += (c > 0u) ? 1u : 0u; mine = (j == x) ? c : mine; }
        if (sum == G) break;
        __builtin_amdgcn_s_sleep(1);
        if ((++sp & 255u) == 0u) { if (xb_ld(&bar[XB_TMO])) break; if (sp > XB_SPIN_CAP) { atomicAdd(&bar[XB_TMO], 1u); break; } }
    }
    nloc = mine > 0u ? mine : 1u; nx = cnt > 0u ? cnt : 1u;
}

__device__ __forceinline__ void xcd_barrier(const XcdBarrier& b) {
    asm volatile("s_waitcnt vmcnt(0)" ::: "memory");
    __syncthreads();
    if (threadIdx.x == 0) {
        unsigned* bar = b.bar;
        __builtin_amdgcn_s_waitcnt(0);
        unsigned nloc = b.st[0], nx = b.st[1];
        if (nloc == 0u) { xcd_barrier_complete(bar, b.x, nloc, nx); b.st[0] = nloc; b.st[1] = nx; }
        const unsigned old = xb_add(&bar[XB_XSUB(b.x)], 1u);
        const unsigned gen = old / nloc;
        if (old + 1u == (gen + 1u) * nloc) {
            __builtin_amdgcn_fence(__ATOMIC_RELEASE, "agent");
            asm volatile("s_waitcnt vmcnt(0)" ::: "memory");
            const unsigned og = xb_add(&bar[XB_TOP], 1u);
            const unsigned tg = og / nx;
            if (og + 1u == (tg + 1u) * nx) xb_add(&bar[XB_TOPGEN], 1u);
            else XB_SPIN(xb_ld(&bar[XB_TOPGEN]) == tg, bar);
            __builtin_amdgcn_fence(__ATOMIC_ACQUIRE, "agent");
            xb_add(&bar[XB_XGEN(b.x)], 1u);
            asm volatile("s_waitcnt vmcnt(0)" ::: "memory");
        } else {
            XB_SPIN(xb_ld(&bar[XB_XGEN(b.x)]) == gen, bar);
            __builtin_amdgcn_fence(__ATOMIC_ACQUIRE, "agent");
            asm volatile("s_waitcnt vmcnt(0)" ::: "memory");
        }
    }
    __syncthreads();
}

struct Frame {
    LAS unsigned char* lds; int tid, lane, wave, vcu, G;
};

__device__ __forceinline__ void p0_transpose_item(const float* W, int K, int N, bf16* WT, LAS float* scr, int item, int lane) {
    const int nblk = N / 32, kb = item / nblk, nb = item % nblk, k0 = 64 * kb, n0 = 32 * nb;
#pragma unroll 8
    for (int i = 0; i < 32; ++i) { const int kk = 2 * i + (lane >> 5); scr[kk * 33 + (lane & 31)] = W[(size_t)(k0 + kk) * N + n0 + (lane & 31)]; }
    LDS_WAIT(); asm volatile("" ::: "memory");
    const int c = lane & 7;
#pragma unroll
    for (int j = 0; j < 4; ++j) { const int n = (lane >> 3) + 8 * j; const LAS float* s = scr + (8 * c) * 33 + n;
        v4u o; o.x = pk2(s[0 * 33], s[1 * 33]); o.y = pk2(s[2 * 33], s[3 * 33]); o.z = pk2(s[4 * 33], s[5 * 33]); o.w = pk2(s[6 * 33], s[7 * 33]);
        *(GAS v4u*)(WT + (size_t)(n0 + n) * K + k0 + 8 * c) = o; }
    LDS_WAIT(); asm volatile("" ::: "memory");
}
__device__ __forceinline__ void cvt_plain(const Frame& F, const float* src, bf16* dst, long n8) {
    const long gt = (long)(F.vcu * NWAVES + F.wave) * 64 + F.lane, NT = (long)F.G * NWAVES * 64;
    for (long i = gt; i < n8; i += NT) { const f32x4 a = *(const GAS f32x4*)(src + i * 8), b = *(const GAS f32x4*)(src + i * 8 + 4);
        v4u o; o.x = pk2(a[0], a[1]); o.y = pk2(a[2], a[3]); o.z = pk2(b[0], b[1]); o.w = pk2(b[2], b[3]); *(GAS v4u*)(dst + i * 8) = o; }
}
__device__ __forceinline__ void sincos_d(double r, float& s, float& c) {
    const double z = r * r;
    double ps = 1.9572941063391263e-20; ps = ps * z + -8.22063524662433e-18; ps = ps * z + 2.8114572543455206e-15; ps = ps * z + -7.647163731819816e-13; ps = ps * z + 1.6059043836821613e-10;
    ps = ps * z + -2.505210838544172e-08; ps = ps * z + 2.7557319223985893e-06; ps = ps * z + -0.0001984126984126984; ps = ps * z + 0.008333333333333333; ps = ps * z + -0.16666666666666666; ps = ps * z + 1.0;
    double pc = -8.896791392450574e-22; pc = pc * z + 4.110317623312165e-19; pc = pc * z + -1.5619206968586225e-16; pc = pc * z + 4.779477332387385e-14; pc = pc * z + -1.1470745597729725e-11; pc = pc * z + 2.08767569878681e-09;
    pc = pc * z + -2.755731922398589e-07; pc = pc * z + 2.48015873015873e-05; pc = pc * z + -0.001388888888888889; pc = pc * z + 0.041666666666666664; pc = pc * z + -0.5; pc = pc * z + 1.0;
    s = (float)(r * ps); c = (float)pc;
}
struct P0Args { const float *c, *w_ada, *b_ada, *w_in, *w_a, *w_g, *w_out, *w_pq, *keys, *wsp; const int* pos; unsigned char* ws; };
__device__ __forceinline__ void p0_prologue(const Frame& F, const P0Args& a) {
    LAS float* scr = (LAS float*)(F.lds + F.wave * 16384);
    const int gw = F.vcu * NWAVES + F.wave, NGW = F.G * NWAVES;
    constexpr int I_IN = (D / 64) * (NIN / 32), I_SQ = (D / 64) * (D / 32), I_PQ = (D / 64) * (NPQ / 32), NITEMS = I_IN + 3 * I_SQ + I_PQ;
    for (int it = gw; it < NITEMS; it += NGW) {
        int r = it;
        if (r < I_IN) { p0_transpose_item(a.w_in, D, NIN, (bf16*)(a.ws + WS_WIN), scr, r, F.lane); continue; } r -= I_IN;
        if (r < I_SQ) { p0_transpose_item(a.w_a, D, D, (bf16*)(a.ws + WS_WA), scr, r, F.lane); continue; } r -= I_SQ;
        if (r < I_SQ) { p0_transpose_item(a.w_g, D, D, (bf16*)(a.ws + WS_WG), scr, r, F.lane); continue; } r -= I_SQ;
        if (r < I_SQ) { p0_transpose_item(a.w_out, D, D, (bf16*)(a.ws + WS_WOUT), scr, r, F.lane); continue; } r -= I_SQ;
        p0_transpose_item(a.w_pq, D, NPQ, (bf16*)(a.ws + WS_WPQ), scr, r, F.lane);
    }
    cvt_plain(F, a.keys, (bf16*)(a.ws + WS_KEYS), 8 * 2 * 128 * 128 / 8);
    cvt_plain(F, a.wsp, (bf16*)(a.ws + WS_WSP), 8 * 128 * 128 / 8);
    { const long gt = (long)gw * 64 + F.lane, NT = (long)NGW * 64; float* rope = (float*)(a.ws + WS_ROPE);
      for (long m = gt; m < M; m += NT) { const double p = (double)a.pos[m];
          const double invf[8] = {1.0, 0.19392274474868576, 0.03760603093086393, 0.007292664737217109, 0.001414213562373095, 0.0002742481756762073, 5.318295896944988e-05, 1.031338537721246e-05};
          float cs[8], sn[8];
#pragma unroll
          for (int i = 0; i < 8; ++i) { const double ang = p * invf[i]; const double k = __builtin_rint(ang * 0.15915494309189535); const double r = ang - k * 6.283185307179586; sincos_d(r, sn[i], cs[i]); }
          f32x4* o = (f32x4*)(rope + m * 16);
          o[0] = (f32x4){cs[0], cs[1], cs[2], cs[3]}; o[1] = (f32x4){cs[4], cs[5], cs[6], cs[7]}; o[2] = (f32x4){sn[0], sn[1], sn[2], sn[3]}; o[3] = (f32x4){sn[4], sn[5], sn[6], sn[7]}; } }
    { float* mod = (float*)(a.ws + WS_MOD); LAS float* red = (LAS float*)F.lds;
      __syncthreads();
      for (int it = F.vcu; it < NMOD / 32; it += F.G) { const int col = it * 32 + (F.lane & 31), kh = F.lane >> 5, k0 = F.wave * 128 + kh * 64;
          float acc[8];
#pragma unroll
          for (int b = 0; b < 8; ++b) acc[b] = 0.f;
#pragma unroll 8
          for (int kk = 0; kk < 64; ++kk) { const int k = k0 + kk; const float w = a.w_ada[(size_t)k * NMOD + col];
#pragma unroll
              for (int b = 0; b < 8; ++b) { const float cv = a.c[b * D + k]; const float sl = cv * __builtin_amdgcn_rcpf(1.f + __expf(-cv)); acc[b] += sl * w; } }
#pragma unroll
          for (int b = 0; b < 8; ++b) red[((F.wave * 2 + kh) * 8 + b) * 32 + (F.lane & 31)] = acc[b];
          __syncthreads();
          if (F.tid < 256) { const int b = F.tid >> 5, c = F.tid & 31; float s = a.b_ada[it * 32 + c];
#pragma unroll
              for (int p = 0; p < 16; ++p) s += red[(p * 8 + b) * 32 + c];
              mod[b * NMOD + it * 32 + c] = s; }
          __syncthreads(); } }
}

__device__ __forceinline__ void p1_xn(const Frame& F, const float* x, const float* g_pre, const float* mod, bf16* XN) {
    const int gw = F.vcu * NWAVES + F.wave, NGW = F.G * NWAVES;
    for (int m = gw; m < M; m += NGW) { const int b = m >> 12;
        const GAS f32x4* xr = (const GAS f32x4*)(x + (size_t)m * D) + F.lane;
        f32x4 v[4]; float ss = 0.f;
#pragma unroll
        for (int j = 0; j < 4; ++j) { v[j] = xr[64 * j]; ss += (v[j].x * v[j].x + v[j].y * v[j].y) + (v[j].z * v[j].z + v[j].w * v[j].w); }
        const float rs = 1.f / sqrtf(wave_sum(ss) * (1.f / D) + EPS);
        GAS v2u* o8 = (GAS v2u*)(XN + (size_t)m * D) + F.lane;
#pragma unroll
        for (int j = 0; j < 4; ++j) { const int col = 256 * j + 4 * F.lane;
            const f32x4 g = *(const f32x4*)(g_pre + col), sh = *(const f32x4*)(mod + b * NMOD + col), sc = *(const f32x4*)(mod + b * NMOD + D + col);
            const f32x4 h = v[j] * rs * g * (sc + 1.f) + sh; v2u w; w.x = pk2(h.x, h.y); w.y = pk2(h.z, h.w); o8[64 * j] = w; }
    }
}

__device__ __forceinline__ s16x4 tr_read_dyn(unsigned addr) { s16x4 r; asm volatile("ds_read_b64_tr_b16 %0, %1" : "=&v"(r) : "v"(addr) : "memory"); return r; }
struct GmlpArgs { const bf16* ZV; bf16* U; const float* stats; const float* ln_g; const float* ln_b; const bf16* wsp; const float* b_s; };
__device__ __forceinline__ void p3_gmlp(const Frame& F, const GmlpArgs& a) {
    LAS unsigned char* T = F.lds + F.wave * 16384;
    LAS float* MR = (LAS float*)(F.lds + LDSCTL_OFF + 1024);
    const int g = F.wave, lane = F.lane, L31 = lane & 31, hh = lane >> 5;
    const unsigned Tb = (unsigned)(uintptr_t)T;
    const int qq = (lane & 15) >> 2, p4 = lane & 3, g16 = (lane >> 4) & 1, sw = (qq >> 1) & 1;
    const unsigned rb0 = Tb + (8 * hh + qq) * 128 + 64 * (0 ^ sw) + (16 * g16 + 4 * p4) * 2;
    const unsigned rb1 = Tb + (8 * hh + qq) * 128 + 64 * (1 ^ sw) + (16 * g16 + 4 * p4) * 2;
    for (int ck = F.vcu; ck < M / 128; ck += F.G) {
        const size_t rowc = (size_t)ck * 128;
        __syncthreads();
        if (F.tid < 128) { const f32x4* sp = (const f32x4*)(a.stats + (rowc + F.tid) * 32); float s = 0.f, q = 0.f;
#pragma unroll
            for (int j = 0; j < 8; ++j) { const f32x4 t = sp[j]; s += t.x + t.z; q += t.y + t.w; }
            const float mu = s * (1.f / 1024.f), var = q * (1.f / 1024.f) - mu * mu;
            MR[2 * F.tid] = mu; MR[2 * F.tid + 1] = 1.f / sqrtf(fmaxf(var, 0.f) + EPS); }
        __syncthreads();
#pragma unroll 1
        for (int half = 0; half < 2; ++half) {
            const int cbase = g * 128 + half * 64;
            { const int c0 = 8 * (lane & 7);
              const f32x4 ga = *(const f32x4*)(a.ln_g + cbase + c0), gb = *(const f32x4*)(a.ln_g + cbase + c0 + 4), ba = *(const f32x4*)(a.ln_b + cbase + c0), bb = *(const f32x4*)(a.ln_b + cbase + c0 + 4);
#pragma unroll 4
              for (int i = 0; i < 16; ++i) { const int q = (lane >> 3) + 8 * i;
                  const v4u w = *(const GAS v4u*)(a.ZV + (rowc + q) * 1024 + cbase + c0);
                  const float mu = MR[2 * q], rs = MR[2 * q + 1];
                  f32x4 x0 = {bflo(w.x), bfhi(w.x), bflo(w.y), bfhi(w.y)}, x1 = {bflo(w.z), bfhi(w.z), bflo(w.w), bfhi(w.w)};
                  x0 = (x0 - mu) * rs * ga + ba; x1 = (x1 - mu) * rs * gb + bb;
                  v4u o; o.x = pk2(x0[0], x0[1]); o.y = pk2(x0[2], x0[3]); o.z = pk2(x1[0], x1[1]); o.w = pk2(x1[2], x1[3]);
                  *(LAS v4u*)(T + q * 128 + ((c0 * 2) ^ (((q >> 1) & 1) << 6))) = o; } }
            LDS_WAIT(); asm volatile("" ::: "memory");
#pragma unroll 1
            for (int pb = 0; pb < 4; ++pb) {
                bf16x8 af[8];
#pragma unroll
                for (int ks = 0; ks < 8; ++ks) af[ks] = *(const GAS bf16x8*)(a.wsp + ((size_t)(g * 128 + pb * 32 + L31)) * 128 + 16 * ks + 8 * hh);
                f32x16 acc0 = {}, acc1 = {};
#pragma unroll
                for (int ks = 0; ks < 8; ++ks) {
                    const s16x4 l0 = tr_read_dyn(rb0 + ks * 2048), h0 = tr_read_dyn(rb0 + ks * 2048 + 512), l1 = tr_read_dyn(rb1 + ks * 2048), h1 = tr_read_dyn(rb1 + ks * 2048 + 512);
                    asm volatile("s_waitcnt lgkmcnt(0)" ::: "memory"); SBAR();
                    const bf16x8 b0 = {l0[0], l0[1], l0[2], l0[3], h0[0], h0[1], h0[2], h0[3]}, b1 = {l1[0], l1[1], l1[2], l1[3], h1[0], h1[1], h1[2], h1[3]};
                    acc0 = __builtin_amdgcn_mfma_f32_32x32x16_bf16(af[ks], b0, acc0, 0, 0, 0);
                    acc1 = __builtin_amdgcn_mfma_f32_32x32x16_bf16(af[ks], b1, acc1, 0, 0, 0);
                }
#pragma unroll
                for (int r = 0; r < 16; ++r) { const int p = pb * 32 + crow(r, hh); const float bs = a.b_s[g * 128 + p];
                    bf16* up = a.U + (rowc + p) * 1024 + cbase + L31;
                    const float u0 = bflo((unsigned)up[0]), u1 = bflo((unsigned)up[32]);
                    up[0] = (bf16)f2bf(u0 * (acc0[r] + bs)); up[32] = (bf16)f2bf(u1 * (acc1[r] + bs)); }
            }
            LDS_WAIT(); asm volatile("" ::: "memory");
        }
    }
    __syncthreads();
}

namespace att {
constexpr int NW = 8, QBLK = 32, KVBLK = 64, LD = 1024;
constexpr float SCALE = 0.125f, THR = 8.f;
constexpr int SHM_V = 16384, SHM_K = 8192, OFF_V = 0, OFF_K = 2 * SHM_V, OFF_WS = OFF_K + 2 * SHM_K, OFF_STG = OFF_WS + NW * 64 * 4, ATT_LDS = OFF_STG + NW * 8192;
static_assert(ATT_LDS <= 131072, "attention LDS");
#define KSWZ64(row, colB) ((row) * 128 + ((colB) ^ ((((row) >> 1) & 7) << 4)))
__device__ __forceinline__ unsigned cvtpk(float lo, float hi) { return pk2(lo, hi); }
__device__ __forceinline__ void partialSM(f32x16& p0, f32x16& p1, float& m_reg, float& mn, float& alpha) {
  constexpr float C = SCALE * 1.4426950408889634f;
  float pmax = p0[0];
#pragma unroll
  for (int r = 1; r < 16; ++r) pmax = fmaxf(pmax, p0[r]);
#pragma unroll
  for (int r = 0; r < 16; ++r) pmax = fmaxf(pmax, p1[r]);
  { auto rr = __builtin_amdgcn_permlane32_swap(__float_as_uint(pmax), __float_as_uint(pmax), false, false);
    pmax = fmaxf(__uint_as_float(rr[0]), __uint_as_float(rr[1])); }
  if (__builtin_expect(__all(pmax - m_reg <= THR / SCALE), 1)) { mn = m_reg; alpha = 1.f; }
  else { mn = fmaxf(m_reg, pmax); alpha = __builtin_amdgcn_exp2f((m_reg - mn) * C); m_reg = mn; }
  float mnC = -mn * C;
#pragma unroll
  for (int r = 0; r < 16; ++r) p0[r] = fmaf(p0[r], C, mnC);
#pragma unroll
  for (int r = 0; r < 16; ++r) p1[r] = fmaf(p1[r], C, mnC);
#pragma unroll
  for (int r = 0; r < 16; ++r) p0[r] = __builtin_amdgcn_exp2f(p0[r]);
}
__device__ __forceinline__ void finishSM(f32x16& p0, f32x16& p1, float alpha, float& l_reg, bf16x8& pa0, bf16x8& pa1, bf16x8& pa2, bf16x8& pa3) {
#pragma unroll
  for (int r = 0; r < 16; ++r) p1[r] = __builtin_amdgcn_exp2f(p1[r]);
  float ps = 0;
#pragma unroll
  for (int r = 0; r < 16; ++r) ps += p0[r];
#pragma unroll
  for (int r = 0; r < 16; ++r) ps += p1[r];
  { auto rr = __builtin_amdgcn_permlane32_swap(__float_as_uint(ps), __float_as_uint(ps), false, false);
    ps = __uint_as_float(rr[0]) + __uint_as_float(rr[1]); }
  l_reg = l_reg * alpha + ps;
#define PK4(P, BASE, OUT) do { unsigned a0 = cvtpk(P[BASE + 0], P[BASE + 1]), a1 = cvtpk(P[BASE + 2], P[BASE + 3]);   \
    unsigned b0 = cvtpk(P[BASE + 4], P[BASE + 5]), b1 = cvtpk(P[BASE + 6], P[BASE + 7]);                              \
    auto r0 = __builtin_amdgcn_permlane32_swap(a0, b0, false, false); auto r1 = __builtin_amdgcn_permlane32_swap(a1, b1, false, false); \
    v4u w = {r0[0], r1[0], r0[1], r1[1]}; OUT = *reinterpret_cast<bf16x8*>(&w); } while (0)
  PK4(p0, 0, pa0); PK4(p0, 8, pa1); PK4(p1, 0, pa2); PK4(p1, 8, pa3);
#undef PK4
}
__device__ __forceinline__ void qkt(f32x16& p0, f32x16& p1, const char* Ks, const bf16x8* qr, int r32, int hi) {
  p0 = f32x16{}; p1 = f32x16{};
#pragma unroll
  for (int d0 = 0; d0 < 4; ++d0) { const int cb = (d0 * 16 + hi * 8) * 2;
    bf16x8 b0 = *reinterpret_cast<const bf16x8*>(Ks + KSWZ64(r32, cb));
    bf16x8 b1 = *reinterpret_cast<const bf16x8*>(Ks + KSWZ64(32 + r32, cb));
    p0 = __builtin_amdgcn_mfma_f32_32x32x16_bf16(b0, qr[d0], p0, 0, 0, 0);
    p1 = __builtin_amdgcn_mfma_f32_32x32x16_bf16(b1, qr[d0], p1, 0, 0, 0); }
}
__device__ __forceinline__ int v_st(int k, int c) { const int kk = (k & ~0xC) | ((k & 4) << 1) | ((k & 8) >> 1); return ((kk >> 3) * 4 + (c >> 5)) * 512 + ((kk & 7) * 32 + (c & 31)) * 2; }
__device__ __forceinline__ int v_rd_base(int lane) { return ((lane & 3) << 3) | (((lane >> 2) & 3) << 6) | (((lane >> 4) & 1) << 5) | (((lane >> 5) & 1) << 8); }
constexpr int v_rd_off(int d0, int ks, int half) { return d0 * 512 + ks * 4096 + half * 2048; }
template <int OFF> __device__ __forceinline__ s16x4 tr_read(int vb) {
  s16x4 r; asm volatile("ds_read_b64_tr_b16 %0, %1 offset:%2" : "=&v"(r) : "v"(vb), "i"(OFF) : "memory"); return r;
}
template <int D0> __device__ __forceinline__ void pv_one(f32x16& od, int vb, bf16x8 pa0, bf16x8 pa1, bf16x8 pa2, bf16x8 pa3) {
  const s16x4 l0 = tr_read<v_rd_off(D0, 0, 0)>(vb), h0 = tr_read<v_rd_off(D0, 0, 1)>(vb), l1 = tr_read<v_rd_off(D0, 1, 0)>(vb), h1 = tr_read<v_rd_off(D0, 1, 1)>(vb);
  const s16x4 l2 = tr_read<v_rd_off(D0, 2, 0)>(vb), h2 = tr_read<v_rd_off(D0, 2, 1)>(vb), l3 = tr_read<v_rd_off(D0, 3, 0)>(vb), h3 = tr_read<v_rd_off(D0, 3, 1)>(vb);
  asm volatile("s_waitcnt lgkmcnt(0)" ::: "memory"); SBAR();
#define PK(L, H) (bf16x8){L[0], L[1], L[2], L[3], H[0], H[1], H[2], H[3]}
  od = __builtin_amdgcn_mfma_f32_32x32x16_bf16(pa0, PK(l0, h0), od, 0, 0, 0);
  od = __builtin_amdgcn_mfma_f32_32x32x16_bf16(pa1, PK(l1, h1), od, 0, 0, 0);
  od = __builtin_amdgcn_mfma_f32_32x32x16_bf16(pa2, PK(l2, h2), od, 0, 0, 0);
  od = __builtin_amdgcn_mfma_f32_32x32x16_bf16(pa3, PK(l3, h3), od, 0, 0, 0);
#undef PK
}
__device__ __forceinline__ void pv_d0(f32x16* o, int vb, bf16x8 pa0, bf16x8 pa1, bf16x8 pa2, bf16x8 pa3) {
  pv_one<0>(o[0], vb, pa0, pa1, pa2, pa3); pv_one<1>(o[1], vb, pa0, pa1, pa2, pa3); pv_one<2>(o[2], vb, pa0, pa1, pa2, pa3); pv_one<3>(o[3], vb, pa0, pa1, pa2, pa3);
}

template <int t>
__device__ __forceinline__ void attn_pass(const bf16* Qh, const bf16* __restrict__ Kh, const bf16* __restrict__ Vh, bf16* ONh, int q0, float lam, const float* gsub, float* stash, char* lds) {
  int tid = threadIdx.x; asm volatile("" : "+v"(tid));
  const int wid = tid >> 6, lane = tid & 63, r32 = lane & 31, hi = lane >> 5;
  char* V_lds = lds + OFF_V; char* K_lds = lds + OFF_K;
  float* ws = (float*)(lds + OFF_WS) + wid * 64; float* li_l = ws; float* al_l = ws + 32;
  bf16* stg = (bf16*)(lds + OFF_STG + wid * 8192);
  const int sr = tid >> 4, sc = (tid & 15) * 8, vst0 = v_st(sr, sc), vst1 = v_st(32 + sr, sc);
  const int kr = tid >> 3, kc = (tid & 7) * 8, kst = KSWZ64(kr, kc * 2);
  const int vb0 = (int)(uintptr_t)V_lds + v_rd_base(lane);
  constexpr int NT = SEQ / KVBLK;
  {
    const bf16* Kt = Kh + t * 64;
    float m_reg = -1e30f, l_reg = 0; f32x16 o[4] = {}; bf16x8 qr[4];
    const bf16* Qw = Qh + (long)(q0 + wid * QBLK + r32) * LD + t * 64 + hi * 8;
#pragma unroll
    for (int d0 = 0; d0 < 4; ++d0) qr[d0] = *reinterpret_cast<const bf16x8*>(Qw + d0 * 16);
    struct { bf16x8 vs0, vs1, ks0; } sr_[2];
#define SLOAD(i, k0) do { sr_[i].vs0 = *reinterpret_cast<const bf16x8*>(&Vh[(long)((k0) + sr) * LD + sc]); sr_[i].vs1 = *reinterpret_cast<const bf16x8*>(&Vh[(long)((k0) + 32 + sr) * LD + sc]); \
    sr_[i].ks0 = *reinterpret_cast<const bf16x8*>(&Kt[(long)((k0) + kr) * LD + kc]); } while (0)
#define SWRITE(b, i) do { *(bf16x8*)(V_lds + (b) * SHM_V + vst0) = sr_[i].vs0; *(bf16x8*)(V_lds + (b) * SHM_V + vst1) = sr_[i].vs1; \
    *(bf16x8*)(K_lds + (b) * SHM_K + kst) = sr_[i].ks0; } while (0)
#define SWAIT() asm volatile("s_waitcnt vmcnt(3)" ::: "memory")
#define RESC(a) do { if (__any((a) < 1.f)) { if (hi == 0) al_l[r32] = (a); asm volatile("s_waitcnt lgkmcnt(0)" ::: "memory"); \
    _Pragma("unroll") for (int d = 0; d < 4; ++d) _Pragma("unroll") for (int r = 0; r < 16; ++r) o[d][r] *= al_l[crow(r, hi)]; } } while (0)
    f32x16 pA0, pA1, pB0, pB1; float mnA, mnB, alA, alB; bf16x8 pa0, pa1, pa2, pa3;
    constexpr int SE = 0, SO = 1;
    SLOAD(SE, 0); asm volatile("s_waitcnt vmcnt(0)" ::: "memory"); SWRITE(0, SE); __syncthreads();
    qkt(pA0, pA1, K_lds, qr, r32, hi); partialSM(pA0, pA1, m_reg, mnA, alA);
    SLOAD(SO, KVBLK); SLOAD(SE, 2 * KVBLK);
    SWAIT(); SWRITE(1, SO); __syncthreads();
#pragma unroll 1
    for (int j = 1; j + 1 < NT; j += 2) {
      SBAR(); qkt(pB0, pB1, K_lds + SHM_K, qr, r32, hi);
      finishSM(pA0, pA1, alA, l_reg, pa0, pa1, pa2, pa3); SBAR();
      SLOAD(SO, (j + 2) * KVBLK); SBAR();
      pv_d0(o, vb0, pa0, pa1, pa2, pa3); partialSM(pB0, pB1, m_reg, mnB, alB);
      __syncthreads(); SWAIT(); SWRITE(0, SE);
      RESC(alB); __syncthreads();
      SBAR(); qkt(pA0, pA1, K_lds, qr, r32, hi);
      finishSM(pB0, pB1, alB, l_reg, pa0, pa1, pa2, pa3); SBAR();
      if (j + 3 < NT) SLOAD(SE, (j + 3) * KVBLK); SBAR();
      pv_d0(o, vb0 + SHM_V, pa0, pa1, pa2, pa3); partialSM(pA0, pA1, m_reg, mnA, alA);
      __syncthreads(); SWAIT(); SWRITE(1, SO);
      RESC(alA); __syncthreads();
    }
    SBAR(); qkt(pB0, pB1, K_lds + SHM_K, qr, r32, hi);
    finishSM(pA0, pA1, alA, l_reg, pa0, pa1, pa2, pa3); SBAR();
    pv_d0(o, vb0, pa0, pa1, pa2, pa3); partialSM(pB0, pB1, m_reg, mnB, alB);
    __syncthreads(); RESC(alB);
    finishSM(pB0, pB1, alB, l_reg, pa0, pa1, pa2, pa3); SBAR();
    pv_d0(o, vb0 + SHM_V, pa0, pa1, pa2, pa3);
#undef SLOAD
#undef SWRITE
#undef SWAIT
#undef RESC
    if (hi == 0) li_l[r32] = l_reg; asm volatile("s_waitcnt lgkmcnt(0)" ::: "memory");
    float rli[16];
#pragma unroll
    for (int r = 0; r < 16; ++r) rli[r] = __builtin_amdgcn_rcpf(li_l[crow(r, hi)]);
    GAS float* sp = (GAS float*)(stash + (size_t)wid * 4096 + lane);
    asm volatile("" : "+v"(sp));
    if (t == 0) {
#pragma unroll
      for (int r = 0; r < 16; ++r)
#pragma unroll
        for (int d0 = 0; d0 < 4; ++d0) sp[(d0 * 16 + r) * 64] = o[d0][r] * rli[r];
    } else {
      float gs[4];
#pragma unroll
      for (int d0 = 0; d0 < 4; ++d0) gs[d0] = gsub[d0 * 32 + r32] * 0.8f;
#pragma unroll
      for (int r = 0; r < 16; ++r) { float oc[4]; float ss = 0.f;
#pragma unroll
        for (int d0 = 0; d0 < 4; ++d0) { oc[d0] = sp[(d0 * 16 + r) * 64] - lam * (o[d0][r] * rli[r]); ss += oc[d0] * oc[d0]; }
        ss += __shfl_xor(ss, 1); ss += __shfl_xor(ss, 2); ss += __shfl_xor(ss, 4); ss += __shfl_xor(ss, 8); ss += __shfl_xor(ss, 16);
        const float rs = 1.f / sqrtf(ss * (1.f / 128.f) + EPS); const int orow = crow(r, hi);
#pragma unroll
        for (int d0 = 0; d0 < 4; ++d0) stg[orow * 128 + d0 * 32 + r32] = (bf16)f2bf(oc[d0] * rs * gs[d0]); }
      asm volatile("s_waitcnt lgkmcnt(0)" ::: "memory");
      bf16* Ow = ONh + (long)(q0 + wid * QBLK) * LD;
#pragma unroll
      for (int i = 0; i < 8; ++i) { const int row = i * 4 + (lane >> 4), ch = lane & 15; const v4u v = *(const v4u*)(stg + row * 128 + ch * 8); *(v4u*)(Ow + (long)row * LD + ch * 8) = v; }
      asm volatile("s_waitcnt lgkmcnt(0)" ::: "memory");
    }
  }
}
__device__ __forceinline__ void attn_unit(const bf16* Qh, const bf16* __restrict__ Kh, const bf16* __restrict__ Vh, bf16* ONh, int q0, float lam, const float* gsub, float* stash, char* lds) {
  attn_pass<0>(Qh, Kh, Vh, ONh, q0, lam, gsub, stash, lds);
  asm volatile("s_waitcnt vmcnt(0) lgkmcnt(0)" ::: "memory"); SBAR();
  attn_pass<1>(Qh, Kh, Vh, ONh, q0, lam, gsub, stash, lds);
  asm volatile("s_waitcnt vmcnt(0) lgkmcnt(0)" ::: "memory"); SBAR();
}
}

__device__ __forceinline__ void p6_rows(const Frame& F, const float* x, float* io, const float* g_post, const float* g_pre2, const float* mod, bf16* H2) {
    const int gw = F.vcu * NWAVES + F.wave, NGW = F.G * NWAVES;
    for (int m = gw; m < M; m += NGW) { const int b = m >> 12; const float* mb = mod + b * NMOD;
        GAS f32x4* mr = (GAS f32x4*)(io + (size_t)m * D) + F.lane; const GAS f32x4* xr = (const GAS f32x4*)(x + (size_t)m * D) + F.lane;
        f32x4 v[4], xv[4]; float ss = 0.f;
#pragma unroll
        for (int j = 0; j < 4; ++j) { v[j] = mr[64 * j]; xv[j] = xr[64 * j]; ss += (v[j].x * v[j].x + v[j].y * v[j].y) + (v[j].z * v[j].z + v[j].w * v[j].w); }
        const float rs = 1.f / sqrtf(wave_sum(ss) * (1.f / D) + EPS); float s2 = 0.f;
#pragma unroll
        for (int j = 0; j < 4; ++j) { const int col = 256 * j + 4 * F.lane;
            const f32x4 g = *(const f32x4*)(g_post + col), gt = *(const f32x4*)(mb + 2 * D + col);
            v[j] = xv[j] + gt * (v[j] * rs * g); mr[64 * j] = v[j];
            s2 += (v[j].x * v[j].x + v[j].y * v[j].y) + (v[j].z * v[j].z + v[j].w * v[j].w); }
        const float rs2 = 1.f / sqrtf(wave_sum(s2) * (1.f / D) + EPS);
        GAS v2u* o8 = (GAS v2u*)(H2 + (size_t)m * D) + F.lane;
#pragma unroll
        for (int j = 0; j < 4; ++j) { const int col = 256 * j + 4 * F.lane;
            const f32x4 g = *(const f32x4*)(g_pre2 + col), sh = *(const f32x4*)(mb + 3 * D + col), sc = *(const f32x4*)(mb + 4 * D + col);
            const f32x4 h = v[j] * rs2 * g * (sc + 1.f) + sh; v2u w; w.x = pk2(h.x, h.y); w.y = pk2(h.z, h.w); o8[64 * j] = w; }
    }
}

__device__ __forceinline__ float vmaxf(float a, float b) { float r; asm("v_max_f32_e32 %0, %1, %2" : "=v"(r) : "v"(a), "v"(b)); return r; }
__device__ __forceinline__ float vminf(float a, float b) { float r; asm("v_min_f32_e32 %0, %1, %2" : "=v"(r) : "v"(a), "v"(b)); return r; }
#define CE_DESC(a, b) do { const float _mx = vmaxf(a, b), _mn = vminf(a, b); a = _mx; b = _mn; } while (0)
__device__ __forceinline__ void sort16_desc(float (&v)[16]) {
#pragma unroll
    for (int k = 2; k <= 16; k <<= 1)
#pragma unroll
        for (int j = k >> 1; j > 0; j >>= 1)
#pragma unroll
            for (int i = 0; i < 16; ++i) { const int l = i ^ j; if (l > i) { if ((i & k) == 0) CE_DESC(v[i], v[l]); else CE_DESC(v[l], v[i]); } }
}
__device__ __forceinline__ void merge16_desc(float (&a)[16], const float (&b)[16]) {
#pragma unroll
    for (int i = 0; i < 16; ++i) a[i] = vmaxf(a[i], b[15 - i]);
#pragma unroll
    for (int j = 8; j > 0; j >>= 1)
#pragma unroll
        for (int i = 0; i < 16; ++i) { const int l = i ^ j; if (l > i) CE_DESC(a[i], a[l]); }
}
#define FILL_ROUND0 bt[0] = CAND(0, 0); bt[1] = CAND(0, 1); bt[2] = CAND(1, 0); bt[3] = CAND(0, 2); bt[4] = CAND(2, 0); bt[5] = CAND(1, 1); bt[6] = CAND(0, 3); bt[7] = CAND(3, 0); bt[8] = CAND(0, 4); bt[9] = CAND(4, 0); bt[10] = CAND(1, 2); bt[11] = CAND(2, 1); bt[12] = CAND(0, 5); bt[13] = CAND(5, 0); bt[14] = CAND(0, 6); bt[15] = CAND(6, 0);
#define FILL_ROUND1 bt[0] = CAND(1, 3); bt[1] = CAND(3, 1); bt[2] = CAND(0, 7); bt[3] = CAND(7, 0); bt[4] = CAND(2, 2); bt[5] = CAND(0, 8); bt[6] = CAND(8, 0); bt[7] = CAND(1, 4); bt[8] = CAND(4, 1); bt[9] = CAND(0, 9); bt[10] = CAND(9, 0); bt[11] = CAND(0, 10); bt[12] = CAND(10, 0); bt[13] = CAND(2, 3); bt[14] = CAND(3, 2); bt[15] = CAND(1, 5);
#define FILL_ROUND2 bt[0] = CAND(5, 1); bt[1] = CAND(0, 11); bt[2] = CAND(11, 0); bt[3] = CAND(0, 12); bt[4] = CAND(12, 0); bt[5] = CAND(1, 6); bt[6] = CAND(6, 1); bt[7] = CAND(0, 13); bt[8] = CAND(13, 0); bt[9] = CAND(2, 4); bt[10] = CAND(4, 2); bt[11] = CAND(0, 14); bt[12] = CAND(14, 0); bt[13] = CAND(3, 3); bt[14] = CAND(1, 7); bt[15] = CAND(7, 1);
#define FILL_ROUND3 bt[0] = CAND(0, 15); bt[1] = CAND(15, 0); bt[2] = NEG_INF; bt[3] = NEG_INF; bt[4] = NEG_INF; bt[5] = NEG_INF; bt[6] = NEG_INF; bt[7] = NEG_INF; bt[8] = NEG_INF; bt[9] = NEG_INF; bt[10] = NEG_INF; bt[11] = NEG_INF; bt[12] = NEG_INF; bt[13] = NEG_INF; bt[14] = NEG_INF; bt[15] = NEG_INF;
struct RouteArgs { const bf16* QP; const bf16* keys; int* IDX; float* GATE; };
__device__ __forceinline__ void p8_route(const Frame& F, const RouteArgs& a) {
    const int lane = F.lane, L31 = lane & 31, hh = lane >> 5, h = F.wave;
    LAS unsigned char* tab = F.lds + F.wave * 2048 + lane * 32;
    for (int tb = F.vcu; tb < M / 32; tb += F.G) {
        const int tok = tb * 32 + L31;
        float st[2][16];
#pragma unroll
        for (int t = 0; t < 2; ++t) {
            bf16x8 bq[8];
#pragma unroll
            for (int ks = 0; ks < 8; ++ks) bq[ks] = *(const GAS bf16x8*)(a.QP + (size_t)tok * NPQ + h * 256 + t * 128 + 16 * ks + 8 * hh);
            const bf16* kb = a.keys + (size_t)((h * 2 + t) * 128 + L31) * 128 + 8 * hh;
            float top[16];
#pragma unroll 1
            for (int nb = 0; nb < 4; ++nb) {
                f32x16 acc = {};
#pragma unroll
                for (int ks = 0; ks < 8; ++ks) { const bf16x8 af = *(const GAS bf16x8*)(kb + (size_t)nb * 32 * 128 + 16 * ks);
                    acc = __builtin_amdgcn_mfma_f32_32x32x16_bf16(af, bq[ks], acc, 0, 0, 0); }
                float bt[16];
#pragma unroll
                for (int r = 0; r < 16; ++r) bt[r] = __uint_as_float((__float_as_uint(acc[r]) & 0xFFFFFF80u) | (unsigned)(nb * 32 + crow(r, hh)));
                sort16_desc(bt);
                if (nb == 0) {
#pragma unroll
                    for (int r = 0; r < 16; ++r) top[r] = bt[r];
                } else merge16_desc(top, bt);
            }
            { float pt[16];
#pragma unroll
              for (int r = 0; r < 16; ++r) { auto rr = __builtin_amdgcn_permlane32_swap(__float_as_uint(top[r]), __float_as_uint(top[r]), false, false); pt[r] = __uint_as_float(hh ? rr[0] : rr[1]); }
              merge16_desc(top, pt); }
#pragma unroll
            for (int r = 0; r < 16; ++r) st[t][r] = top[r];
        }
        { unsigned w[8];
#pragma unroll
          for (int d = 0; d < 4; ++d) { w[d] = 0u; w[4 + d] = 0u;
#pragma unroll
              for (int k = 0; k < 4; ++k) { w[d] |= (__float_as_uint(st[0][4 * d + k]) & 0x7Fu) << (8 * k); w[4 + d] |= (__float_as_uint(st[1][4 * d + k]) & 0x7Fu) << (8 * k); } }
          *(LAS v4u*)(tab) = (v4u){w[0], w[1], w[2], w[3]}; *(LAS v4u*)(tab + 16) = (v4u){w[4], w[5], w[6], w[7]}; }
        float top[16], bt[16];
        const float NEG_INF = -__builtin_inff();
#define CAND(i, j) __uint_as_float((__float_as_uint(st[0][i] + st[1][j]) & 0xFFFFFF00u) | (unsigned)((i) * 16 + (j)))
        FILL_ROUND0 sort16_desc(bt);
#pragma unroll
        for (int r = 0; r < 16; ++r) top[r] = bt[r];
        FILL_ROUND1 sort16_desc(bt); merge16_desc(top, bt);
        FILL_ROUND2 sort16_desc(bt); merge16_desc(top, bt);
        FILL_ROUND3 sort16_desc(bt); merge16_desc(top, bt);
#undef CAND
        float e[16], es = 0.f;
#pragma unroll
        for (int r = 0; r < 16; ++r) { e[r] = __builtin_amdgcn_exp2f((top[r] - top[0]) * 1.4426950408889634f); es += e[r]; }
        const float inv = 1.f / es;
        LDS_WAIT();
        int ex[16];
#pragma unroll
        for (int r = 0; r < 16; ++r) { const unsigned cell = __float_as_uint(top[r]) & 0xFFu; const unsigned n0 = tab[cell >> 4], n1 = tab[16 + (cell & 15u)]; ex[r] = (int)(n0 * 128u + n1); e[r] *= inv; }
        int oi[8]; float og[8];
#pragma unroll
        for (int k = 0; k < 8; ++k) { oi[k] = hh ? ex[8 + k] : ex[k]; og[k] = hh ? e[8 + k] : e[k]; }
        int* ip = a.IDX + (size_t)tok * 128 + h * 16 + 8 * hh; float* gp = a.GATE + (size_t)tok * 128 + h * 16 + 8 * hh;
        *(GAS v4u*)ip = (v4u){(unsigned)oi[0], (unsigned)oi[1], (unsigned)oi[2], (unsigned)oi[3]}; *(GAS v4u*)(ip + 4) = (v4u){(unsigned)oi[4], (unsigned)oi[5], (unsigned)oi[6], (unsigned)oi[7]};
        *(GAS f32x4*)gp = (f32x4){og[0], og[1], og[2], og[3]}; *(GAS f32x4*)(gp + 4) = (f32x4){og[4], og[5], og[6], og[7]};
        LDS_WAIT(); asm volatile("" ::: "memory");
    }
}

#ifndef TBL_FP8
#define TBL_FP8 1
#endif
constexpr int NSL = TBL_FP8 ? 8 : 16, CW = D / NSL, ESZ = TBL_FP8 ? 1 : 2, ROWB = CW * ESZ, CPL = 16 / ESZ;
static_assert(ROWB == 128 && CPL * 8 == CW, "one cache line per (expert, slice) row, 8 lanes per row");
constexpr float U_SCALE = TBL_FP8 ? 1024.f : 1.f, V_SCALE = TBL_FP8 ? 16.f : 1.f;
__device__ __forceinline__ float dot2bf(unsigned a, unsigned b, float c) { return __builtin_amdgcn_fdot2_f32_bf16(__builtin_bit_cast(bf16x2_t, a), __builtin_bit_cast(bf16x2_t, b), c, false); }
__device__ __forceinline__ float dot8(const v4u a, const v4u b, float c) {
    c = dot2bf(a.x, b.x, c); c = dot2bf(a.y, b.y, c); c = dot2bf(a.z, b.z, c); c = dot2bf(a.w, b.w, c); return c;
}
__device__ __forceinline__ void cvt_table(const Frame& F, const float* src, unsigned char* dst, float scale) {
    const long gt = (long)(F.vcu * NWAVES + F.wave) * 64 + F.lane, NT = (long)F.G * NWAVES * 64, n8 = (long)NEXP * D / 8;
    for (long i = gt; i < n8; i += NT) { const long e = i >> 7; const int c0 = (int)(i & 127) * 8, s = c0 / CW, cc = c0 % CW;
        const f32x4 a = *(const GAS f32x4*)(src + i * 8), b = *(const GAS f32x4*)(src + i * 8 + 4);
        unsigned char* d = dst + ((size_t)s * NEXP + e) * ROWB + cc * ESZ;
#if TBL_FP8
        int w0 = 0, w1 = 0;
        w0 = __builtin_amdgcn_cvt_pk_fp8_f32(a[0] * scale, a[1] * scale, w0, false); w0 = __builtin_amdgcn_cvt_pk_fp8_f32(a[2] * scale, a[3] * scale, w0, true);
        w1 = __builtin_amdgcn_cvt_pk_fp8_f32(b[0] * scale, b[1] * scale, w1, false); w1 = __builtin_amdgcn_cvt_pk_fp8_f32(b[2] * scale, b[3] * scale, w1, true);
        *(GAS v2u*)d = (v2u){(unsigned)w0, (unsigned)w1};
#else
        (void)scale; v4u o; o.x = pk2(a[0], a[1]); o.y = pk2(a[2], a[3]); o.z = pk2(b[0], b[1]); o.w = pk2(b[2], b[3]); *(GAS v4u*)d = o;
#endif
    }
}
template <int CTRL> __device__ __forceinline__ float dpp_mov(float v) { return __builtin_bit_cast(float, __builtin_amdgcn_update_dpp(0, __builtin_bit_cast(int, v), CTRL, 0xF, 0xF, true)); }
#ifndef PEER_OPT
#define PEER_OPT 7
#endif
__device__ __forceinline__ float red8(float v) {
#if PEER_OPT & 1
    v += dpp_mov<0xB1>(v); v += dpp_mov<0x4E>(v); v += dpp_mov<0x141>(v); return v;
#else
    v += __shfl_xor(v, 1); v += __shfl_xor(v, 2); v += __shfl_xor(v, 4); return v;
#endif
}
__device__ __forceinline__ float red_groups(float v) {
#if !(PEER_OPT & 4)
    v += __shfl_xor(v, 8); v += __shfl_xor(v, 16); v += __shfl_xor(v, 32); return v;
#endif
    v += dpp_mov<0x128>(v);
    { unsigned a = __float_as_uint(v), b = a; asm volatile("" : "+v"(a), "+v"(b)); auto r = __builtin_amdgcn_permlane16_swap(a, b, false, false); v = __uint_as_float(r[0]) + __uint_as_float(r[1]); }
    { unsigned a = __float_as_uint(v), b = a; asm volatile("" : "+v"(a), "+v"(b)); auto r = __builtin_amdgcn_permlane32_swap(a, b, false, false); v = __uint_as_float(r[0]) + __uint_as_float(r[1]); }
    return v;
}
#if TBL_FP8
__device__ __forceinline__ void tbl_unpack2(const v4u w, f32x2 (&f)[8]) {
    f[0] = __builtin_amdgcn_cvt_pk_f32_fp8((int)w.x, false); f[1] = __builtin_amdgcn_cvt_pk_f32_fp8((int)w.x, true); f[2] = __builtin_amdgcn_cvt_pk_f32_fp8((int)w.y, false); f[3] = __builtin_amdgcn_cvt_pk_f32_fp8((int)w.y, true);
    f[4] = __builtin_amdgcn_cvt_pk_f32_fp8((int)w.z, false); f[5] = __builtin_amdgcn_cvt_pk_f32_fp8((int)w.z, true); f[6] = __builtin_amdgcn_cvt_pk_f32_fp8((int)w.w, false); f[7] = __builtin_amdgcn_cvt_pk_f32_fp8((int)w.w, true);
}
#endif
__device__ __forceinline__ void tbl_unpack(const v4u w, float (&f)[CPL]) {
#if TBL_FP8
#pragma unroll
    for (int i = 0; i < 4; ++i) { const unsigned x = i == 0 ? w.x : i == 1 ? w.y : i == 2 ? w.z : w.w;
        const f32x2 lo = __builtin_amdgcn_cvt_pk_f32_fp8((int)x, false), hi = __builtin_amdgcn_cvt_pk_f32_fp8((int)x, true);
        f[4 * i] = lo[0]; f[4 * i + 1] = lo[1]; f[4 * i + 2] = hi[0]; f[4 * i + 3] = hi[1]; }
#else
    f[0] = bflo(w.x); f[1] = bfhi(w.x); f[2] = bflo(w.y); f[3] = bfhi(w.y); f[4] = bflo(w.z); f[5] = bfhi(w.z); f[6] = bflo(w.w); f[7] = bfhi(w.w);
#endif
}
struct PeerArgs { const bf16* H2; const int* IDX; const float* GATE; const unsigned char* PU; const unsigned char* PV; float* PART; float* A; float* Y; float* io; const float* g_post2; const float* mod; };
__device__ __forceinline__ void pk_issue8(const unsigned char* tab, const v4u ia, const v4u ib, v4u (&w)[8]) {
    w[0] = *(const GAS v4u*)(tab + (size_t)ia.x * ROWB); w[1] = *(const GAS v4u*)(tab + (size_t)ia.y * ROWB); w[2] = *(const GAS v4u*)(tab + (size_t)ia.z * ROWB); w[3] = *(const GAS v4u*)(tab + (size_t)ia.w * ROWB);
    w[4] = *(const GAS v4u*)(tab + (size_t)ib.x * ROWB); w[5] = *(const GAS v4u*)(tab + (size_t)ib.y * ROWB); w[6] = *(const GAS v4u*)(tab + (size_t)ib.z * ROWB); w[7] = *(const GAS v4u*)(tab + (size_t)ib.w * ROWB);
}
__device__ __forceinline__ void p9_half(const v4u (&w)[8], const v4u h0, const v4u h1, float* val  ) {
#if TBL_FP8
    const f32x2 hp[8] = {{bflo(h0.x), bfhi(h0.x)}, {bflo(h0.y), bfhi(h0.y)}, {bflo(h0.z), bfhi(h0.z)}, {bflo(h0.w), bfhi(h0.w)}, {bflo(h1.x), bfhi(h1.x)}, {bflo(h1.y), bfhi(h1.y)}, {bflo(h1.z), bfhi(h1.z)}, {bflo(h1.w), bfhi(h1.w)}};
#pragma unroll
    for (int i = 0; i < 8; ++i) { f32x2 f[8]; tbl_unpack2(w[i], f);
        f32x2 s0 = f[0] * hp[0], s1 = f[1] * hp[1];
        s0 = f[2] * hp[2] + s0; s1 = f[3] * hp[3] + s1; s0 = f[4] * hp[4] + s0; s1 = f[5] * hp[5] + s1; s0 = f[6] * hp[6] + s0; s1 = f[7] * hp[7] + s1;
        const f32x2 t = s0 + s1; val[i] = red8(t.x + t.y) * (1.f / U_SCALE); }
#else
    (void)h1;
#pragma unroll
    for (int i = 0; i < 8; ++i) val[i] = red8(dot8(w[i], h0, 0.f));
#endif
}
__device__ __forceinline__ void p9_udots(const Frame& F, const PeerArgs& a) {
    const int lane = F.lane, sub = lane & 7, g8 = lane >> 3, label = F.vcu >> 5, rank = F.vcu & 31;
    constexpr int TS = 32 * NWAVES, NT = M / TS;
#pragma unroll 1
    for (int ps = 0; ps < NSL / 8; ++ps) {
        const int s = label + 8 * ps;
        const unsigned char* tab = a.PU + (size_t)s * NEXP * ROWB + sub * 16;
        float* part = a.PART + (size_t)label * M * 128;
        const int t0 = rank * NWAVES + F.wave;
        v4u wA[8], wB[8], ix0, ix1, ix2, ix3, h0, h1 = {0u, 0u, 0u, 0u}, n0, n1 = {0u, 0u, 0u, 0u};
        { const GAS v4u* ip = (const GAS v4u*)(a.IDX + (size_t)t0 * 128 + 16 * g8); ix0 = ip[0]; ix1 = ip[1]; ix2 = ip[2]; ix3 = ip[3]; }
        pk_issue8(tab, ix0, ix1, wA); pk_issue8(tab, ix2, ix3, wB);
        { const bf16* hp = a.H2 + (size_t)t0 * D + s * CW + sub * CPL; h0 = *(const GAS v4u*)hp; if (TBL_FP8) h1 = *(const GAS v4u*)(hp + 8); }
        { const GAS v4u* ip = (const GAS v4u*)(a.IDX + (size_t)(t0 + TS) * 128 + 16 * g8); ix0 = ip[0]; ix1 = ip[1]; ix2 = ip[2]; ix3 = ip[3]; }
#pragma unroll 1
        for (int k = 0; k < NT; ++k) { const int tk = t0 + k * TS, tn = (k + 1 < NT) ? tk + TS : tk, tnn = (k + 2 < NT) ? tk + 2 * TS : tk;
            float val[16];
            p9_half(wA, h0, h1, val); SBAR();
            pk_issue8(tab, ix0, ix1, wA); SBAR();
            p9_half(wB, h0, h1, val + 8); SBAR();
            pk_issue8(tab, ix2, ix3, wB); { const bf16* hp = a.H2 + (size_t)tn * D + s * CW + sub * CPL; n0 = *(const GAS v4u*)hp; if (TBL_FP8) n1 = *(const GAS v4u*)(hp + 8); }
            { const GAS v4u* ip = (const GAS v4u*)(a.IDX + (size_t)tnn * 128 + 16 * g8); ix0 = ip[0]; ix1 = ip[1]; ix2 = ip[2]; ix3 = ip[3]; } SBAR();
            if (sub == 0) { GAS f32x4* pp = (GAS f32x4*)(part + (size_t)tk * 128 + 16 * g8);
#pragma unroll
                for (int q = 0; q < 4; ++q) { f32x4 v = {val[4 * q], val[4 * q + 1], val[4 * q + 2], val[4 * q + 3]}; if (ps > 0) v += pp[q]; pp[q] = v; } }
            h0 = n0; h1 = n1;
        }
    }
}
__device__ __forceinline__ void p10_acomb(const Frame& F, const PeerArgs& a) {
    const long gt = (long)(F.vcu * NWAVES + F.wave) * 64 + F.lane, NT = (long)F.G * NWAVES * 64, n4 = (long)M * 128 / 4;
    for (long i = gt; i < n4; i += NT) { f32x4 s = *(const GAS f32x4*)(a.PART + i * 4);
#pragma unroll
        for (int j = 1; j < 8; ++j) s += *(const GAS f32x4*)(a.PART + (size_t)j * M * 128 + i * 4);
        const f32x4 g = *(const GAS f32x4*)(a.GATE + i * 4);
        *(GAS f32x4*)(a.A + i * 4) = (f32x4){gelu_tanh(s[0]) * g[0], gelu_tanh(s[1]) * g[1], gelu_tanh(s[2]) * g[2], gelu_tanh(s[3]) * g[3]}; }
}
__device__ __forceinline__ void p11_half(const v4u (&w)[8], const f32x4 aa, const f32x4 ab, float (&acc)[CPL]) {
#pragma unroll
    for (int i = 0; i < 8; ++i) { const float ai = i == 0 ? aa.x : i == 1 ? aa.y : i == 2 ? aa.z : i == 3 ? aa.w : i == 4 ? ab.x : i == 5 ? ab.y : i == 6 ? ab.z : ab.w;
#if TBL_FP8
        f32x2 f[8]; tbl_unpack2(w[i], f); const f32x2 a2 = {ai, ai};
#pragma unroll
        for (int c = 0; c < 8; ++c) { f32x2 t = {acc[2 * c], acc[2 * c + 1]}; t = f[c] * a2 + t; acc[2 * c] = t.x; acc[2 * c + 1] = t.y; }
#else
        float f[CPL]; tbl_unpack(w[i], f);
#pragma unroll
        for (int c = 0; c < CPL; ++c) acc[c] += ai * f[c];
#endif
    }
}
__device__ __forceinline__ void p11_vaxpy(const Frame& F, const PeerArgs& a) {
    const int lane = F.lane, sub = lane & 7, g8 = lane >> 3, label = F.vcu >> 5, rank = F.vcu & 31;
    constexpr int TS = 32 * NWAVES, NT = M / TS;
#pragma unroll 1
    for (int ps = 0; ps < NSL / 8; ++ps) {
        const int s = label + 8 * ps;
        const unsigned char* tab = a.PV + (size_t)s * NEXP * ROWB + sub * 16;
        const int t0 = rank * NWAVES + F.wave;
        v4u wA[8], wB[8], ix0, ix1, ix2, ix3; f32x4 a0, a1, a2, a3, m0, m1, m2, m3;
        { const GAS v4u* ip = (const GAS v4u*)(a.IDX + (size_t)t0 * 128 + 16 * g8); ix0 = ip[0]; ix1 = ip[1]; ix2 = ip[2]; ix3 = ip[3]; }
        pk_issue8(tab, ix0, ix1, wA); pk_issue8(tab, ix2, ix3, wB);
        { const GAS f32x4* ap = (const GAS f32x4*)(a.A + (size_t)t0 * 128 + 16 * g8); a0 = ap[0]; a1 = ap[1]; a2 = ap[2]; a3 = ap[3]; }
        { const GAS v4u* ip = (const GAS v4u*)(a.IDX + (size_t)(t0 + TS) * 128 + 16 * g8); ix0 = ip[0]; ix1 = ip[1]; ix2 = ip[2]; ix3 = ip[3]; }
        m0 = a0; m1 = a1; m2 = a2; m3 = a3;
#pragma unroll 1
        for (int k = 0; k < NT; ++k) { const int tk = t0 + k * TS, tn = (k + 1 < NT) ? tk + TS : tk, tnn = (k + 2 < NT) ? tk + 2 * TS : tk;
            float acc[CPL];
#pragma unroll
            for (int c = 0; c < CPL; ++c) acc[c] = 0.f;
            p11_half(wA, a0, a1, acc); SBAR();
            pk_issue8(tab, ix0, ix1, wA); SBAR();
            p11_half(wB, a2, a3, acc); SBAR();
            pk_issue8(tab, ix2, ix3, wB); { const GAS f32x4* ap = (const GAS f32x4*)(a.A + (size_t)tn * 128 + 16 * g8); m0 = ap[0]; m1 = ap[1]; m2 = ap[2]; m3 = ap[3]; }
            { const GAS v4u* ip = (const GAS v4u*)(a.IDX + (size_t)tnn * 128 + 16 * g8); ix0 = ip[0]; ix1 = ip[1]; ix2 = ip[2]; ix3 = ip[3]; } SBAR();
#pragma unroll
            for (int c = 0; c < CPL; ++c) acc[c] = red_groups(acc[c]) * (1.f / V_SCALE);
            if (g8 == 0) { GAS f32x4* yp = (GAS f32x4*)(a.Y + (size_t)tk * D + s * CW + sub * CPL);
#pragma unroll
                for (int q = 0; q < CPL / 4; ++q) yp[q] = (f32x4){acc[4 * q], acc[4 * q + 1], acc[4 * q + 2], acc[4 * q + 3]}; }
            a0 = m0; a1 = m1; a2 = m2; a3 = m3;
        }
    }
}
__device__ __forceinline__ void p12_final(const Frame& F, const PeerArgs& a) {
    const int gw = F.vcu * NWAVES + F.wave, NGW = F.G * NWAVES;
    for (int m = gw; m < M; m += NGW) { const int b = m >> 12; const float* gt2 = a.mod + b * NMOD + 5 * D;
        const GAS f32x4* yr = (const GAS f32x4*)(a.Y + (size_t)m * D) + F.lane; GAS f32x4* orow = (GAS f32x4*)(a.io + (size_t)m * D) + F.lane;
        f32x4 v[4]; float ss = 0.f;
#pragma unroll
        for (int j = 0; j < 4; ++j) { v[j] = yr[64 * j]; ss += (v[j].x * v[j].x + v[j].y * v[j].y) + (v[j].z * v[j].z + v[j].w * v[j].w); }
        const float rs = 1.f / sqrtf(wave_sum(ss) * (1.f / D) + EPS);
#pragma unroll
        for (int j = 0; j < 4; ++j) { const int col = 256 * j + 4 * F.lane; const f32x4 g = *(const f32x4*)(a.g_post2 + col), gt = *(const f32x4*)(gt2 + col);
            orow[64 * j] = orow[64 * j] + gt * (v[j] * rs * g); }
    }
}


#ifndef DBG_STOP
#define DBG_STOP 99
#endif
__device__ __forceinline__ void dbg_dump(const Frame& F, float* out, const bf16* b0, const bf16* b1, const bf16* b2, const bf16* b3, const bf16* b4) {
    const int gw = F.vcu * NWAVES + F.wave, NGW = F.G * NWAVES;
    for (int m = gw; m < M; m += NGW) {
#pragma unroll
        for (int j = 0; j < 4; ++j) { const size_t off = (size_t)m * D + 256 * j + 4 * F.lane; f32x4 s = {0.f, 0.f, 0.f, 0.f};
            const bf16* bs[5] = {b0, b1, b2, b3, b4};
#pragma unroll
            for (int k = 0; k < 5; ++k) if (bs[k]) { const v2u w = *(const GAS v2u*)(bs[k] + off); s += (f32x4){bflo(w.x), bfhi(w.x), bflo(w.y), bfhi(w.y)}; }
            *(GAS f32x4*)(out + off) = s; }
    }
}
struct Args { const void* in[26]; float* out; unsigned char* ws; int ph_lo, ph_hi; };
__global__ void __launch_bounds__(NWAVES * 64, 2) mk_fwd(Args args) {
    extern __shared__ __attribute__((aligned(16))) unsigned char lds[];
    Frame F;
    F.lds = (LAS unsigned char*)lds;
    F.tid = threadIdx.x; F.lane = F.tid & 63; F.wave = __builtin_amdgcn_readfirstlane(F.tid >> 6);
    F.G = gridDim.x; { const int bx = blockIdx.x; F.vcu = (F.G % 8 == 0) ? (bx % 8) * (F.G / 8) + bx / 8 : bx; }
    unsigned char* ws = args.ws;
    gu32* ctl = (gu32*)(ws + WS_CTL);
    volatile LAS unsigned* MISC = (volatile LAS unsigned*)(F.lds + MISC_OFF);
    for (int u = F.tid; u < (LDS_BYTES - LDSCTL_OFF) / 4; u += NWAVES * 64) ((LAS unsigned*)(F.lds + LDSCTL_OFF))[u] = 0u;
    __syncthreads();
    XcdBarrier bar; bar.bar = (unsigned*)(ctl + CW_BAR); bar.x = 0; bar.st = nullptr;
    if (N_LAUNCHES == 1) bar = xcd_barrier_post((unsigned*)(ctl + CW_BAR), MISC + 8);
#define GRID_BAR() do { if (N_LAUNCHES == 1) xcd_barrier(bar); } while (0)
    const int lo = args.ph_lo, hi = args.ph_hi;
#ifndef PH_MASK
#define PH_MASK 0x1FFF
#endif
#define IN(k) ((((PH_MASK) >> (k)) & 1) && (k) <= DBG_STOP && lo <= (k) && (k) < hi)
#define BOTH(k) (IN(k) && IN((k) + 1))
#ifndef REP_MASK
#define REP_MASK 0
#endif
#define NREP(k) ((((REP_MASK) >> (k)) & 1) ? 2 : 1)
    const float* x = (const float*)args.in[0]; const float* mod = (const float*)(ws + WS_MOD);
    float* out = args.out;
    bf16* GA = (bf16*)out; bf16* GG = (bf16*)out + (size_t)M * D;

    if (IN(0)) {
        P0Args a{(const float*)args.in[1], (const float*)args.in[3], (const float*)args.in[4], (const float*)args.in[7], (const float*)args.in[13], (const float*)args.in[18], (const float*)args.in[19],
                 (const float*)args.in[22], (const float*)args.in[23], (const float*)args.in[16], (const int*)args.in[2], ws};
        for (int rep = 0; rep < NREP(0); ++rep) p0_prologue(F, a); if (BOTH(0)) GRID_BAR();
    }
    if (IN(1)) { for (int rep = 0; rep < NREP(1); ++rep) p1_xn(F, x, (const float*)args.in[5], mod, (bf16*)(ws + WS_XN)); if (BOTH(1)) GRID_BAR(); }
    if (IN(2)) {
        pg8::Gemm g{(const bf16*)(ws + WS_XN), nullptr, (const bf16*)(ws + WS_WIN), nullptr, M, NIN, D}; pg8::StaticOrder S; S.init(M, NIN, F.G, (int)blockIdx.x);
        pg8::EpiInProj E{(bf16*)(ws + WS_Q), (bf16*)(ws + WS_K), (bf16*)(ws + WS_V), (bf16*)(ws + WS_U), (bf16*)(ws + WS_ZV), GA, GG, (const float*)(ws + WS_ROPE), (float*)(ws + WS_STATS)};
        for (int rep = 0; rep < NREP(2); ++rep) pg8::gemm_phase<pg8::EpiInProj, pg8::StaticOrder, true, true>(F.lds, g, S, E);
        if (BOTH(2)) GRID_BAR();
    }
    if (IN(3)) {
        GmlpArgs ga{(const bf16*)(ws + WS_ZV), (bf16*)(ws + WS_U), (const float*)(ws + WS_STATS), (const float*)args.in[14], (const float*)args.in[15], (const bf16*)(ws + WS_WSP), (const float*)args.in[17]};
#ifndef NO_GMLP
        p3_gmlp(F, ga);
#endif
        float lam;
        { const float* lq1 = (const float*)args.in[8]; const float* lk1 = (const float*)args.in[9]; const float* lq2 = (const float*)args.in[10]; const float* lk2 = (const float*)args.in[11];
          float s1 = 0.f, s2 = 0.f; for (int i = 0; i < 64; ++i) { s1 += lq1[i] * lk1[i]; s2 += lq2[i] * lk2[i]; }
          lam = __expf(s1) - __expf(s2) + 0.2f; }
        const bf16* Qb = (const bf16*)(ws + WS_Q); const bf16* Kb = (const bf16*)(ws + WS_K); const bf16* Vb = (const bf16*)(ws + WS_V);
        float* stash = (float*)(ws + WS_O0) + (size_t)blockIdx.x * 32768;
#ifndef NO_ATT
#ifndef ATT_VAR
#define ATT_VAR 0
#endif
        if (NREP(3) == 2)
        for (int uu = F.vcu; uu < 1024; uu += F.G) {
            const int bh = uu >> 4, qb = uu & 15, b = bh >> 3, h = bh & 7; const size_t ro = (size_t)b * SEQ * D + h * 128;
            att::attn_unit(Qb + ro, Kb + ro, Vb + ro, (bf16*)(ws + 424 * MiB) + ro, qb * 256, lam, (const float*)args.in[12], stash, (char*)lds); }
        for (int uu = F.vcu; uu < 1024; uu += F.G) {
            const int bh = uu >> 4, qb = uu & 15, b = bh >> 3, h = bh & 7; const size_t ro = (size_t)b * SEQ * D + h * 128;
            att::attn_unit(Qb + ro, Kb + ro, Vb + ro, (bf16*)(ws + WS_Q) + ro, qb * 256, lam, (const float*)args.in[12], stash, (char*)lds); }
#endif
        if (BOTH(3)) GRID_BAR();
    }
    if (IN(4)) {
        pg8::Gemm g{(const bf16*)(ws + WS_Q), (const bf16*)(ws + WS_U), (const bf16*)(ws + WS_WA), (const bf16*)(ws + WS_WG), M, D, D}; pg8::StaticOrder S; S.init(M, D, F.G, (int)blockIdx.x, 2);
        pg8::EpiMerge E{GA, GG, (bf16*)(ws + WS_MIXIN)};
        for (int rep = 0; rep < NREP(4); ++rep) pg8::gemm_phase<pg8::EpiMerge, pg8::StaticOrder, true, true>(F.lds, g, S, E);
        if (BOTH(4)) GRID_BAR();
    }
    if (IN(5)) {
        pg8::Gemm g{(const bf16*)(ws + WS_MIXIN), nullptr, (const bf16*)(ws + WS_WOUT), nullptr, M, D, D}; pg8::StaticOrder S; S.init(M, D, F.G, (int)blockIdx.x);
        pg8::EpiF32 E{out, D};
        for (int rep = 0; rep < NREP(5); ++rep) pg8::gemm_phase<pg8::EpiF32, pg8::StaticOrder, true, true>(F.lds, g, S, E);
        if (BOTH(5)) GRID_BAR();
    }
    if (IN(6)) {
        p6_rows(F, x, out, (const float*)args.in[6], (const float*)args.in[20], mod, (bf16*)(ws + WS_H2));
        cvt_table(F, (const float*)args.in[24], ws + WS_PU, U_SCALE);
        cvt_table(F, (const float*)args.in[25], ws + WS_PV, V_SCALE);
        if (BOTH(6)) GRID_BAR();
    }
    if (IN(7)) {
        pg8::Gemm g{(const bf16*)(ws + WS_H2), nullptr, (const bf16*)(ws + WS_WPQ), nullptr, M, NPQ, D}; pg8::StaticOrder S; S.init(M, NPQ, F.G, (int)blockIdx.x);
        pg8::EpiBf16<0> E{(bf16*)(ws + WS_QP), NPQ, nullptr, 0, 0, 1.f};
        for (int rep = 0; rep < NREP(7); ++rep) pg8::gemm_phase<pg8::EpiBf16<0>, pg8::StaticOrder, true, true>(F.lds, g, S, E);
        if (BOTH(7)) GRID_BAR();
    }
    if (IN(8)) { RouteArgs ra{(const bf16*)(ws + WS_QP), (const bf16*)(ws + WS_KEYS), (int*)(ws + WS_IDX), (float*)(ws + WS_GATE)}; for (int rep = 0; rep < NREP(8); ++rep) p8_route(F, ra); if (BOTH(8)) GRID_BAR(); }
    PeerArgs pa{(const bf16*)(ws + WS_H2), (const int*)(ws + WS_IDX), (const float*)(ws + WS_GATE), ws + WS_PU, ws + WS_PV, (float*)(ws + WS_PART), (float*)(ws + WS_A), (float*)(ws + WS_Y), out, (const float*)args.in[21], mod};
    if (IN(9)) { for (int rep = 0; rep < NREP(9); ++rep) p9_udots(F, pa); if (BOTH(9)) GRID_BAR(); }
    if (IN(10)) { for (int rep = 0; rep < NREP(10); ++rep) p10_acomb(F, pa); if (BOTH(10)) GRID_BAR(); }
    if (IN(11)) { for (int rep = 0; rep < NREP(11); ++rep) p11_vaxpy(F, pa); if (BOTH(11)) GRID_BAR(); }
    if (IN(12)) { p12_final(F, pa); }
    if (DBG_STOP < 9 && lo <= DBG_STOP && DBG_STOP < hi) {
        if (N_LAUNCHES == 1) GRID_BAR();
        if (N_LAUNCHES != 1) {   }
    }
    if (DBG_STOP < 9 && ((N_LAUNCHES == 1 && hi > DBG_STOP) || (N_LAUNCHES != 1 && lo == DBG_STOP + 1))) {
        if (DBG_STOP == 2) dbg_dump(F, out, GA, nullptr, nullptr, nullptr, nullptr);
        if (DBG_STOP == 3) dbg_dump(F, out, (const bf16*)(ws + WS_Q), (const bf16*)(ws + WS_U), nullptr, nullptr, nullptr);
        if (DBG_STOP == 4) dbg_dump(F, out, (const bf16*)(ws + WS_MIXIN), nullptr, nullptr, nullptr, nullptr);

        if (DBG_STOP == 7) dbg_dump(F, out, (const bf16*)(ws + WS_QP), (const bf16*)(ws + WS_QP) + (size_t)M * D, nullptr, nullptr, nullptr);
        if (DBG_STOP == 8) dbg_dump(F, out, (const bf16*)(ws + WS_IDX), (const bf16*)(ws + WS_GATE), nullptr, nullptr, nullptr);
    }
#undef IN
#undef BOTH
}

extern "C" void kernel_launch(void* const* d_in, const int* in_sizes, int n_in, void* d_out, int out_size, void* d_ws, size_t ws_size, hipStream_t stream) {
    static int grid = 0;
    if (grid == 0) {
        if (n_in != 26 || in_sizes[0] != M * D || out_size != M * D || ws_size < WS_END) { fprintf(stderr, "kernel_launch: shape/workspace mismatch (n_in %d, in0 %d, out %d, ws %zu, need %zu)\n", n_in, n_in > 0 ? in_sizes[0] : -1, out_size, ws_size, (size_t)WS_END); grid = -1; return; }
        int dev = 0, cus = 0, per_cu = 0;
        if (hipGetDevice(&dev) != hipSuccess || hipDeviceGetAttribute(&cus, hipDeviceAttributeMultiprocessorCount, dev) != hipSuccess) { grid = -1; return; }
        if (hipFuncSetAttribute((const void*)mk_fwd, hipFuncAttributeMaxDynamicSharedMemorySize, LDS_BYTES) != hipSuccess) { fprintf(stderr, "kernel_launch: hipFuncSetAttribute failed\n"); grid = -1; return; }
        if (hipOccupancyMaxActiveBlocksPerMultiprocessor(&per_cu, (const void*)mk_fwd, NWAVES * 64, LDS_BYTES) != hipSuccess || per_cu < 1) { fprintf(stderr, "kernel_launch: occupancy query says %d\n", per_cu); per_cu = 1; }
        (void)hipGetLastError();
        grid = cus;
        if (grid % 8 != 0 || grid > 256) fprintf(stderr, "kernel_launch: note: grid %d\n", grid);
    }
    if (grid < 0) return;
    if (hipMemsetAsync((char*)d_ws + WS_CTL, 0, CTL_ZERO_BYTES, stream) != hipSuccess) { fprintf(stderr, "kernel_launch: memset failed\n"); return; }
    Args a{};
    for (int i = 0; i < 26; ++i) a.in[i] = d_in[i];
    a.out = (float*)d_out; a.ws = (unsigned char*)d_ws;
    for (int li = 0; li < N_LAUNCHES; ++li) {
        a.ph_lo = (N_LAUNCHES == 1) ? 0 : li; a.ph_hi = (N_LAUNCHES == 1) ? NPHASE : li + 1;
        hipLaunchKernelGGL(mk_fwd, dim3(grid), dim3(NWAVES * 64), LDS_BYTES, stream, a);
        const hipError_t le = hipPeekAtLastError();
        if (le != hipSuccess) { fprintf(stderr, "kernel_launch: launch %d failed: %s\n", li, hipGetErrorName(le)); break; }
    }
}
```

```cpp
#include <hip/hip_runtime.h>
#include <cstdio>
#include <cstdint>
namespace pg8 {
#define PG8_LAS __attribute__((address_space(3)))
typedef unsigned short bf16_t;
typedef short bf16x8 __attribute__((ext_vector_type(8)));
typedef float f32x4 __attribute__((ext_vector_type(4)));
typedef unsigned u32x4 __attribute__((ext_vector_type(4)));
constexpr int BM = 256, BK = 64, HALF = 128, HTB = HALF * BK * 2  , STAGE_BYTES = 8 * HTB, NXCD = 8, WGM = 8;

__host__ __device__ __forceinline__ int lds_byte(int r, int c) { const int st = (r >> 4) * 2 + (c >> 5), rr = r & 15, cc = c & 31, ob = rr * 64 + cc * 2; return st * 1024 + (ob ^ (((ob >> 9) & 1) << 5)); }
__host__ __device__ __forceinline__ void stage_rc(int b, int& R, int& C) { const int st = b / 1024, sb = b % 1024, swz = sb ^ (((sb >> 9) & 1) << 5); R = (st >> 1) * 16 + swz / 64; C = (st & 1) * 32 + (swz % 64) / 2; }
__host__ __device__ __forceinline__ int perm32(int rho) { const int n = rho >> 4, i = rho & 15; return 8 * (i >> 2) + 4 * n + (i & 3); }

struct Unit { int pm, pn, w; };
struct Gemm { const bf16_t* A0; const bf16_t* A1; const bf16_t* B0; const bf16_t* B1; int M, N, K; };

struct StaticOrder {
    int nM, nN, nwg, G, c, passes;
    __host__ __device__ void init(int M, int N, int G_, int c_, int passes_ = 1) { nM = M / BM; nN = N / BM; nwg = nM * nN; G = G_; c = c_; passes = passes_; }
    __host__ __device__ bool next(int i, Unit& u) const {
        const int ti = (passes == 2) ? (i >> 1) : i; u.w = (passes == 2) ? (i & 1) : 0;
        const long L = (long)ti * G + c; if (L >= nwg) return false;
        int wgid = (int)L; { const int q = nwg / NXCD, r = nwg % NXCD, xcd = wgid % NXCD, off = wgid / NXCD; wgid = (xcd < r ? xcd * (q + 1) : r * (q + 1) + (xcd - r) * q) + off; }
        const int nig = WGM * nN, gid = wgid / nig, fm = gid * WGM, gsz = (nM - fm) < WGM ? (nM - fm) : WGM;
        u.pm = fm + ((wgid % nig) % gsz); u.pn = (wgid % nig) / gsz; return true;
    }
    __device__ __forceinline__ void a_ready(const Unit&) const {}
    __device__ __forceinline__ void done(const Unit&) const {}
};

typedef float f32x2c __attribute__((ext_vector_type(2))); typedef __bf16 bf16x2c __attribute__((ext_vector_type(2)));
__device__ __forceinline__ unsigned cvt_pk_bf16(float lo, float hi) { f32x2c v = {lo, hi}; bf16x2c b = __builtin_convertvector(v, bf16x2c); return __builtin_bit_cast(unsigned, b); }
typedef float f32x2 __attribute__((ext_vector_type(2)));
__device__ __forceinline__ f32x2 gelu_pk(f32x2 v) {
    const f32x2 av = __builtin_elementwise_abs(v), d = av * 0.2316418882f + 1.0f;
    f32x2 t; t.x = __builtin_amdgcn_rcpf(d.x); t.y = __builtin_amdgcn_rcpf(d.y);
    f32x2 q = t * 0.5307027145f + (-0.7265760135f); q = q * t + 0.7107068705f; q = q * t + (-0.142248368f); q = q * t + 0.127414796f; q = q * t;
    const f32x2 s = (v * v) * (-0.72134752044f);
    f32x2 e; e.x = __builtin_amdgcn_exp2f(s.x); e.y = __builtin_amdgcn_exp2f(s.y);
    const f32x2 m = v * (q * e), r = v - m;
    f32x2 o; o.x = v.x < 0.f ? m.x : r.x; o.y = v.y < 0.f ? m.y : r.y; return o;
}

template <int ACT  > struct EpiBf16 {
    static constexpr bool PERM = true, AFTER_DRAIN = false; static_assert(ACT == 0 || ACT == 1, "EpiBf16: ACT is 0 (none) or 1 (gelu_pk)");
    bf16_t* O; int ldc; const float* bias; int split_cols; size_t split_stride; float scale0;
    __device__ __forceinline__ void operator()(const f32x4 (&acc)[2][2][4][2], const Unit& u, int wr, int wc, int fr, int fq) const {
        const int row0 = u.pm * BM + wr * 64 + fr; int colt = u.pn * BM; bf16_t* base = O;
        float sc = 1.f; if (split_cols) { const int t = colt / split_cols; base += (size_t)t * split_stride; colt -= t * split_cols; if (t == 0) sc = scale0; }
        const int col0 = colt + wc * 32 + 8 * fq, bcol0 = u.pn * BM + wc * 32 + 8 * fq;
        f32x4 bv[2][2];
#pragma unroll
        for (int bj = 0; bj < 2; ++bj)
#pragma unroll
            for (int n = 0; n < 2; ++n) bv[bj][n] = bias ? *(const f32x4*)(bias + bcol0 + bj * HALF + 4 * n) : (f32x4){0.f, 0.f, 0.f, 0.f};
#pragma unroll
        for (int ai = 0; ai < 2; ++ai)
#pragma unroll
            for (int m = 0; m < 4; ++m) { bf16_t* rowp = base + (size_t)(row0 + ai * HALF + m * 16) * ldc + col0;
#pragma unroll
                for (int bj = 0; bj < 2; ++bj) { f32x4 v0 = acc[ai][bj][m][0] + bv[bj][0], v1 = acc[ai][bj][m][1] + bv[bj][1];
                    if (ACT == 1) { f32x2 a = gelu_pk((f32x2){v0[0], v0[1]}), b = gelu_pk((f32x2){v0[2], v0[3]}), c = gelu_pk((f32x2){v1[0], v1[1]}), d = gelu_pk((f32x2){v1[2], v1[3]});
                        v0 = (f32x4){a.x, a.y, b.x, b.y}; v1 = (f32x4){c.x, c.y, d.x, d.y}; }
                    v0 = v0 * sc; v1 = v1 * sc; u32x4 w; w.x = cvt_pk_bf16(v0[0], v0[1]); w.y = cvt_pk_bf16(v0[2], v0[3]); w.z = cvt_pk_bf16(v1[0], v1[1]); w.w = cvt_pk_bf16(v1[2], v1[3]);
                    *(u32x4*)(rowp + bj * HALF) = w; } }
    }
};

template <class Epi, class Sched, bool ALIGN_EPI = false, bool SP2 = false>
__device__ __forceinline__ void gemm_phase(PG8_LAS unsigned char* lds, const Gemm g, const Sched& S, const Epi& E) {
    const int tid = threadIdx.x, wid = __builtin_amdgcn_readfirstlane(tid >> 6), lane = tid & 63, wr = wid >> 2, wc = wid & 3, fr = lane & 15, fq = lane >> 4;
    const int K = g.K, nt = K / BK;
    unsigned voffA[2], voffB[2];
#pragma unroll
    for (int i = 0; i < 2; ++i) { int R, C; stage_rc(tid * 16 + i * 8192, R, C); const int Rb = Epi::PERM ? ((R & ~31) + perm32(R & 31)) : R;
        voffA[i] = (unsigned)(R * K + C) * 2u; voffB[i] = (unsigned)(Rb * K + C) * 2u; }
    const size_t kstep = (size_t)(BK * 2);
    const size_t hstep = (size_t)HALF * K * 2;
    const size_t tstep = 2 * hstep;
    const unsigned ldsw = (unsigned)wid * 1024u;
    const int aoff = lds_byte(wr * 64 + fr, fq * 8), boff = lds_byte(wc * 32 + fr, fq * 8);
#define PG8_SA(b, h) (((b) * 2 + (h)) * HTB)
#define PG8_SB(b, h) ((4 + (b) * 2 + (h)) * HTB)
#define PG8_STAGE(bufoff, gbase, voff) do { _Pragma("unroll") for (int _i = 0; _i < 2; ++_i) \
        __builtin_amdgcn_global_load_lds((const unsigned*)((const char*)(gbase) + (voff)[_i]), (PG8_LAS unsigned*)(lds + (bufoff) + ldsw + _i * 8192), 16, 0, 0); } while (0)
#define PG8_LDA(dst, b, h) do { _Pragma("unroll") for (int m = 0; m < 4; ++m) _Pragma("unroll") for (int k = 0; k < 2; ++k) dst[m][k] = *(const PG8_LAS bf16x8*)(lds + PG8_SA(b, h) + aoff + m * 2048 + k * 1024); } while (0)
#define PG8_LDB(dst, b, h) do { _Pragma("unroll") for (int n = 0; n < 2; ++n) _Pragma("unroll") for (int k = 0; k < 2; ++k) dst[n][k] = *(const PG8_LAS bf16x8*)(lds + PG8_SB(b, h) + boff + n * 2048 + k * 1024); } while (0)
#define PG8_MMA(ai, bj, At, Bt) do { __builtin_amdgcn_s_setprio(1); _Pragma("unroll") for (int m = 0; m < 4; ++m) _Pragma("unroll") for (int n = 0; n < 2; ++n) _Pragma("unroll") for (int k = 0; k < 2; ++k) \
        acc[ai][bj][m][n] = __builtin_amdgcn_mfma_f32_16x16x32_bf16(Bt[n][k], At[m][k], acc[ai][bj][m][n], 0, 0, 0); __builtin_amdgcn_s_setprio(0); } while (0)
#define PG8_WAIT_V(n) asm volatile("s_waitcnt vmcnt(" #n ")" ::: "memory")
#define PG8_WAIT_L(n) asm volatile("s_waitcnt lgkmcnt(" #n ")" ::: "memory")
#define PG8_BAR __builtin_amdgcn_s_barrier()
#define PG8_SCHED __builtin_amdgcn_sched_barrier(0)
    Unit cur, nxt; int ui = 0;
    if (!S.next(0, cur)) return;
    f32x4 acc[2][2][4][2];
#pragma unroll
    for (int a = 0; a < 2; ++a)
#pragma unroll
        for (int b = 0; b < 2; ++b)
#pragma unroll
            for (int m = 0; m < 4; ++m)
#pragma unroll
                for (int n = 0; n < 2; ++n) acc[a][b][m][n] = (f32x4){0.f, 0.f, 0.f, 0.f};
    bf16x8 At[4][2], B0[2][2], B1[2][2];
    const char* cA = (const char*)(cur.w ? g.A1 : g.A0) + (size_t)cur.pm * tstep; const char* cB = (const char*)(cur.w ? g.B1 : g.B0) + (size_t)cur.pn * tstep;
    S.a_ready(cur);
    if constexpr (SP2) {
        PG8_STAGE(PG8_SB(0, 0), cB, voffB); PG8_STAGE(PG8_SB(0, 1), cB + hstep, voffB); PG8_STAGE(PG8_SA(0, 0), cA, voffA); PG8_STAGE(PG8_SA(0, 1), cA + hstep, voffA);
        if (wr == 1) PG8_BAR;
        PG8_WAIT_V(2); PG8_BAR;
        PG8_STAGE(PG8_SB(1, 0), cB + kstep, voffB); PG8_STAGE(PG8_SA(1, 0), cA + kstep, voffA); PG8_STAGE(PG8_SB(1, 1), cB + hstep + kstep, voffB);
        PG8_WAIT_V(6); PG8_BAR;
    } else {
        PG8_STAGE(PG8_SB(0, 0), cB, voffB); PG8_STAGE(PG8_SA(0, 0), cA, voffA); PG8_STAGE(PG8_SB(0, 1), cB + hstep, voffB); PG8_STAGE(PG8_SA(0, 1), cA + hstep, voffA);
        if (wr == 1) PG8_BAR;
        PG8_WAIT_V(4); PG8_BAR;
        PG8_STAGE(PG8_SB(1, 0), cB + kstep, voffB); PG8_STAGE(PG8_SA(1, 0), cA + kstep, voffA); PG8_STAGE(PG8_SB(1, 1), cB + hstep + kstep, voffB);
        PG8_WAIT_V(6); PG8_BAR;
    }
    for (;;) {
        const bool has_next = S.next(ui + 1, nxt);
        const char* nA = has_next ? (const char*)(nxt.w ? g.A1 : g.A0) + (size_t)nxt.pm * tstep : cA; const char* nB = has_next ? (const char*)(nxt.w ? g.B1 : g.B0) + (size_t)nxt.pn * tstep : cB;
        for (int t = 0; t < nt; t += 2) {
            const bool last = (t == nt - 2);
            const char* a1 = cA + (size_t)(t + 1) * kstep;
            const char* a2 = last ? nA : cA + (size_t)(t + 2) * kstep; const char* b2 = last ? nB : cB + (size_t)(t + 2) * kstep;
            const char* a3 = a2 + kstep; const char* b3 = b2 + kstep;
            if (last && has_next) S.a_ready(nxt);
            if constexpr (SP2) {
            PG8_LDB(B0, 0, 0); PG8_LDB(B1, 0, 1); PG8_SCHED; PG8_LDA(At, 0, 0); PG8_STAGE(PG8_SA(1, 1), a1 + hstep, voffA);
            PG8_WAIT_V(8); PG8_WAIT_L(0); PG8_BAR; PG8_MMA(0, 0, At, B0); PG8_MMA(0, 1, At, B1); PG8_BAR; PG8_SCHED;
            PG8_LDA(At, 0, 1); PG8_STAGE(PG8_SB(0, 0), b2, voffB); PG8_STAGE(PG8_SB(0, 1), b2 + hstep, voffB); PG8_STAGE(PG8_SA(0, 0), a2, voffA);
            PG8_WAIT_V(8); PG8_WAIT_L(0); PG8_BAR; PG8_MMA(1, 0, At, B0); PG8_MMA(1, 1, At, B1); PG8_BAR; PG8_SCHED;
            PG8_LDB(B0, 1, 0); PG8_LDB(B1, 1, 1); PG8_SCHED; PG8_LDA(At, 1, 0); PG8_STAGE(PG8_SA(0, 1), a2 + hstep, voffA);
            PG8_WAIT_V(8); PG8_WAIT_L(0); PG8_BAR; PG8_MMA(0, 0, At, B0); PG8_MMA(0, 1, At, B1); PG8_BAR; PG8_SCHED;
            PG8_LDA(At, 1, 1); PG8_STAGE(PG8_SB(1, 0), b3, voffB); PG8_STAGE(PG8_SB(1, 1), b3 + hstep, voffB); PG8_STAGE(PG8_SA(1, 0), a3, voffA);
            PG8_WAIT_V(8); PG8_WAIT_L(0); PG8_BAR; PG8_MMA(1, 0, At, B0); PG8_MMA(1, 1, At, B1); PG8_BAR; PG8_SCHED;
            } else {
            PG8_LDB(B0, 0, 0); PG8_SCHED; PG8_LDA(At, 0, 0); PG8_STAGE(PG8_SA(1, 1), a1 + hstep, voffA);
            PG8_WAIT_L(8); PG8_BAR; PG8_WAIT_L(0); PG8_MMA(0, 0, At, B0); PG8_BAR; PG8_SCHED;
            PG8_LDB(B1, 0, 1); PG8_STAGE(PG8_SB(0, 0), b2, voffB);
            PG8_BAR; PG8_WAIT_L(0); PG8_MMA(0, 1, At, B1); PG8_BAR;
            PG8_LDA(At, 0, 1); PG8_STAGE(PG8_SA(0, 0), a2, voffA);
            PG8_BAR; PG8_WAIT_L(0); PG8_MMA(1, 0, At, B0); PG8_BAR; PG8_SCHED;
            PG8_STAGE(PG8_SB(0, 1), b2 + hstep, voffB);
            PG8_WAIT_V(6); PG8_BAR; PG8_MMA(1, 1, At, B1); PG8_BAR;
            PG8_LDB(B0, 1, 0); PG8_SCHED; PG8_LDA(At, 1, 0); PG8_STAGE(PG8_SA(0, 1), a2 + hstep, voffA);
            PG8_WAIT_L(8); PG8_BAR; PG8_WAIT_L(0); PG8_MMA(0, 0, At, B0); PG8_BAR; PG8_SCHED;
            PG8_LDB(B1, 1, 1); PG8_STAGE(PG8_SB(1, 0), b3, voffB);
            PG8_BAR; PG8_WAIT_L(0); PG8_MMA(0, 1, At, B1); PG8_BAR;
            PG8_LDA(At, 1, 1); PG8_STAGE(PG8_SA(1, 0), a3, voffA);
            PG8_BAR; PG8_WAIT_L(0); PG8_MMA(1, 0, At, B0); PG8_BAR; PG8_SCHED;
            PG8_STAGE(PG8_SB(1, 1), b3 + hstep, voffB);
            PG8_WAIT_V(6); PG8_BAR; PG8_MMA(1, 1, At, B1); PG8_BAR;
            }
        }
        if constexpr (ALIGN_EPI) { if (wr == 0) PG8_BAR; }
        if constexpr (!Epi::AFTER_DRAIN) { E(acc, cur, wr, wc, fr, fq); S.done(cur); }
        if (!has_next) break;
#pragma unroll
        for (int a = 0; a < 2; ++a)
#pragma unroll
            for (int b = 0; b < 2; ++b)
#pragma unroll
                for (int m = 0; m < 4; ++m)
#pragma unroll
                    for (int n = 0; n < 2; ++n) acc[a][b][m][n] = (f32x4){0.f, 0.f, 0.f, 0.f};
        cur = nxt; cA = nA; cB = nB; ++ui;
        if constexpr (ALIGN_EPI) { if (wr == 1) PG8_BAR; }
    }
    PG8_WAIT_V(0);
    if constexpr (!ALIGN_EPI) { if (wr == 0) PG8_BAR; }
    PG8_BAR;
    if constexpr (Epi::AFTER_DRAIN) { E.fused(acc, cur, wr, wc, fr, fq, lds, wid, lane); S.done(cur); }
#undef PG8_SA
#undef PG8_SB
#undef PG8_STAGE
#undef PG8_LDA
#undef PG8_LDB
#undef PG8_MMA
#undef PG8_WAIT_V
#undef PG8_WAIT_L
#undef PG8_BAR
#undef PG8_SCHED
}
}

constexpr int BATCH = 8, SEQ = 4096, D = 1024, M = BATCH * SEQ, NIN = 7168, NMOD = 6 * D, NEXP = 16384, NPQ = 2048;
constexpr float EPS = 1e-6f;
constexpr int NWAVES = 8;
#ifndef MK_N_LAUNCHES
#define MK_N_LAUNCHES 1
#endif
#define DBG_STOP 99
#define PEER_OPT 7
constexpr int NPHASE = 13;
constexpr int N_LAUNCHES = MK_N_LAUNCHES;

constexpr size_t MiB = 1u << 20;
constexpr size_t WS_CTL = 0, CTL_ZERO_BYTES = 2 * MiB;
constexpr size_t WS_MOD = 1 * MiB;
constexpr size_t WS_ROPE = 2 * MiB;
constexpr size_t WS_STATS = 4 * MiB;
constexpr size_t WS_WIN = 8 * MiB, WS_WA = 22 * MiB, WS_WG = 24 * MiB, WS_WOUT = 26 * MiB, WS_WPQ = 28 * MiB, WS_KEYS = 32 * MiB, WS_WSP = 33 * MiB;
constexpr size_t WS_XN = 40 * MiB, WS_Q = 104 * MiB, WS_K = 168 * MiB, WS_V = 232 * MiB, WS_U = 296 * MiB, WS_ZV = 360 * MiB, WS_END = 424 * MiB;
constexpr size_t WS_O0 = WS_XN;
constexpr size_t WS_T1 = WS_K;
constexpr size_t WS_MIXIN = WS_ZV;
constexpr size_t WS_H2 = WS_XN;
constexpr size_t WS_QP = WS_K;
constexpr size_t WS_IDX = WS_U, WS_GATE = WS_U + 16 * MiB;
constexpr size_t WS_PU = WS_Q, WS_PV = WS_Q + 32 * MiB;
constexpr size_t WS_PART = WS_K;
constexpr size_t WS_A = WS_U + 32 * MiB;
constexpr size_t WS_Y = WS_K;
constexpr int CW_TMO = 0, CW_BAR = 4096;

constexpr int RING_BYTES = 131072, LDSCTL_OFF = RING_BYTES, MISC_OFF = LDSCTL_OFF + 320, LDS_BYTES = 147456;

#define GAS __attribute__((address_space(1)))
#define LAS __attribute__((address_space(3)))
typedef unsigned short bf16;
typedef unsigned v4u __attribute__((ext_vector_type(4)));
typedef unsigned v2u __attribute__((ext_vector_type(2)));
typedef float f32x4 __attribute__((ext_vector_type(4)));
typedef float f32x2 __attribute__((ext_vector_type(2)));
typedef float f32x16 __attribute__((ext_vector_type(16)));
typedef short bf16x8 __attribute__((ext_vector_type(8)));
typedef short s16x4 __attribute__((ext_vector_type(4)));
typedef __bf16 bf16x2_t __attribute__((ext_vector_type(2)));
typedef GAS unsigned gu32;
#define RLX_AGENT __ATOMIC_RELAXED, __HIP_MEMORY_SCOPE_AGENT
#define LDS_WAIT() asm volatile("s_waitcnt lgkmcnt(0)" ::: "memory")
#define VM_WAIT() asm volatile("s_waitcnt vmcnt(0)" ::: "memory")
#define SBAR() __builtin_amdgcn_sched_barrier(0)
__device__ __forceinline__ unsigned f2bf(float f) { unsigned u = __builtin_bit_cast(unsigned, f); return (u + 0x7fffu + ((u >> 16) & 1u)) >> 16; }
__device__ __forceinline__ unsigned pk2(float lo, float hi) { f32x2 v = {lo, hi}; bf16x2_t b = __builtin_convertvector(v, bf16x2_t); return __builtin_bit_cast(unsigned, b); }
__device__ __forceinline__ float bflo(unsigned w) { return __builtin_bit_cast(float, w << 16); }
__device__ __forceinline__ float bfhi(unsigned w) { return __builtin_bit_cast(float, w & 0xffff0000u); }
__device__ __forceinline__ float gelu_tanh(float x) {
    const float u = x * (0.7978845608f + 0.035677408137f * x * x);
    const float e = __builtin_amdgcn_exp2f(-2.885390081777927f * u);
    return x * __builtin_amdgcn_rcpf(1.f + e);
}
__device__ __forceinline__ float sigmoidf_(float x) { return __builtin_amdgcn_rcpf(1.f + __builtin_amdgcn_exp2f(-1.4426950408889634f * x)); }
__device__ __forceinline__ float wave_sum(float v) {
#pragma unroll
    for (int o = 1; o < 64; o <<= 1) v += __shfl_xor(v, o);
    return v;
}
__device__ __forceinline__ int crow(int r, int hi) { return (r & 3) + 8 * (r >> 2) + 4 * hi; }


namespace pg8 {
typedef float f32x2e __attribute__((ext_vector_type(2)));
__device__ __forceinline__ float bf_lo(unsigned w) { return __builtin_bit_cast(float, w << 16); }
__device__ __forceinline__ float bf_hi(unsigned w) { return __builtin_bit_cast(float, w & 0xffff0000u); }
__device__ __forceinline__ float gelu_t(float x) { const float u = x * (0.7978845608f + 0.035677408137f * x * x); const float e = __builtin_amdgcn_exp2f(-2.885390081777927f * u); return x * __builtin_amdgcn_rcpf(1.f + e); }
__device__ __forceinline__ float sigm(float x) { return __builtin_amdgcn_rcpf(1.f + __builtin_amdgcn_exp2f(-1.4426950408889634f * x)); }
__device__ __forceinline__ u32x4 pack8(const f32x4& a, const f32x4& b) { u32x4 w; w.x = cvt_pk_bf16(a[0], a[1]); w.y = cvt_pk_bf16(a[2], a[3]); w.z = cvt_pk_bf16(b[0], b[1]); w.w = cvt_pk_bf16(b[2], b[3]); return w; }

struct EpiInProj {
    static constexpr bool PERM = true, AFTER_DRAIN = false;
    bf16_t* Q; bf16_t* K; bf16_t* V; bf16_t* U; bf16_t* ZV; bf16_t* GA; bf16_t* GG; const float* rope; float* stats;
    __device__ __forceinline__ void operator()(const f32x4 (&acc)[2][2][4][2], const Unit& u, int wr, int wc, int fr, int fq) const {
        const int ty = u.pn >> 2;
        const int row0 = u.pm * BM + wr * 64 + fr;
        const int cc0 = (u.pn & 3) * BM + wc * 32 + 8 * fq;
        bf16_t* base = ty == 0 ? Q : ty == 1 ? K : ty == 2 ? V : ty == 3 ? U : ty == 4 ? ZV : ty == 5 ? GA : GG;
        if (ty <= 1) {
            const bool even = (wc & 1) == 0;
            const bool part = even && fq < 2;
            const float sg = (fq == 0) ? -1.f : 1.f;
#pragma unroll
            for (int ai = 0; ai < 2; ++ai)
#pragma unroll
                for (int m = 0; m < 4; ++m) {
                    const int row = row0 + ai * HALF + m * 16;
                    f32x4 c0 = {1.f, 1.f, 1.f, 1.f}, c1 = c0, s0 = {0.f, 0.f, 0.f, 0.f}, s1 = s0;
                    if (even) { const f32x4* rp = (const f32x4*)(rope + (size_t)row * 16); c0 = rp[0]; c1 = rp[1]; s0 = rp[2]; s1 = rp[3]; }
#pragma unroll
                    for (int bj = 0; bj < 2; ++bj) {
                        f32x4 v0 = acc[ai][bj][m][0], v1 = acc[ai][bj][m][1];
                        if (even) {
                            f32x4 p0, p1;
#pragma unroll
                            for (int j = 0; j < 4; ++j) { p0[j] = __shfl_xor(v0[j], 16); p1[j] = __shfl_xor(v1[j], 16); }
                            if (part) { v0 = v0 * c0 + (p0 * s0) * sg; v1 = v1 * c1 + (p1 * s1) * sg; }
                        }
                        *(u32x4*)(base + (size_t)row * 1024 + cc0 + bj * HALF) = pack8(v0, v1);
                    }
                }
        } else if (ty == 2) {
#pragma unroll
            for (int ai = 0; ai < 2; ++ai)
#pragma unroll
                for (int m = 0; m < 4; ++m) { const int row = row0 + ai * HALF + m * 16;
#pragma unroll
                    for (int bj = 0; bj < 2; ++bj) *(u32x4*)(base + (size_t)row * 1024 + cc0 + bj * HALF) = pack8(acc[ai][bj][m][0], acc[ai][bj][m][1]); }
        } else if (ty <= 4) {
#pragma unroll
            for (int ai = 0; ai < 2; ++ai)
#pragma unroll
                for (int m = 0; m < 4; ++m) { const int row = row0 + ai * HALF + m * 16; float s = 0.f, q = 0.f;
#pragma unroll
                    for (int bj = 0; bj < 2; ++bj) { f32x4 v0 = acc[ai][bj][m][0], v1 = acc[ai][bj][m][1];
#pragma unroll
                        for (int j = 0; j < 4; ++j) { v0[j] = gelu_t(v0[j]); v1[j] = gelu_t(v1[j]); }
                        const u32x4 w = pack8(v0, v1);
                        *(u32x4*)(base + (size_t)row * 1024 + cc0 + bj * HALF) = w;
                        if (ty == 4) {
#pragma unroll
                            for (int j = 0; j < 4; ++j) { const float a = bf_lo(w[j]), b = bf_hi(w[j]); s += a + b; q += a * a + b * b; } }
                    }
                    if (ty == 4) { s += __shfl_xor(s, 16); s += __shfl_xor(s, 32); q += __shfl_xor(q, 16); q += __shfl_xor(q, 32);
                        if (fq == 0) { f32x2e o = {s, q}; *(f32x2e*)(stats + ((size_t)row * 16 + (u.pn & 3) * 4 + wc) * 2) = o; } }
                }
        } else {
#pragma unroll
            for (int ai = 0; ai < 2; ++ai)
#pragma unroll
                for (int m = 0; m < 4; ++m) { const int row = row0 + ai * HALF + m * 16;
#pragma unroll
                    for (int bj = 0; bj < 2; ++bj) { f32x4 v0 = acc[ai][bj][m][0], v1 = acc[ai][bj][m][1];
#pragma unroll
                        for (int j = 0; j < 4; ++j) { v0[j] = sigm(v0[j]); v1[j] = sigm(v1[j]); }
                        *(u32x4*)(base + (size_t)row * 1024 + cc0 + bj * HALF) = pack8(v0, v1); } }
        }
    }
};

struct EpiMerge {
    static constexpr bool PERM = true, AFTER_DRAIN = false;
    const bf16_t* GA; const bf16_t* GG; bf16_t* O;
    __device__ __forceinline__ void operator()(const f32x4 (&acc)[2][2][4][2], const Unit& u, int wr, int wc, int fr, int fq) const {
        const int row0 = u.pm * BM + wr * 64 + fr, col0 = u.pn * BM + wc * 32 + 8 * fq;
        const bf16_t* G = u.w == 0 ? GA : GG;
#pragma unroll
        for (int ai = 0; ai < 2; ++ai)
#pragma unroll
            for (int m = 0; m < 4; ++m) { const size_t ro = (size_t)(row0 + ai * HALF + m * 16) * 1024 + col0;
#pragma unroll
                for (int bj = 0; bj < 2; ++bj) { const size_t off = ro + bj * HALF;
                    const u32x4 g = *(const u32x4*)(G + off);
                    f32x4 v0 = acc[ai][bj][m][0], v1 = acc[ai][bj][m][1];
                    v0[0] *= bf_lo(g.x); v0[1] *= bf_hi(g.x); v0[2] *= bf_lo(g.y); v0[3] *= bf_hi(g.y);
                    v1[0] *= bf_lo(g.z); v1[1] *= bf_hi(g.z); v1[2] *= bf_lo(g.w); v1[3] *= bf_hi(g.w);
                    if (u.w != 0) { const u32x4 t = *(const u32x4*)(O + off);
                        v0[0] += bf_lo(t.x); v0[1] += bf_hi(t.x); v0[2] += bf_lo(t.y); v0[3] += bf_hi(t.y); v1[0] += bf_lo(t.z); v1[1] += bf_hi(t.z); v1[2] += bf_lo(t.w); v1[3] += bf_hi(t.w); }
                    *(u32x4*)(O + off) = pack8(v0, v1); } }
    }
};

struct EpiF32 {
    static constexpr bool PERM = true, AFTER_DRAIN = false;
    float* O; int ldc;
    __device__ __forceinline__ void operator()(const f32x4 (&acc)[2][2][4][2], const Unit& u, int wr, int wc, int fr, int fq) const {
        const int row0 = u.pm * BM + wr * 64 + fr, col0 = u.pn * BM + wc * 32 + 8 * fq;
#pragma unroll
        for (int ai = 0; ai < 2; ++ai)
#pragma unroll
            for (int m = 0; m < 4; ++m) { float* rowp = O + (size_t)(row0 + ai * HALF + m * 16) * ldc + col0;
#pragma unroll
                for (int bj = 0; bj < 2; ++bj) { *(f32x4*)(rowp + bj * HALF) = acc[ai][bj][m][0]; *(f32x4*)(rowp + bj * HALF + 4) = acc[ai][bj][m][1]; } }
    }
};
}
#define XB_TMO      128
#define XB_XCNT(j)  (256  + 64 * (j))
#define XB_XSUB(j)  (1280 + 64 * (j))
#define XB_XGEN(j)  (2304 + 64 * (j))
#define XB_TOP      3328
#define XB_TOPGEN   3392
#define XCD_BAR_WORDS 3456
#define XB_SPIN_CAP (1u << 18)

__device__ __forceinline__ unsigned xb_ld(unsigned* p)              { return __hip_atomic_load(p, __ATOMIC_RELAXED, __HIP_MEMORY_SCOPE_AGENT); }
__device__ __forceinline__ unsigned xb_add(unsigned* p, unsigned v) { return __hip_atomic_fetch_add(p, v, __ATOMIC_RELAXED, __HIP_MEMORY_SCOPE_AGENT); }
__device__ __forceinline__ unsigned xb_xcc_id() { return (unsigned)__builtin_amdgcn_s_getreg((3 << 11) | 20) & 0xFu; }
#define XB_SPIN(cond, bar) do { unsigned _sp = 0; while (cond) { __builtin_amdgcn_s_sleep(1); \
    if ((++_sp & 255u) == 0u) { if (xb_ld(&(bar)[XB_TMO])) break; if (_sp > XB_SPIN_CAP) { atomicAdd(&(bar)[XB_TMO], 1u); break; } } } } while (0)

struct XcdBarrier {
    unsigned* bar; unsigned x;
    volatile LAS unsigned* st;
};

__device__ __forceinline__ XcdBarrier xcd_barrier_post(unsigned* bar, volatile LAS unsigned* st) {
    XcdBarrier b; b.bar = bar; b.x = xb_xcc_id(); b.st = st;
    if (threadIdx.x == 0) (void)xb_add(&bar[XB_XCNT(b.x)], 1u);
    return b;
}
__device__ __forceinline__ void xcd_barrier_complete(unsigned* bar, unsigned x, unsigned& nloc, unsigned& nx) {
    const unsigned G = gridDim.x * gridDim.y * gridDim.z;
    unsigned sum, cnt, mine, sp = 0u;
    for (;;) {
        sum = 0u; cnt = 0u; mine = 0u;
#pragma unroll
        for (unsigned j = 0; j < 16; ++j) { const unsigned c = xb_ld(&bar[XB_XCNT(j)]); sum += c; cnt += (c > 0u) ? 1u : 0u; mine = (j == x) ? c : mine; }
        if (sum == G) break;
        __builtin_amdgcn_s_sleep(1);
        if ((++sp & 255u) == 0u) { if (xb_ld(&bar[XB_TMO])) break; if (sp > XB_SPIN_CAP) { atomicAdd(&bar[XB_TMO], 1u); break; } }
    }
    nloc = mine > 0u ? mine : 1u; nx = cnt > 0u ? cnt : 1u;
}

__device__ __forceinline__ void xcd_barrier(const XcdBarrier& b) {
    asm volatile("s_waitcnt vmcnt(0)" ::: "memory");
    __syncthreads();
    if (threadIdx.x == 0) {
        unsigned* bar = b.bar;
        __builtin_amdgcn_s_waitcnt(0);
        unsigned nloc = b.st[0], nx = b.st[1];
        if (nloc == 0u) { xcd_barrier_complete(bar, b.x, nloc, nx); b.st[0] = nloc; b.st[1] = nx; }
        const unsigned old = xb_add(&bar[XB_XSUB(b.x)], 1u);
        const unsigned gen = old / nloc;
        if (old + 1u == (gen + 1u) * nloc) {
            __builtin_amdgcn_fence(__ATOMIC_RELEASE, "agent");
            asm volatile("s_waitcnt vmcnt(0)" ::: "memory");
            const unsigned og = xb_add(&bar[XB_TOP], 1u);
            const unsigned tg = og / nx;
            if (og + 1u == (tg + 1u) * nx) xb_add(&bar[XB_TOPGEN], 1u);
            else XB_SPIN(xb_ld(&bar[XB_TOPGEN]) == tg, bar);
            __builtin_amdgcn_fence(__ATOMIC_ACQUIRE, "agent");
            xb_add(&bar[XB_XGEN(b.x)], 1u);
            asm volatile("s_waitcnt vmcnt(0)" ::: "memory");
        } else {
            XB_SPIN(xb_ld(&bar[XB_XGEN(b.x)]) == gen, bar);
            __builtin_amdgcn_fence(__ATOMIC_ACQUIRE, "agent");
            asm volatile("s_waitcnt vmcnt(0)" ::: "memory");
        }
    }
    __syncthreads();
}

struct Frame {
    LAS unsigned char* lds; int tid, lane, wave, vcu, G;
};

__device__ __forceinline__ void p0_transpose_item(const float* W, int K, int N, bf16* WT, LAS float* scr, int item, int lane) {
    const int nblk = N / 32, kb = item / nblk, nb = item % nblk, k0 = 64 * kb, n0 = 32 * nb;
#pragma unroll 8
    for (int i = 0; i < 32; ++i) { const int kk = 2 * i + (lane >> 5); scr[kk * 33 + (lane & 31)] = W[(size_t)(k0 + kk) * N + n0 + (lane & 31)]; }
    LDS_WAIT(); asm volatile("" ::: "memory");
    const int c = lane & 7;
#pragma unroll
    for (int j = 0; j < 4; ++j) { const int n = (lane >> 3) + 8 * j; const LAS float* s = scr + (8 * c) * 33 + n;
        v4u o; o.x = pk2(s[0 * 33], s[1 * 33]); o.y = pk2(s[2 * 33], s[3 * 33]); o.z = pk2(s[4 * 33], s[5 * 33]); o.w = pk2(s[6 * 33], s[7 * 33]);
        *(GAS v4u*)(WT + (size_t)(n0 + n) * K + k0 + 8 * c) = o; }
    LDS_WAIT(); asm volatile("" ::: "memory");
}
__device__ __forceinline__ void cvt_plain(const Frame& F, const float* src, bf16* dst, long n8) {
    const long gt = (long)(F.vcu * NWAVES + F.wave) * 64 + F.lane, NT = (long)F.G * NWAVES * 64;
    for (long i = gt; i < n8; i += NT) { const f32x4 a = *(const GAS f32x4*)(src + i * 8), b = *(const GAS f32x4*)(src + i * 8 + 4);
        v4u o; o.x = pk2(a[0], a[1]); o.y = pk2(a[2], a[3]); o.z = pk2(b[0], b[1]); o.w = pk2(b[2], b[3]); *(GAS v4u*)(dst + i * 8) = o; }
}
__device__ __forceinline__ void sincos_d(double r, float& s, float& c) {
    const double z = r * r;
    double ps = 1.9572941063391263e-20; ps = ps * z + -8.22063524662433e-18; ps = ps * z + 2.8114572543455206e-15; ps = ps * z + -7.647163731819816e-13; ps = ps * z + 1.6059043836821613e-10;
    ps = ps * z + -2.505210838544172e-08; ps = ps * z + 2.7557319223985893e-06; ps = ps * z + -0.0001984126984126984; ps = ps * z + 0.008333333333333333; ps = ps * z + -0.16666666666666666; ps = ps * z + 1.0;
    double pc = -8.896791392450574e-22; pc = pc * z + 4.110317623312165e-19; pc = pc * z + -1.5619206968586225e-16; pc = pc * z + 4.779477332387385e-14; pc = pc * z + -1.1470745597729725e-11; pc = pc * z + 2.08767569878681e-09;
    pc = pc * z + -2.755731922398589e-07; pc = pc * z + 2.48015873015873e-05; pc = pc * z + -0.001388888888888889; pc = pc * z + 0.041666666666666664; pc = pc * z + -0.5; pc = pc * z + 1.0;
    s = (float)(r * ps); c = (float)pc;
}
struct P0Args { const float *c, *w_ada, *b_ada, *w_in, *w_a, *w_g, *w_out, *w_pq, *keys, *wsp; const int* pos; unsigned char* ws; };
__device__ __forceinline__ void p0_prologue(const Frame& F, const P0Args& a) {
    LAS float* scr = (LAS float*)(F.lds + F.wave * 16384);
    const int gw = F.vcu * NWAVES + F.wave, NGW = F.G * NWAVES;
    constexpr int I_IN = (D / 64) * (NIN / 32), I_SQ = (D / 64) * (D / 32), I_PQ = (D / 64) * (NPQ / 32), NITEMS = I_IN + 3 * I_SQ + I_PQ;
    for (int it = gw; it < NITEMS; it += NGW) {
        int r = it;
        if (r < I_IN) { p0_transpose_item(a.w_in, D, NIN, (bf16*)(a.ws + WS_WIN), scr, r, F.lane); continue; } r -= I_IN;
        if (r < I_SQ) { p0_transpose_item(a.w_a, D, D, (bf16*)(a.ws + WS_WA), scr, r, F.lane); continue; } r -= I_SQ;
        if (r < I_SQ) { p0_transpose_item(a.w_g, D, D, (bf16*)(a.ws + WS_WG), scr, r, F.lane); continue; } r -= I_SQ;
        if (r < I_SQ) { p0_transpose_item(a.w_out, D, D, (bf16*)(a.ws + WS_WOUT), scr, r, F.lane); continue; } r -= I_SQ;
        p0_transpose_item(a.w_pq, D, NPQ, (bf16*)(a.ws + WS_WPQ), scr, r, F.lane);
    }
    cvt_plain(F, a.keys, (bf16*)(a.ws + WS_KEYS), 8 * 2 * 128 * 128 / 8);
    cvt_plain(F, a.wsp, (bf16*)(a.ws + WS_WSP), 8 * 128 * 128 / 8);
    { const long gt = (long)gw * 64 + F.lane, NT = (long)NGW * 64; float* rope = (float*)(a.ws + WS_ROPE);
      for (long m = gt; m < M; m += NT) { const double p = (double)a.pos[m];
          const double invf[8] = {1.0, 0.19392274474868576, 0.03760603093086393, 0.007292664737217109, 0.001414213562373095, 0.0002742481756762073, 5.318295896944988e-05, 1.031338537721246e-05};
          float cs[8], sn[8];
#pragma unroll
          for (int i = 0; i < 8; ++i) { const double ang = p * invf[i]; const double k = __builtin_rint(ang * 0.15915494309189535); const double r = ang - k * 6.283185307179586; sincos_d(r, sn[i], cs[i]); }
          f32x4* o = (f32x4*)(rope + m * 16);
          o[0] = (f32x4){cs[0], cs[1], cs[2], cs[3]}; o[1] = (f32x4){cs[4], cs[5], cs[6], cs[7]}; o[2] = (f32x4){sn[0], sn[1], sn[2], sn[3]}; o[3] = (f32x4){sn[4], sn[5], sn[6], sn[7]}; } }
    { float* mod = (float*)(a.ws + WS_MOD); LAS float* red = (LAS float*)F.lds;
      __syncthreads();
      for (int it = F.vcu; it < NMOD / 32; it += F.G) { const int col = it * 32 + (F.lane & 31), kh = F.lane >> 5, k0 = F.wave * 128 + kh * 64;
          float acc[8];
#pragma unroll
          for (int b = 0; b < 8; ++b) acc[b] = 0.f;
#pragma unroll 8
          for (int kk = 0; kk < 64; ++kk) { const int k = k0 + kk; const float w = a.w_ada[(size_t)k * NMOD + col];
#pragma unroll
              for (int b = 0; b < 8; ++b) { const float cv = a.c[b * D + k]; const float sl = cv * __builtin_amdgcn_rcpf(1.f + __expf(-cv)); acc[b] += sl * w; } }
#pragma unroll
          for (int b = 0; b < 8; ++b) red[((F.wave * 2 + kh) * 8 + b) * 32 + (F.lane & 31)] = acc[b];
          __syncthreads();
          if (F.tid < 256) { const int b = F.tid >> 5, c = F.tid & 31; float s = a.b_ada[it * 32 + c];
#pragma unroll
              for (int p = 0; p < 16; ++p) s += red[(p * 8 + b) * 32 + c];
              mod[b * NMOD + it * 32 + c] = s; }
          __syncthreads(); } }
}

__device__ __forceinline__ void p1_xn(const Frame& F, const float* x, const float* g_pre, const float* mod, bf16* XN) {
    const int gw = F.vcu * NWAVES + F.wave, NGW = F.G * NWAVES;
    for (int m = gw; m < M; m += NGW) { const int b = m >> 12;
        const GAS f32x4* xr = (const GAS f32x4*)(x + (size_t)m * D) + F.lane;
        f32x4 v[4]; float ss = 0.f;
#pragma unroll
        for (int j = 0; j < 4; ++j) { v[j] = xr[64 * j]; ss += (v[j].x * v[j].x + v[j].y * v[j].y) + (v[j].z * v[j].z + v[j].w * v[j].w); }
        const float rs = 1.f / sqrtf(wave_sum(ss) * (1.f / D) + EPS);
        GAS v2u* o8 = (GAS v2u*)(XN + (size_t)m * D) + F.lane;
#pragma unroll
        for (int j = 0; j < 4; ++j) { const int col = 256 * j + 4 * F.lane;
            const f32x4 g = *(const f32x4*)(g_pre + col), sh = *(const f32x4*)(mod + b * NMOD + col), sc = *(const f32x4*)(mod + b * NMOD + D + col);
            const f32x4 h = v[j] * rs * g * (sc + 1.f) + sh; v2u w; w.x = pk2(h.x, h.y); w.y = pk2(h.z, h.w); o8[64 * j] = w; }
    }
}

__device__ __forceinline__ s16x4 tr_read_dyn(unsigned addr) { s16x4 r; asm volatile("ds_read_b64_tr_b16 %0, %1" : "=&v"(r) : "v"(addr) : "memory"); return r; }
struct GmlpArgs { const bf16* ZV; bf16* U; const float* stats; const float* ln_g; const float* ln_b; const bf16* wsp; const float* b_s; };
__device__ __forceinline__ void p3_gmlp(const Frame& F, const GmlpArgs& a) {
    LAS unsigned char* T = F.lds + F.wave * 16384;
    LAS float* MR = (LAS float*)(F.lds + LDSCTL_OFF + 1024);
    const int g = F.wave, lane = F.lane, L31 = lane & 31, hh = lane >> 5;
    const unsigned Tb = (unsigned)(uintptr_t)T;
    const int qq = (lane & 15) >> 2, p4 = lane & 3, g16 = (lane >> 4) & 1, sw = (qq >> 1) & 1;
    const unsigned rb0 = Tb + (8 * hh + qq) * 128 + 64 * (0 ^ sw) + (16 * g16 + 4 * p4) * 2;
    const unsigned rb1 = Tb + (8 * hh + qq) * 128 + 64 * (1 ^ sw) + (16 * g16 + 4 * p4) * 2;
    for (int ck = F.vcu; ck < M / 128; ck += F.G) {
        const size_t rowc = (size_t)ck * 128;
        __syncthreads();
        if (F.tid < 128) { const f32x4* sp = (const f32x4*)(a.stats + (rowc + F.tid) * 32); float s = 0.f, q = 0.f;
#pragma unroll
            for (int j = 0; j < 8; ++j) { const f32x4 t = sp[j]; s += t.x + t.z; q += t.y + t.w; }
            const float mu = s * (1.f / 1024.f), var = q * (1.f / 1024.f) - mu * mu;
            MR[2 * F.tid] = mu; MR[2 * F.tid + 1] = 1.f / sqrtf(fmaxf(var, 0.f) + EPS); }
        __syncthreads();
#pragma unroll 1
        for (int half = 0; half < 2; ++half) {
            const int cbase = g * 128 + half * 64;
            { const int c0 = 8 * (lane & 7);
              const f32x4 ga = *(const f32x4*)(a.ln_g + cbase + c0), gb = *(const f32x4*)(a.ln_g + cbase + c0 + 4), ba = *(const f32x4*)(a.ln_b + cbase + c0), bb = *(const f32x4*)(a.ln_b + cbase + c0 + 4);
#pragma unroll 4
              for (int i = 0; i < 16; ++i) { const int q = (lane >> 3) + 8 * i;
                  const v4u w = *(const GAS v4u*)(a.ZV + (rowc + q) * 1024 + cbase + c0);
                  const float mu = MR[2 * q], rs = MR[2 * q + 1];
                  f32x4 x0 = {bflo(w.x), bfhi(w.x), bflo(w.y), bfhi(w.y)}, x1 = {bflo(w.z), bfhi(w.z), bflo(w.w), bfhi(w.w)};
                  x0 = (x0 - mu) * rs * ga + ba; x1 = (x1 - mu) * rs * gb + bb;
                  v4u o; o.x = pk2(x0[0], x0[1]); o.y = pk2(x0[2], x0[3]); o.z = pk2(x1[0], x1[1]); o.w = pk2(x1[2], x1[3]);
                  *(LAS v4u*)(T + q * 128 + ((c0 * 2) ^ (((q >> 1) & 1) << 6))) = o; } }
            LDS_WAIT(); asm volatile("" ::: "memory");
#pragma unroll 1
            for (int pb = 0; pb < 4; ++pb) {
                bf16x8 af[8];
#pragma unroll
                for (int ks = 0; ks < 8; ++ks) af[ks] = *(const GAS bf16x8*)(a.wsp + ((size_t)(g * 128 + pb * 32 + L31)) * 128 + 16 * ks + 8 * hh);
                f32x16 acc0 = {}, acc1 = {};
#pragma unroll
                for (int ks = 0; ks < 8; ++ks) {
                    const s16x4 l0 = tr_read_dyn(rb0 + ks * 2048), h0 = tr_read_dyn(rb0 + ks * 2048 + 512), l1 = tr_read_dyn(rb1 + ks * 2048), h1 = tr_read_dyn(rb1 + ks * 2048 + 512);
                    asm volatile("s_waitcnt lgkmcnt(0)" ::: "memory"); SBAR();
                    const bf16x8 b0 = {l0[0], l0[1], l0[2], l0[3], h0[0], h0[1], h0[2], h0[3]}, b1 = {l1[0], l1[1], l1[2], l1[3], h1[0], h1[1], h1[2], h1[3]};
                    acc0 = __builtin_amdgcn_mfma_f32_32x32x16_bf16(af[ks], b0, acc0, 0, 0, 0);
                    acc1 = __builtin_amdgcn_mfma_f32_32x32x16_bf16(af[ks], b1, acc1, 0, 0, 0);
                }
#pragma unroll
                for (int r = 0; r < 16; ++r) { const int p = pb * 32 + crow(r, hh); const float bs = a.b_s[g * 128 + p];
                    bf16* up = a.U + (rowc + p) * 1024 + cbase + L31;
                    const float u0 = bflo((unsigned)up[0]), u1 = bflo((unsigned)up[32]);
                    up[0] = (bf16)f2bf(u0 * (acc0[r] + bs)); up[32] = (bf16)f2bf(u1 * (acc1[r] + bs)); }
            }
            LDS_WAIT(); asm volatile("" ::: "memory");
        }
    }
    __syncthreads();
}

namespace att {
#ifndef ATT_PV_PIPE
#define ATT_PV_PIPE 0
#endif
constexpr int NW = 8, QBLK = 32, KVBLK = 64, LD = 1024;
constexpr float SCALE = 0.125f, THR = 8.f;
constexpr int SHM_V = 16384, SHM_K = 8192, OFF_K = 0, OFF_V = 2 * SHM_K, OFF_WS = OFF_V + 3 * SHM_V, OFF_STG = OFF_WS + NW * 64 * 4, ATT_LDS = OFF_STG + NW * 4096;
static_assert(ATT_LDS <= 131072, "attention LDS");
#define KSWZ64(row, colB) ((row) * 128 + ((colB) ^ ((((row) >> 1) & 7) << 4)))
__device__ __forceinline__ void glds16(const void* gsrc, unsigned lds_dst) { unsigned keep;
  asm volatile("s_mov_b32 %0, m0\n\ts_mov_b32 m0, %2\n\ts_nop 0\n\tglobal_load_lds_dwordx4 %1, off\n\ts_mov_b32 m0, %0" : "=&s"(keep) : "v"(gsrc), "s"(lds_dst) : "memory"); }
#define WAIT_BAR(N) asm volatile("s_waitcnt vmcnt(" #N ") lgkmcnt(0)\n\ts_barrier" ::: "memory")
__device__ __forceinline__ unsigned cvtpk(float lo, float hi) { return pk2(lo, hi); }
__device__ __forceinline__ void partialSM(f32x16& p0, f32x16& p1, float& m_reg, float& mn, float& alpha) {
  constexpr float C = SCALE * 1.4426950408889634f;
  float pmax = p0[0];
#pragma unroll
  for (int r = 1; r < 16; ++r) pmax = fmaxf(pmax, p0[r]);
#pragma unroll
  for (int r = 0; r < 16; ++r) pmax = fmaxf(pmax, p1[r]);
  { auto rr = __builtin_amdgcn_permlane32_swap(__float_as_uint(pmax), __float_as_uint(pmax), false, false);
    pmax = fmaxf(__uint_as_float(rr[0]), __uint_as_float(rr[1])); }
  if (__builtin_expect(__all(pmax - m_reg <= THR / SCALE), 1)) { mn = m_reg; alpha = 1.f; }
  else { mn = fmaxf(m_reg, pmax); alpha = __builtin_amdgcn_exp2f((m_reg - mn) * C); m_reg = mn; }
  float mnC = -mn * C;
#pragma unroll
  for (int r = 0; r < 16; ++r) p0[r] = fmaf(p0[r], C, mnC);
#pragma unroll
  for (int r = 0; r < 16; ++r) p1[r] = fmaf(p1[r], C, mnC);
#pragma unroll
  for (int r = 0; r < 16; ++r) p0[r] = __builtin_amdgcn_exp2f(p0[r]);
}
__device__ __forceinline__ void finishSM(f32x16& p0, f32x16& p1, float alpha, float& l_reg, bf16x8& pa0, bf16x8& pa1, bf16x8& pa2, bf16x8& pa3) {
#pragma unroll
  for (int r = 0; r < 16; ++r) p1[r] = __builtin_amdgcn_exp2f(p1[r]);
  float ps = 0;
#pragma unroll
  for (int r = 0; r < 16; ++r) ps += p0[r];
#pragma unroll
  for (int r = 0; r < 16; ++r) ps += p1[r];
  { auto rr = __builtin_amdgcn_permlane32_swap(__float_as_uint(ps), __float_as_uint(ps), false, false);
    ps = __uint_as_float(rr[0]) + __uint_as_float(rr[1]); }
  l_reg = l_reg * alpha + ps;
#define PK4(P, BASE, OUT) do { unsigned a0 = cvtpk(P[BASE + 0], P[BASE + 1]), a1 = cvtpk(P[BASE + 2], P[BASE + 3]);   \
    unsigned b0 = cvtpk(P[BASE + 4], P[BASE + 5]), b1 = cvtpk(P[BASE + 6], P[BASE + 7]);                              \
    auto r0 = __builtin_amdgcn_permlane32_swap(a0, b0, false, false); auto r1 = __builtin_amdgcn_permlane32_swap(a1, b1, false, false); \
    v4u w = {r0[0], r1[0], r0[1], r1[1]}; OUT = *reinterpret_cast<bf16x8*>(&w); } while (0)
  PK4(p0, 0, pa0); PK4(p0, 8, pa1); PK4(p1, 0, pa2); PK4(p1, 8, pa3);
#undef PK4
}
__device__ __forceinline__ void qkt(f32x16& p0, f32x16& p1, const char* Ks, const bf16x8* qr, int r32, int hi) {
  p0 = f32x16{}; p1 = f32x16{};
#pragma unroll
  for (int d0 = 0; d0 < 4; ++d0) { const int cb = (d0 * 16 + hi * 8) * 2;
    bf16x8 b0 = *reinterpret_cast<const bf16x8*>(Ks + KSWZ64(r32, cb));
    bf16x8 b1 = *reinterpret_cast<const bf16x8*>(Ks + KSWZ64(32 + r32, cb));
    p0 = __builtin_amdgcn_mfma_f32_32x32x16_bf16(b0, qr[d0], p0, 0, 0, 0);
    p1 = __builtin_amdgcn_mfma_f32_32x32x16_bf16(b1, qr[d0], p1, 0, 0, 0); }
}
__device__ __forceinline__ int v_st(int k, int c) { const int kk = (k & ~0xC) | ((k & 4) << 1) | ((k & 8) >> 1); return ((kk >> 3) * 4 + (c >> 5)) * 512 + ((kk & 7) * 32 + (c & 31)) * 2; }
__device__ __forceinline__ int v_rd_base(int lane) { return ((lane & 3) << 3) | (((lane >> 2) & 3) << 6) | (((lane >> 4) & 1) << 5) | (((lane >> 5) & 1) << 8); }
constexpr int v_rd_off(int d0, int ks, int half) { return d0 * 512 + ks * 4096 + half * 2048; }
template <int OFF> __device__ __forceinline__ s16x4 tr_read(int vb) {
  s16x4 r; asm volatile("ds_read_b64_tr_b16 %0, %1 offset:%2" : "=&v"(r) : "v"(vb), "i"(OFF) : "memory"); return r;
}
struct VFrag { s16x4 l0, h0, l1, h1, l2, h2, l3, h3; };
template <int D0> __device__ __forceinline__ void pv_issue(VFrag& f, int vb) {
  f.l0 = tr_read<v_rd_off(D0, 0, 0)>(vb); f.h0 = tr_read<v_rd_off(D0, 0, 1)>(vb); f.l1 = tr_read<v_rd_off(D0, 1, 0)>(vb); f.h1 = tr_read<v_rd_off(D0, 1, 1)>(vb);
  f.l2 = tr_read<v_rd_off(D0, 2, 0)>(vb); f.h2 = tr_read<v_rd_off(D0, 2, 1)>(vb); f.l3 = tr_read<v_rd_off(D0, 3, 0)>(vb); f.h3 = tr_read<v_rd_off(D0, 3, 1)>(vb);
}
__device__ __forceinline__ void pv_mma(f32x16& od, const VFrag& f, bf16x8 pa0, bf16x8 pa1, bf16x8 pa2, bf16x8 pa3) {
#define PK(L, H) (bf16x8){L[0], L[1], L[2], L[3], H[0], H[1], H[2], H[3]}
  od = __builtin_amdgcn_mfma_f32_32x32x16_bf16(pa0, PK(f.l0, f.h0), od, 0, 0, 0);
  od = __builtin_amdgcn_mfma_f32_32x32x16_bf16(pa1, PK(f.l1, f.h1), od, 0, 0, 0);
  od = __builtin_amdgcn_mfma_f32_32x32x16_bf16(pa2, PK(f.l2, f.h2), od, 0, 0, 0);
  od = __builtin_amdgcn_mfma_f32_32x32x16_bf16(pa3, PK(f.l3, f.h3), od, 0, 0, 0);
#undef PK
}
__device__ __forceinline__ void pv_d0(f32x16* o, int vb, bf16x8 pa0, bf16x8 pa1, bf16x8 pa2, bf16x8 pa3) {
#if ATT_PV_PIPE
  VFrag fa, fb;
  pv_issue<0>(fa, vb);
  pv_issue<1>(fb, vb); asm volatile("s_waitcnt lgkmcnt(8)" ::: "memory"); SBAR(); pv_mma(o[0], fa, pa0, pa1, pa2, pa3);
  pv_issue<2>(fa, vb); asm volatile("s_waitcnt lgkmcnt(8)" ::: "memory"); SBAR(); pv_mma(o[1], fb, pa0, pa1, pa2, pa3);
  pv_issue<3>(fb, vb); asm volatile("s_waitcnt lgkmcnt(8)" ::: "memory"); SBAR(); pv_mma(o[2], fa, pa0, pa1, pa2, pa3);
  asm volatile("s_waitcnt lgkmcnt(0)" ::: "memory"); SBAR(); pv_mma(o[3], fb, pa0, pa1, pa2, pa3);
#else
  VFrag f;
  pv_issue<0>(f, vb); asm volatile("s_waitcnt lgkmcnt(0)" ::: "memory"); SBAR(); pv_mma(o[0], f, pa0, pa1, pa2, pa3);
  pv_issue<1>(f, vb); asm volatile("s_waitcnt lgkmcnt(0)" ::: "memory"); SBAR(); pv_mma(o[1], f, pa0, pa1, pa2, pa3);
  pv_issue<2>(f, vb); asm volatile("s_waitcnt lgkmcnt(0)" ::: "memory"); SBAR(); pv_mma(o[2], f, pa0, pa1, pa2, pa3);
  pv_issue<3>(f, vb); asm volatile("s_waitcnt lgkmcnt(0)" ::: "memory"); SBAR(); pv_mma(o[3], f, pa0, pa1, pa2, pa3);
#endif
}

template <int t>
__device__ __forceinline__ void attn_pass(const bf16* Qh, const bf16* __restrict__ Kh, const bf16* __restrict__ Vh, bf16* ONh, int q0, float lam, const float* gsub, float* stash, char* lds) {
  int tid = threadIdx.x; asm volatile("" : "+v"(tid));
  const int wid = tid >> 6, lane = tid & 63, r32 = lane & 31, hi = lane >> 5;
  char* V_lds = lds + OFF_V; char* K_lds = lds + OFF_K;
  float* ws = (float*)(lds + OFF_WS) + wid * 64; float* li_l = ws; float* al_l = ws + 32;
  bf16* stg = (bf16*)(lds + OFF_STG + wid * 4096);
  const int ku = tid, krow = ku >> 3, kchunk = (ku & 7) ^ ((krow >> 1) & 7);
  const int vu0 = tid, vu1 = 512 + tid;
  const int vkk0 = ((vu0 >> 5) >> 2) * 8 + ((vu0 & 31) >> 2), vkey0 = (vkk0 & ~0xC) | ((vkk0 & 8) >> 1) | ((vkk0 & 4) << 1), vcol0 = ((vu0 >> 5) & 3) * 32 + (vu0 & 3) * 8;
  const int vkk1 = ((vu1 >> 5) >> 2) * 8 + ((vu1 & 31) >> 2), vkey1 = (vkk1 & ~0xC) | ((vkk1 & 8) >> 1) | ((vkk1 & 4) << 1), vcol1 = ((vu1 >> 5) & 3) * 32 + (vu1 & 3) * 8;
  const unsigned lds0 = (unsigned)(uintptr_t)lds, kdst = lds0 + OFF_K + wid * 1024, vdst = lds0 + OFF_V + wid * 1024;
  const int vb0 = (int)(uintptr_t)V_lds + v_rd_base(lane);
  constexpr int NT = SEQ / KVBLK;
  {
    const bf16* Kt = Kh + t * 64;
    float m_reg = -1e30f, l_reg = 0; f32x16 o[4] = {}; bf16x8 qr[4];
    const bf16* Qw = Qh + (long)(q0 + wid * QBLK + r32) * LD + t * 64 + hi * 8;
#pragma unroll
    for (int d0 = 0; d0 < 4; ++d0) qr[d0] = *reinterpret_cast<const bf16x8*>(Qw + d0 * 16);
    const bf16* ksrc = Kt + (long)krow * LD + kchunk * 8; const bf16* vsrc0 = Vh + (long)vkey0 * LD + vcol0; const bf16* vsrc1 = Vh + (long)vkey1 * LD + vcol1;
#define DMA_TILE(tt, kslot, vslotoff) do { glds16(ksrc + (long)(tt) * KVBLK * LD, (unsigned)__builtin_amdgcn_readfirstlane(kdst + (kslot) * SHM_K)); \
    glds16(vsrc0 + (long)(tt) * KVBLK * LD, (unsigned)__builtin_amdgcn_readfirstlane(vdst + (vslotoff))); glds16(vsrc1 + (long)(tt) * KVBLK * LD, (unsigned)__builtin_amdgcn_readfirstlane(vdst + (vslotoff) + 8192)); } while (0)
#define RESC(a) do { if (__any((a) < 1.f)) { if (hi == 0) al_l[r32] = (a); asm volatile("s_waitcnt lgkmcnt(0)" ::: "memory"); \
    _Pragma("unroll") for (int d = 0; d < 4; ++d) _Pragma("unroll") for (int r = 0; r < 16; ++r) o[d][r] *= al_l[crow(r, hi)]; } } while (0)
    f32x16 pA0, pA1, pB0, pB1; float mnA, mnB, alA, alB; bf16x8 pa0, pa1, pa2, pa3;
    int vprev = 2 * SHM_V, vcur = 0, vnext = SHM_V;
#define ROTV() do { const int t_ = vprev; vprev = vcur; vcur = vnext; vnext = t_; } while (0)
    WAIT_BAR(0);
    DMA_TILE(0, 0, 0); DMA_TILE(1, 1, SHM_V);
    WAIT_BAR(3);
    qkt(pA0, pA1, K_lds, qr, r32, hi); partialSM(pA0, pA1, m_reg, mnA, alA);
    vprev = 0; vcur = SHM_V; vnext = 2 * SHM_V;
#define STEP(X0, X1, mnX, alX, Y0, Y1, alY, j, HASW, HASL) do { \
      WAIT_BAR(0); \
      if (HASW) DMA_TILE((j) + 1, ((j) + 1) & 1, vnext); \
      SBAR(); qkt(X0, X1, K_lds + ((j) & 1) * SHM_K, qr, r32, hi); \
      finishSM(Y0, Y1, alY, l_reg, pa0, pa1, pa2, pa3); SBAR(); \
      pv_d0(o, vb0 + vprev, pa0, pa1, pa2, pa3); partialSM(X0, X1, m_reg, mnX, alX); \
      RESC(alX); ROTV(); } while (0)
#pragma unroll 1
    for (int j = 1; j + 3 < NT; j += 2) {
      STEP(pB0, pB1, mnB, alB, pA0, pA1, alA, j, true, true);
      STEP(pA0, pA1, mnA, alA, pB0, pB1, alB, j + 1, true, true);
    }
    STEP(pB0, pB1, mnB, alB, pA0, pA1, alA, NT - 3, true, true);
    STEP(pA0, pA1, mnA, alA, pB0, pB1, alB, NT - 2, true, false);
    STEP(pB0, pB1, mnB, alB, pA0, pA1, alA, NT - 1, false, false);
    finishSM(pB0, pB1, alB, l_reg, pa0, pa1, pa2, pa3); SBAR();
    pv_d0(o, vb0 + vprev, pa0, pa1, pa2, pa3);
#undef STEP
#undef ROTV
#undef DMA_TILE
#undef RESC
    if (hi == 0) li_l[r32] = l_reg; asm volatile("s_waitcnt lgkmcnt(0)" ::: "memory");
    float rli[16];
#pragma unroll
    for (int r = 0; r < 16; ++r) rli[r] = __builtin_amdgcn_rcpf(li_l[crow(r, hi)]);
    GAS float* sp = (GAS float*)(stash + (size_t)wid * 4096 + lane);
    asm volatile("" : "+v"(sp));
    if (t == 0) {
#pragma unroll
      for (int r = 0; r < 16; ++r)
#pragma unroll
        for (int d0 = 0; d0 < 4; ++d0) sp[(d0 * 16 + r) * 64] = o[d0][r] * rli[r];
    } else {
      float gs[4];
#pragma unroll
      for (int d0 = 0; d0 < 4; ++d0) gs[d0] = gsub[d0 * 32 + r32] * 0.8f;
      bf16* Ow = ONh + (long)(q0 + wid * QBLK) * LD;
#pragma unroll
      for (int half = 0; half < 2; ++half) {
#pragma unroll
        for (int rr = 0; rr < 8; ++rr) { const int r = half * 8 + rr; float oc[4]; float ss = 0.f;
#pragma unroll
          for (int d0 = 0; d0 < 4; ++d0) { oc[d0] = sp[(d0 * 16 + r) * 64] - lam * (o[d0][r] * rli[r]); ss += oc[d0] * oc[d0]; }
          ss += __shfl_xor(ss, 1); ss += __shfl_xor(ss, 2); ss += __shfl_xor(ss, 4); ss += __shfl_xor(ss, 8); ss += __shfl_xor(ss, 16);
          const float rs = 1.f / sqrtf(ss * (1.f / 128.f) + EPS); const int orow = crow(r, hi) - 16 * half;
#pragma unroll
          for (int d0 = 0; d0 < 4; ++d0) stg[orow * 128 + d0 * 32 + r32] = (bf16)f2bf(oc[d0] * rs * gs[d0]); }
        asm volatile("s_waitcnt lgkmcnt(0)" ::: "memory");
#pragma unroll
        for (int i = 0; i < 4; ++i) { const int row = i * 4 + (lane >> 4), ch = lane & 15; const v4u v = *(const v4u*)(stg + row * 128 + ch * 8); *(v4u*)(Ow + (long)(half * 16 + row) * LD + ch * 8) = v; }
        asm volatile("s_waitcnt lgkmcnt(0)" ::: "memory");
      }
    }
  }
}
__device__ __forceinline__ void attn_unit(const bf16* Qh, const bf16* __restrict__ Kh, const bf16* __restrict__ Vh, bf16* ONh, int q0, float lam, const float* gsub, float* stash, char* lds) {
  attn_pass<0>(Qh, Kh, Vh, ONh, q0, lam, gsub, stash, lds);
  asm volatile("s_waitcnt vmcnt(0) lgkmcnt(0)" ::: "memory"); SBAR();
  attn_pass<1>(Qh, Kh, Vh, ONh, q0, lam, gsub, stash, lds);
  asm volatile("s_waitcnt vmcnt(0) lgkmcnt(0)" ::: "memory"); SBAR();
}
}

__device__ __forceinline__ void p6_rows(const Frame& F, const float* x, float* io, const float* g_post, const float* g_pre2, const float* mod, bf16* H2) {
    const int gw = F.vcu * NWAVES + F.wave, NGW = F.G * NWAVES;
    for (int m = gw; m < M; m += NGW) { const int b = m >> 12; const float* mb = mod + b * NMOD;
        GAS f32x4* mr = (GAS f32x4*)(io + (size_t)m * D) + F.lane; const GAS f32x4* xr = (const GAS f32x4*)(x + (size_t)m * D) + F.lane;
        f32x4 v[4], xv[4]; float ss = 0.f;
#pragma unroll
        for (int j = 0; j < 4; ++j) { v[j] = mr[64 * j]; xv[j] = xr[64 * j]; ss += (v[j].x * v[j].x + v[j].y * v[j].y) + (v[j].z * v[j].z + v[j].w * v[j].w); }
        const float rs = 1.f / sqrtf(wave_sum(ss) * (1.f / D) + EPS); float s2 = 0.f;
#pragma unroll
        for (int j = 0; j < 4; ++j) { const int col = 256 * j + 4 * F.lane;
            const f32x4 g = *(const f32x4*)(g_post + col), gt = *(const f32x4*)(mb + 2 * D + col);
            v[j] = xv[j] + gt * (v[j] * rs * g); mr[64 * j] = v[j];
            s2 += (v[j].x * v[j].x + v[j].y * v[j].y) + (v[j].z * v[j].z + v[j].w * v[j].w); }
        const float rs2 = 1.f / sqrtf(wave_sum(s2) * (1.f / D) + EPS);
        GAS v2u* o8 = (GAS v2u*)(H2 + (size_t)m * D) + F.lane;
#pragma unroll
        for (int j = 0; j < 4; ++j) { const int col = 256 * j + 4 * F.lane;
            const f32x4 g = *(const f32x4*)(g_pre2 + col), sh = *(const f32x4*)(mb + 3 * D + col), sc = *(const f32x4*)(mb + 4 * D + col);
            const f32x4 h = v[j] * rs2 * g * (sc + 1.f) + sh; v2u w; w.x = pk2(h.x, h.y); w.y = pk2(h.z, h.w); o8[64 * j] = w; }
    }
}

__device__ __forceinline__ float vmaxf(float a, float b) { float r; asm("v_max_f32_e32 %0, %1, %2" : "=v"(r) : "v"(a), "v"(b)); return r; }
__device__ __forceinline__ float vminf(float a, float b) { float r; asm("v_min_f32_e32 %0, %1, %2" : "=v"(r) : "v"(a), "v"(b)); return r; }
#define CE_DESC(a, b) do { const float _mx = vmaxf(a, b), _mn = vminf(a, b); a = _mx; b = _mn; } while (0)
__device__ __forceinline__ void sort16_desc(float (&v)[16]) {
#pragma unroll
    for (int k = 2; k <= 16; k <<= 1)
#pragma unroll
        for (int j = k >> 1; j > 0; j >>= 1)
#pragma unroll
            for (int i = 0; i < 16; ++i) { const int l = i ^ j; if (l > i) { if ((i & k) == 0) CE_DESC(v[i], v[l]); else CE_DESC(v[l], v[i]); } }
}
__device__ __forceinline__ void merge16_desc(float (&a)[16], const float (&b)[16]) {
#pragma unroll
    for (int i = 0; i < 16; ++i) a[i] = vmaxf(a[i], b[15 - i]);
#pragma unroll
    for (int j = 8; j > 0; j >>= 1)
#pragma unroll
        for (int i = 0; i < 16; ++i) { const int l = i ^ j; if (l > i) CE_DESC(a[i], a[l]); }
}
#define FILL_ROUND0 bt[0] = CAND(0, 0); bt[1] = CAND(0, 1); bt[2] = CAND(1, 0); bt[3] = CAND(0, 2); bt[4] = CAND(2, 0); bt[5] = CAND(1, 1); bt[6] = CAND(0, 3); bt[7] = CAND(3, 0); bt[8] = CAND(0, 4); bt[9] = CAND(4, 0); bt[10] = CAND(1, 2); bt[11] = CAND(2, 1); bt[12] = CAND(0, 5); bt[13] = CAND(5, 0); bt[14] = CAND(0, 6); bt[15] = CAND(6, 0);
#define FILL_ROUND1 bt[0] = CAND(1, 3); bt[1] = CAND(3, 1); bt[2] = CAND(0, 7); bt[3] = CAND(7, 0); bt[4] = CAND(2, 2); bt[5] = CAND(0, 8); bt[6] = CAND(8, 0); bt[7] = CAND(1, 4); bt[8] = CAND(4, 1); bt[9] = CAND(0, 9); bt[10] = CAND(9, 0); bt[11] = CAND(0, 10); bt[12] = CAND(10, 0); bt[13] = CAND(2, 3); bt[14] = CAND(3, 2); bt[15] = CAND(1, 5);
#define FILL_ROUND2 bt[0] = CAND(5, 1); bt[1] = CAND(0, 11); bt[2] = CAND(11, 0); bt[3] = CAND(0, 12); bt[4] = CAND(12, 0); bt[5] = CAND(1, 6); bt[6] = CAND(6, 1); bt[7] = CAND(0, 13); bt[8] = CAND(13, 0); bt[9] = CAND(2, 4); bt[10] = CAND(4, 2); bt[11] = CAND(0, 14); bt[12] = CAND(14, 0); bt[13] = CAND(3, 3); bt[14] = CAND(1, 7); bt[15] = CAND(7, 1);
#define FILL_ROUND3 bt[0] = CAND(0, 15); bt[1] = CAND(15, 0); bt[2] = NEG_INF; bt[3] = NEG_INF; bt[4] = NEG_INF; bt[5] = NEG_INF; bt[6] = NEG_INF; bt[7] = NEG_INF; bt[8] = NEG_INF; bt[9] = NEG_INF; bt[10] = NEG_INF; bt[11] = NEG_INF; bt[12] = NEG_INF; bt[13] = NEG_INF; bt[14] = NEG_INF; bt[15] = NEG_INF;
struct RouteArgs { const bf16* QP; const bf16* keys; int* IDX; float* GATE; };
__device__ __forceinline__ void p8_route(const Frame& F, const RouteArgs& a) {
    const int lane = F.lane, L31 = lane & 31, hh = lane >> 5, h = F.wave;
    LAS unsigned char* tab = F.lds + F.wave * 2048 + lane * 32;
    for (int tb = F.vcu; tb < M / 32; tb += F.G) {
        const int tok = tb * 32 + L31;
        float st[2][16];
#pragma unroll
        for (int t = 0; t < 2; ++t) {
            bf16x8 bq[8];
#pragma unroll
            for (int ks = 0; ks < 8; ++ks) bq[ks] = *(const GAS bf16x8*)(a.QP + (size_t)tok * NPQ + h * 256 + t * 128 + 16 * ks + 8 * hh);
            const bf16* kb = a.keys + (size_t)((h * 2 + t) * 128 + L31) * 128 + 8 * hh;
            float top[16];
#pragma unroll 1
            for (int nb = 0; nb < 4; ++nb) {
                f32x16 acc = {};
#pragma unroll
                for (int ks = 0; ks < 8; ++ks) { const bf16x8 af = *(const GAS bf16x8*)(kb + (size_t)nb * 32 * 128 + 16 * ks);
                    acc = __builtin_amdgcn_mfma_f32_32x32x16_bf16(af, bq[ks], acc, 0, 0, 0); }
                float bt[16];
#pragma unroll
                for (int r = 0; r < 16; ++r) bt[r] = __uint_as_float((__float_as_uint(acc[r]) & 0xFFFFFF80u) | (unsigned)(nb * 32 + crow(r, hh)));
                sort16_desc(bt);
                if (nb == 0) {
#pragma unroll
                    for (int r = 0; r < 16; ++r) top[r] = bt[r];
                } else merge16_desc(top, bt);
            }
            { float pt[16];
#pragma unroll
              for (int r = 0; r < 16; ++r) { auto rr = __builtin_amdgcn_permlane32_swap(__float_as_uint(top[r]), __float_as_uint(top[r]), false, false); pt[r] = __uint_as_float(hh ? rr[0] : rr[1]); }
              merge16_desc(top, pt); }
#pragma unroll
            for (int r = 0; r < 16; ++r) st[t][r] = top[r];
        }
        { unsigned w[8];
#pragma unroll
          for (int d = 0; d < 4; ++d) { w[d] = 0u; w[4 + d] = 0u;
#pragma unroll
              for (int k = 0; k < 4; ++k) { w[d] |= (__float_as_uint(st[0][4 * d + k]) & 0x7Fu) << (8 * k); w[4 + d] |= (__float_as_uint(st[1][4 * d + k]) & 0x7Fu) << (8 * k); } }
          *(LAS v4u*)(tab) = (v4u){w[0], w[1], w[2], w[3]}; *(LAS v4u*)(tab + 16) = (v4u){w[4], w[5], w[6], w[7]}; }
        float top[16], bt[16];
        const float NEG_INF = -__builtin_inff();
#define CAND(i, j) __uint_as_float((__float_as_uint(st[0][i] + st[1][j]) & 0xFFFFFF00u) | (unsigned)((i) * 16 + (j)))
        FILL_ROUND0 sort16_desc(bt);
#pragma unroll
        for (int r = 0; r < 16; ++r) top[r] = bt[r];
        FILL_ROUND1 sort16_desc(bt); merge16_desc(top, bt);
        FILL_ROUND2 sort16_desc(bt); merge16_desc(top, bt);
        FILL_ROUND3 sort16_desc(bt); merge16_desc(top, bt);
#undef CAND
        float e[16], es = 0.f;
#pragma unroll
        for (int r = 0; r < 16; ++r) { e[r] = __builtin_amdgcn_exp2f((top[r] - top[0]) * 1.4426950408889634f); es += e[r]; }
        const float inv = 1.f / es;
        LDS_WAIT();
        int ex[16];
#pragma unroll
        for (int r = 0; r < 16; ++r) { const unsigned cell = __float_as_uint(top[r]) & 0xFFu; const unsigned n0 = tab[cell >> 4], n1 = tab[16 + (cell & 15u)]; ex[r] = (int)(n0 * 128u + n1); e[r] *= inv; }
        int oi[8]; float og[8];
#pragma unroll
        for (int k = 0; k < 8; ++k) { oi[k] = hh ? ex[8 + k] : ex[k]; og[k] = hh ? e[8 + k] : e[k]; }
        int* ip = a.IDX + (size_t)tok * 128 + h * 16 + 8 * hh; float* gp = a.GATE + (size_t)tok * 128 + h * 16 + 8 * hh;
        *(GAS v4u*)ip = (v4u){(unsigned)oi[0], (unsigned)oi[1], (unsigned)oi[2], (unsigned)oi[3]}; *(GAS v4u*)(ip + 4) = (v4u){(unsigned)oi[4], (unsigned)oi[5], (unsigned)oi[6], (unsigned)oi[7]};
        *(GAS f32x4*)gp = (f32x4){og[0], og[1], og[2], og[3]}; *(GAS f32x4*)(gp + 4) = (f32x4){og[4], og[5], og[6], og[7]};
        LDS_WAIT(); asm volatile("" ::: "memory");
    }
}

#ifndef TBL_FP8
#define TBL_FP8 1
#endif
constexpr int NSL = TBL_FP8 ? 8 : 16, CW = D / NSL, ESZ = TBL_FP8 ? 1 : 2, ROWB = CW * ESZ, CPL = 16 / ESZ;
static_assert(ROWB == 128 && CPL * 8 == CW, "one cache line per (expert, slice) row, 8 lanes per row");
constexpr float U_SCALE = TBL_FP8 ? 1024.f : 1.f, V_SCALE = TBL_FP8 ? 16.f : 1.f;
__device__ __forceinline__ float dot2bf(unsigned a, unsigned b, float c) { return __builtin_amdgcn_fdot2_f32_bf16(__builtin_bit_cast(bf16x2_t, a), __builtin_bit_cast(bf16x2_t, b), c, false); }
__device__ __forceinline__ float dot8(const v4u a, const v4u b, float c) {
    c = dot2bf(a.x, b.x, c); c = dot2bf(a.y, b.y, c); c = dot2bf(a.z, b.z, c); c = dot2bf(a.w, b.w, c); return c;
}
__device__ __forceinline__ void cvt_table(const Frame& F, const float* src, unsigned char* dst, float scale) {
    const long gt = (long)(F.vcu * NWAVES + F.wave) * 64 + F.lane, NT = (long)F.G * NWAVES * 64, n8 = (long)NEXP * D / 8;
    for (long i = gt; i < n8; i += NT) { const long e = i >> 7; const int c0 = (int)(i & 127) * 8, s = c0 / CW, cc = c0 % CW;
        const f32x4 a = *(const GAS f32x4*)(src + i * 8), b = *(const GAS f32x4*)(src + i * 8 + 4);
        unsigned char* d = dst + ((size_t)s * NEXP + e) * ROWB + cc * ESZ;
#if TBL_FP8
        int w0 = 0, w1 = 0;
        w0 = __builtin_amdgcn_cvt_pk_fp8_f32(a[0] * scale, a[1] * scale, w0, false); w0 = __builtin_amdgcn_cvt_pk_fp8_f32(a[2] * scale, a[3] * scale, w0, true);
        w1 = __builtin_amdgcn_cvt_pk_fp8_f32(b[0] * scale, b[1] * scale, w1, false); w1 = __builtin_amdgcn_cvt_pk_fp8_f32(b[2] * scale, b[3] * scale, w1, true);
        *(GAS v2u*)d = (v2u){(unsigned)w0, (unsigned)w1};
#else
        (void)scale; v4u o; o.x = pk2(a[0], a[1]); o.y = pk2(a[2], a[3]); o.z = pk2(b[0], b[1]); o.w = pk2(b[2], b[3]); *(GAS v4u*)d = o;
#endif
    }
}
template <int CTRL> __device__ __forceinline__ float dpp_mov(float v) { return __builtin_bit_cast(float, __builtin_amdgcn_update_dpp(0, __builtin_bit_cast(int, v), CTRL, 0xF, 0xF, true)); }
#ifndef PEER_OPT
#define PEER_OPT 7
#endif
__device__ __forceinline__ float red8(float v) {
#if PEER_OPT & 1
    v += dpp_mov<0xB1>(v); v += dpp_mov<0x4E>(v); v += dpp_mov<0x141>(v); return v;
#else
    v += __shfl_xor(v, 1); v += __shfl_xor(v, 2); v += __shfl_xor(v, 4); return v;
#endif
}
__device__ __forceinline__ float red_groups(float v) {
#if !(PEER_OPT & 4)
    v += __shfl_xor(v, 8); v += __shfl_xor(v, 16); v += __shfl_xor(v, 32); return v;
#endif
    v += dpp_mov<0x128>(v);
    { unsigned a = __float_as_uint(v), b = a; asm volatile("" : "+v"(a), "+v"(b)); auto r = __builtin_amdgcn_permlane16_swap(a, b, false, false); v = __uint_as_float(r[0]) + __uint_as_float(r[1]); }
    { unsigned a = __float_as_uint(v), b = a; asm volatile("" : "+v"(a), "+v"(b)); auto r = __builtin_amdgcn_permlane32_swap(a, b, false, false); v = __uint_as_float(r[0]) + __uint_as_float(r[1]); }
    return v;
}
#if TBL_FP8
__device__ __forceinline__ void tbl_unpack2(const v4u w, f32x2 (&f)[8]) {
    f[0] = __builtin_amdgcn_cvt_pk_f32_fp8((int)w.x, false); f[1] = __builtin_amdgcn_cvt_pk_f32_fp8((int)w.x, true); f[2] = __builtin_amdgcn_cvt_pk_f32_fp8((int)w.y, false); f[3] = __builtin_amdgcn_cvt_pk_f32_fp8((int)w.y, true);
    f[4] = __builtin_amdgcn_cvt_pk_f32_fp8((int)w.z, false); f[5] = __builtin_amdgcn_cvt_pk_f32_fp8((int)w.z, true); f[6] = __builtin_amdgcn_cvt_pk_f32_fp8((int)w.w, false); f[7] = __builtin_amdgcn_cvt_pk_f32_fp8((int)w.w, true);
}
#endif
__device__ __forceinline__ void tbl_unpack(const v4u w, float (&f)[CPL]) {
#if TBL_FP8
#pragma unroll
    for (int i = 0; i < 4; ++i) { const unsigned x = i == 0 ? w.x : i == 1 ? w.y : i == 2 ? w.z : w.w;
        const f32x2 lo = __builtin_amdgcn_cvt_pk_f32_fp8((int)x, false), hi = __builtin_amdgcn_cvt_pk_f32_fp8((int)x, true);
        f[4 * i] = lo[0]; f[4 * i + 1] = lo[1]; f[4 * i + 2] = hi[0]; f[4 * i + 3] = hi[1]; }
#else
    f[0] = bflo(w.x); f[1] = bfhi(w.x); f[2] = bflo(w.y); f[3] = bfhi(w.y); f[4] = bflo(w.z); f[5] = bfhi(w.z); f[6] = bflo(w.w); f[7] = bfhi(w.w);
#endif
}
struct PeerArgs { const bf16* H2; const int* IDX; const float* GATE; const unsigned char* PU; const unsigned char* PV; float* PART; float* A; float* Y; float* io; const float* g_post2; const float* mod; };
__device__ __forceinline__ void pk_issue8(const unsigned char* tab, const v4u ia, const v4u ib, v4u (&w)[8]) {
    w[0] = *(const GAS v4u*)(tab + (size_t)ia.x * ROWB); w[1] = *(const GAS v4u*)(tab + (size_t)ia.y * ROWB); w[2] = *(const GAS v4u*)(tab + (size_t)ia.z * ROWB); w[3] = *(const GAS v4u*)(tab + (size_t)ia.w * ROWB);
    w[4] = *(const GAS v4u*)(tab + (size_t)ib.x * ROWB); w[5] = *(const GAS v4u*)(tab + (size_t)ib.y * ROWB); w[6] = *(const GAS v4u*)(tab + (size_t)ib.z * ROWB); w[7] = *(const GAS v4u*)(tab + (size_t)ib.w * ROWB);
}
__device__ __forceinline__ void p9_half(const v4u (&w)[8], const v4u h0, const v4u h1, float* val  ) {
#if TBL_FP8
    const f32x2 hp[8] = {{bflo(h0.x), bfhi(h0.x)}, {bflo(h0.y), bfhi(h0.y)}, {bflo(h0.z), bfhi(h0.z)}, {bflo(h0.w), bfhi(h0.w)}, {bflo(h1.x), bfhi(h1.x)}, {bflo(h1.y), bfhi(h1.y)}, {bflo(h1.z), bfhi(h1.z)}, {bflo(h1.w), bfhi(h1.w)}};
#pragma unroll
    for (int i = 0; i < 8; ++i) { f32x2 f[8]; tbl_unpack2(w[i], f);
        f32x2 s0 = f[0] * hp[0], s1 = f[1] * hp[1];
        s0 = f[2] * hp[2] + s0; s1 = f[3] * hp[3] + s1; s0 = f[4] * hp[4] + s0; s1 = f[5] * hp[5] + s1; s0 = f[6] * hp[6] + s0; s1 = f[7] * hp[7] + s1;
        const f32x2 t = s0 + s1; val[i] = red8(t.x + t.y) * (1.f / U_SCALE); }
#else
    (void)h1;
#pragma unroll
    for (int i = 0; i < 8; ++i) val[i] = red8(dot8(w[i], h0, 0.f));
#endif
}
__device__ __forceinline__ void p9_udots(const Frame& F, const PeerArgs& a) {
    const int lane = F.lane, sub = lane & 7, g8 = lane >> 3, label = F.vcu >> 5, rank = F.vcu & 31;
    constexpr int TS = 32 * NWAVES, NT = M / TS;
#pragma unroll 1
    for (int ps = 0; ps < NSL / 8; ++ps) {
        const int s = label + 8 * ps;
        const unsigned char* tab = a.PU + (size_t)s * NEXP * ROWB + sub * 16;
        float* part = a.PART + (size_t)label * M * 128;
        const int t0 = rank * NWAVES + F.wave;
        v4u wA[8], wB[8], ix0, ix1, ix2, ix3, h0, h1 = {0u, 0u, 0u, 0u}, n0, n1 = {0u, 0u, 0u, 0u};
        { const GAS v4u* ip = (const GAS v4u*)(a.IDX + (size_t)t0 * 128 + 16 * g8); ix0 = ip[0]; ix1 = ip[1]; ix2 = ip[2]; ix3 = ip[3]; }
        pk_issue8(tab, ix0, ix1, wA); pk_issue8(tab, ix2, ix3, wB);
        { const bf16* hp = a.H2 + (size_t)t0 * D + s * CW + sub * CPL; h0 = *(const GAS v4u*)hp; if (TBL_FP8) h1 = *(const GAS v4u*)(hp + 8); }
        { const GAS v4u* ip = (const GAS v4u*)(a.IDX + (size_t)(t0 + TS) * 128 + 16 * g8); ix0 = ip[0]; ix1 = ip[1]; ix2 = ip[2]; ix3 = ip[3]; }
#pragma unroll 1
        for (int k = 0; k < NT; ++k) { const int tk = t0 + k * TS, tn = (k + 1 < NT) ? tk + TS : tk, tnn = (k + 2 < NT) ? tk + 2 * TS : tk;
            float val[16];
            p9_half(wA, h0, h1, val); SBAR();
            pk_issue8(tab, ix0, ix1, wA); SBAR();
            p9_half(wB, h0, h1, val + 8); SBAR();
            pk_issue8(tab, ix2, ix3, wB); { const bf16* hp = a.H2 + (size_t)tn * D + s * CW + sub * CPL; n0 = *(const GAS v4u*)hp; if (TBL_FP8) n1 = *(const GAS v4u*)(hp + 8); }
            { const GAS v4u* ip = (const GAS v4u*)(a.IDX + (size_t)tnn * 128 + 16 * g8); ix0 = ip[0]; ix1 = ip[1]; ix2 = ip[2]; ix3 = ip[3]; } SBAR();
            if (sub == 0) { GAS f32x4* pp = (GAS f32x4*)(part + (size_t)tk * 128 + 16 * g8);
#pragma unroll
                for (int q = 0; q < 4; ++q) { f32x4 v = {val[4 * q], val[4 * q + 1], val[4 * q + 2], val[4 * q + 3]}; if (ps > 0) v += pp[q]; pp[q] = v; } }
            h0 = n0; h1 = n1;
        }
    }
}
__device__ __forceinline__ void p10_acomb(const Frame& F, const PeerArgs& a) {
    const long gt = (long)(F.vcu * NWAVES + F.wave) * 64 + F.lane, NT = (long)F.G * NWAVES * 64, n4 = (long)M * 128 / 4;
    for (long i = gt; i < n4; i += NT) { f32x4 s = *(const GAS f32x4*)(a.PART + i * 4);
#pragma unroll
        for (int j = 1; j < 8; ++j) s += *(const GAS f32x4*)(a.PART + (size_t)j * M * 128 + i * 4);
        const f32x4 g = *(const GAS f32x4*)(a.GATE + i * 4);
        *(GAS f32x4*)(a.A + i * 4) = (f32x4){gelu_tanh(s[0]) * g[0], gelu_tanh(s[1]) * g[1], gelu_tanh(s[2]) * g[2], gelu_tanh(s[3]) * g[3]}; }
}
__device__ __forceinline__ void p11_half(const v4u (&w)[8], const f32x4 aa, const f32x4 ab, float (&acc)[CPL]) {
#pragma unroll
    for (int i = 0; i < 8; ++i) { const float ai = i == 0 ? aa.x : i == 1 ? aa.y : i == 2 ? aa.z : i == 3 ? aa.w : i == 4 ? ab.x : i == 5 ? ab.y : i == 6 ? ab.z : ab.w;
#if TBL_FP8
        f32x2 f[8]; tbl_unpack2(w[i], f); const f32x2 a2 = {ai, ai};
#pragma unroll
        for (int c = 0; c < 8; ++c) { f32x2 t = {acc[2 * c], acc[2 * c + 1]}; t = f[c] * a2 + t; acc[2 * c] = t.x; acc[2 * c + 1] = t.y; }
#else
        float f[CPL]; tbl_unpack(w[i], f);
#pragma unroll
        for (int c = 0; c < CPL; ++c) acc[c] += ai * f[c];
#endif
    }
}
__device__ __forceinline__ void p11_vaxpy(const Frame& F, const PeerArgs& a) {
    const int lane = F.lane, sub = lane & 7, g8 = lane >> 3, label = F.vcu >> 5, rank = F.vcu & 31;
    constexpr int TS = 32 * NWAVES, NT = M / TS;
#pragma unroll 1
    for (int ps = 0; ps < NSL / 8; ++ps) {
        const int s = label + 8 * ps;
        const unsigned char* tab = a.PV + (size_t)s * NEXP * ROWB + sub * 16;
        const int t0 = rank * NWAVES + F.wave;
        v4u wA[8], wB[8], ix0, ix1, ix2, ix3; f32x4 a0, a1, a2, a3, m0, m1, m2, m3;
        { const GAS v4u* ip = (const GAS v4u*)(a.IDX + (size_t)t0 * 128 + 16 * g8); ix0 = ip[0]; ix1 = ip[1]; ix2 = ip[2]; ix3 = ip[3]; }
        pk_issue8(tab, ix0, ix1, wA); pk_issue8(tab, ix2, ix3, wB);
        { const GAS f32x4* ap = (const GAS f32x4*)(a.A + (size_t)t0 * 128 + 16 * g8); a0 = ap[0]; a1 = ap[1]; a2 = ap[2]; a3 = ap[3]; }
        { const GAS v4u* ip = (const GAS v4u*)(a.IDX + (size_t)(t0 + TS) * 128 + 16 * g8); ix0 = ip[0]; ix1 = ip[1]; ix2 = ip[2]; ix3 = ip[3]; }
        m0 = a0; m1 = a1; m2 = a2; m3 = a3;
#pragma unroll 1
        for (int k = 0; k < NT; ++k) { const int tk = t0 + k * TS, tn = (k + 1 < NT) ? tk + TS : tk, tnn = (k + 2 < NT) ? tk + 2 * TS : tk;
            float acc[CPL];
#pragma unroll
            for (int c = 0; c < CPL; ++c) acc[c] = 0.f;
            p11_half(wA, a0, a1, acc); SBAR();
            pk_issue8(tab, ix0, ix1, wA); SBAR();
            p11_half(wB, a2, a3, acc); SBAR();
            pk_issue8(tab, ix2, ix3, wB); { const GAS f32x4* ap = (const GAS f32x4*)(a.A + (size_t)tn * 128 + 16 * g8); m0 = ap[0]; m1 = ap[1]; m2 = ap[2]; m3 = ap[3]; }
            { const GAS v4u* ip = (const GAS v4u*)(a.IDX + (size_t)tnn * 128 + 16 * g8); ix0 = ip[0]; ix1 = ip[1]; ix2 = ip[2]; ix3 = ip[3]; } SBAR();
#pragma unroll
            for (int c = 0; c < CPL; ++c) acc[c] = red_groups(acc[c]) * (1.f / V_SCALE);
            if (g8 == 0) { GAS f32x4* yp = (GAS f32x4*)(a.Y + (size_t)tk * D + s * CW + sub * CPL);
#pragma unroll
                for (int q = 0; q < CPL / 4; ++q) yp[q] = (f32x4){acc[4 * q], acc[4 * q + 1], acc[4 * q + 2], acc[4 * q + 3]}; }
            a0 = m0; a1 = m1; a2 = m2; a3 = m3;
        }
    }
}
__device__ __forceinline__ void p12_final(const Frame& F, const PeerArgs& a) {
    const int gw = F.vcu * NWAVES + F.wave, NGW = F.G * NWAVES;
    for (int m = gw; m < M; m += NGW) { const int b = m >> 12; const float* gt2 = a.mod + b * NMOD + 5 * D;
        const GAS f32x4* yr = (const GAS f32x4*)(a.Y + (size_t)m * D) + F.lane; GAS f32x4* orow = (GAS f32x4*)(a.io + (size_t)m * D) + F.lane;
        f32x4 v[4]; float ss = 0.f;
#pragma unroll
        for (int j = 0; j < 4; ++j) { v[j] = yr[64 * j]; ss += (v[j].x * v[j].x + v[j].y * v[j].y) + (v[j].z * v[j].z + v[j].w * v[j].w); }
        const float rs = 1.f / sqrtf(wave_sum(ss) * (1.f / D) + EPS);
#pragma unroll
        for (int j = 0; j < 4; ++j) { const int col = 256 * j + 4 * F.lane; const f32x4 g = *(const f32x4*)(a.g_post2 + col), gt = *(const f32x4*)(gt2 + col);
            orow[64 * j] = orow[64 * j] + gt * (v[j] * rs * g); }
    }
}


#ifndef DBG_STOP
#define DBG_STOP 99
#endif
__device__ __forceinline__ void dbg_dump(const Frame& F, float* out, const bf16* b0, const bf16* b1, const bf16* b2, const bf16* b3, const bf16* b4) {
    const int gw = F.vcu * NWAVES + F.wave, NGW = F.G * NWAVES;
    for (int m = gw; m < M; m += NGW) {
#pragma unroll
        for (int j = 0; j < 4; ++j) { const size_t off = (size_t)m * D + 256 * j + 4 * F.lane; f32x4 s = {0.f, 0.f, 0.f, 0.f};
            const bf16* bs[5] = {b0, b1, b2, b3, b4};
#pragma unroll
            for (int k = 0; k < 5; ++k) if (bs[k]) { const v2u w = *(const GAS v2u*)(bs[k] + off); s += (f32x4){bflo(w.x), bfhi(w.x), bflo(w.y), bfhi(w.y)}; }
            *(GAS f32x4*)(out + off) = s; }
    }
}
struct Args { const void* in[26]; float* out; unsigned char* ws; int ph_lo, ph_hi; };
__global__ void __launch_bounds__(NWAVES * 64, 2) mk_fwd(Args args) {
    extern __shared__ __attribute__((aligned(16))) unsigned char lds[];
    Frame F;
    F.lds = (LAS unsigned char*)lds;
    F.tid = threadIdx.x; F.lane = F.tid & 63; F.wave = __builtin_amdgcn_readfirstlane(F.tid >> 6);
    F.G = gridDim.x; { const int bx = blockIdx.x; F.vcu = (F.G % 8 == 0) ? (bx % 8) * (F.G / 8) + bx / 8 : bx; }
    unsigned char* ws = args.ws;
    gu32* ctl = (gu32*)(ws + WS_CTL);
    volatile LAS unsigned* MISC = (volatile LAS unsigned*)(F.lds + MISC_OFF);
    for (int u = F.tid; u < (LDS_BYTES - LDSCTL_OFF) / 4; u += NWAVES * 64) ((LAS unsigned*)(F.lds + LDSCTL_OFF))[u] = 0u;
    __syncthreads();
    XcdBarrier bar; bar.bar = (unsigned*)(ctl + CW_BAR); bar.x = 0; bar.st = nullptr;
    if (N_LAUNCHES == 1) bar = xcd_barrier_post((unsigned*)(ctl + CW_BAR), MISC + 8);
#define GRID_BAR() do { if (N_LAUNCHES == 1) xcd_barrier(bar); } while (0)
    const int lo = args.ph_lo, hi = args.ph_hi;
#ifndef PH_MASK
#define PH_MASK 0x1FFF
#endif
#define IN(k) ((((PH_MASK) >> (k)) & 1) && (k) <= DBG_STOP && lo <= (k) && (k) < hi)
#define BOTH(k) (IN(k) && IN((k) + 1))
#ifndef REP_MASK
#define REP_MASK 0
#endif
#define NREP(k) ((((REP_MASK) >> (k)) & 1) ? 2 : 1)
    const float* x = (const float*)args.in[0]; const float* mod = (const float*)(ws + WS_MOD);
    float* out = args.out;
    bf16* GA = (bf16*)out; bf16* GG = (bf16*)out + (size_t)M * D;

    if (IN(0)) {
        P0Args a{(const float*)args.in[1], (const float*)args.in[3], (const float*)args.in[4], (const float*)args.in[7], (const float*)args.in[13], (const float*)args.in[18], (const float*)args.in[19],
                 (const float*)args.in[22], (const float*)args.in[23], (const float*)args.in[16], (const int*)args.in[2], ws};
        for (int rep = 0; rep < NREP(0); ++rep) p0_prologue(F, a); if (BOTH(0)) GRID_BAR();
    }
    if (IN(1)) { for (int rep = 0; rep < NREP(1); ++rep) p1_xn(F, x, (const float*)args.in[5], mod, (bf16*)(ws + WS_XN)); if (BOTH(1)) GRID_BAR(); }
    if (IN(2)) {
        pg8::Gemm g{(const bf16*)(ws + WS_XN), nullptr, (const bf16*)(ws + WS_WIN), nullptr, M, NIN, D}; pg8::StaticOrder S; S.init(M, NIN, F.G, (int)blockIdx.x);
        pg8::EpiInProj E{(bf16*)(ws + WS_Q), (bf16*)(ws + WS_K), (bf16*)(ws + WS_V), (bf16*)(ws + WS_U), (bf16*)(ws + WS_ZV), GA, GG, (const float*)(ws + WS_ROPE), (float*)(ws + WS_STATS)};
        for (int rep = 0; rep < NREP(2); ++rep) pg8::gemm_phase<pg8::EpiInProj, pg8::StaticOrder, true, true>(F.lds, g, S, E);
        if (BOTH(2)) GRID_BAR();
    }
    if (IN(3)) {
        GmlpArgs ga{(const bf16*)(ws + WS_ZV), (bf16*)(ws + WS_U), (const float*)(ws + WS_STATS), (const float*)args.in[14], (const float*)args.in[15], (const bf16*)(ws + WS_WSP), (const float*)args.in[17]};
#ifndef NO_GMLP
        p3_gmlp(F, ga);
#endif
        float lam;
        { const float* lq1 = (const float*)args.in[8]; const float* lk1 = (const float*)args.in[9]; const float* lq2 = (const float*)args.in[10]; const float* lk2 = (const float*)args.in[11];
          float s1 = 0.f, s2 = 0.f; for (int i = 0; i < 64; ++i) { s1 += lq1[i] * lk1[i]; s2 += lq2[i] * lk2[i]; }
          lam = __expf(s1) - __expf(s2) + 0.2f; }
        const bf16* Qb = (const bf16*)(ws + WS_Q); const bf16* Kb = (const bf16*)(ws + WS_K); const bf16* Vb = (const bf16*)(ws + WS_V);
        float* stash = (float*)(ws + WS_O0) + (size_t)blockIdx.x * 32768;
#ifndef NO_ATT
#ifndef ATT_VAR
#define ATT_VAR 0
#endif
        if (NREP(3) == 2)
        for (int uu = F.vcu; uu < 1024; uu += F.G) {
            const int bh = uu >> 4, qb = uu & 15, b = bh >> 3, h = bh & 7; const size_t ro = (size_t)b * SEQ * D + h * 128;
            att::attn_unit(Qb + ro, Kb + ro, Vb + ro, (bf16*)(ws + 424 * MiB) + ro, qb * 256, lam, (const float*)args.in[12], stash, (char*)lds); }
        for (int uu = F.vcu; uu < 1024; uu += F.G) {
            const int bh = uu >> 4, qb = uu & 15, b = bh >> 3, h = bh & 7; const size_t ro = (size_t)b * SEQ * D + h * 128;
            att::attn_unit(Qb + ro, Kb + ro, Vb + ro, (bf16*)(ws + WS_Q) + ro, qb * 256, lam, (const float*)args.in[12], stash, (char*)lds); }
#endif
        if (BOTH(3)) GRID_BAR();
    }
    if (IN(4)) {
        pg8::Gemm g{(const bf16*)(ws + WS_Q), (const bf16*)(ws + WS_U), (const bf16*)(ws + WS_WA), (const bf16*)(ws + WS_WG), M, D, D}; pg8::StaticOrder S; S.init(M, D, F.G, (int)blockIdx.x, 2);
        pg8::EpiMerge E{GA, GG, (bf16*)(ws + WS_MIXIN)};
        for (int rep = 0; rep < NREP(4); ++rep) pg8::gemm_phase<pg8::EpiMerge, pg8::StaticOrder, true, true>(F.lds, g, S, E);
        if (BOTH(4)) GRID_BAR();
    }
    if (IN(5)) {
        pg8::Gemm g{(const bf16*)(ws + WS_MIXIN), nullptr, (const bf16*)(ws + WS_WOUT), nullptr, M, D, D}; pg8::StaticOrder S; S.init(M, D, F.G, (int)blockIdx.x);
        pg8::EpiF32 E{out, D};
        for (int rep = 0; rep < NREP(5); ++rep) pg8::gemm_phase<pg8::EpiF32, pg8::StaticOrder, true, true>(F.lds, g, S, E);
        if (BOTH(5)) GRID_BAR();
    }
    if (IN(6)) {
        p6_rows(F, x, out, (const float*)args.in[6], (const float*)args.in[20], mod, (bf16*)(ws + WS_H2));
        cvt_table(F, (const float*)args.in[24], ws + WS_PU, U_SCALE);
        cvt_table(F, (const float*)args.in[25], ws + WS_PV, V_SCALE);
        if (BOTH(6)) GRID_BAR();
    }
    if (IN(7)) {
        pg8::Gemm g{(const bf16*)(ws + WS_H2), nullptr, (const bf16*)(ws + WS_WPQ), nullptr, M, NPQ, D}; pg8::StaticOrder S; S.init(M, NPQ, F.G, (int)blockIdx.x);
        pg8::EpiBf16<0> E{(bf16*)(ws + WS_QP), NPQ, nullptr, 0, 0, 1.f};
        for (int rep = 0; rep < NREP(7); ++rep) pg8::gemm_phase<pg8::EpiBf16<0>, pg8::StaticOrder, true, true>(F.lds, g, S, E);
        if (BOTH(7)) GRID_BAR();
    }
    if (IN(8)) { RouteArgs ra{(const bf16*)(ws + WS_QP), (const bf16*)(ws + WS_KEYS), (int*)(ws + WS_IDX), (float*)(ws + WS_GATE)}; for (int rep = 0; rep < NREP(8); ++rep) p8_route(F, ra); if (BOTH(8)) GRID_BAR(); }
    PeerArgs pa{(const bf16*)(ws + WS_H2), (const int*)(ws + WS_IDX), (const float*)(ws + WS_GATE), ws + WS_PU, ws + WS_PV, (float*)(ws + WS_PART), (float*)(ws + WS_A), (float*)(ws + WS_Y), out, (const float*)args.in[21], mod};
    if (IN(9)) { for (int rep = 0; rep < NREP(9); ++rep) p9_udots(F, pa); if (BOTH(9)) GRID_BAR(); }
    if (IN(10)) { for (int rep = 0; rep < NREP(10); ++rep) p10_acomb(F, pa); if (BOTH(10)) GRID_BAR(); }
    if (IN(11)) { for (int rep = 0; rep < NREP(11); ++rep) p11_vaxpy(F, pa); if (BOTH(11)) GRID_BAR(); }
    if (IN(12)) { p12_final(F, pa); }
    if (DBG_STOP < 9 && lo <= DBG_STOP && DBG_STOP < hi) {
        if (N_LAUNCHES == 1) GRID_BAR();
        if (N_LAUNCHES != 1) {   }
    }
    if (DBG_STOP < 9 && ((N_LAUNCHES == 1 && hi > DBG_STOP) || (N_LAUNCHES != 1 && lo == DBG_STOP + 1))) {
        if (DBG_STOP == 2) dbg_dump(F, out, GA, nullptr, nullptr, nullptr, nullptr);
        if (DBG_STOP == 3) dbg_dump(F, out, (const bf16*)(ws + WS_Q), (const bf16*)(ws + WS_U), nullptr, nullptr, nullptr);
        if (DBG_STOP == 4) dbg_dump(F, out, (const bf16*)(ws + WS_MIXIN), nullptr, nullptr, nullptr, nullptr);

        if (DBG_STOP == 7) dbg_dump(F, out, (const bf16*)(ws + WS_QP), (const bf16*)(ws + WS_QP) + (size_t)M * D, nullptr, nullptr, nullptr);
        if (DBG_STOP == 8) dbg_dump(F, out, (const bf16*)(ws + WS_IDX), (const bf16*)(ws + WS_GATE), nullptr, nullptr, nullptr);
    }
#undef IN
#undef BOTH
}

extern "C" void kernel_launch(void* const* d_in, const int* in_sizes, int n_in, void* d_out, int out_size, void* d_ws, size_t ws_size, hipStream_t stream) {
    static int grid = 0;
    if (grid == 0) {
        if (n_in != 26 || in_sizes[0] != M * D || out_size != M * D || ws_size < WS_END) { fprintf(stderr, "kernel_launch: shape/workspace mismatch (n_in %d, in0 %d, out %d, ws %zu, need %zu)\n", n_in, n_in > 0 ? in_sizes[0] : -1, out_size, ws_size, (size_t)WS_END); grid = -1; return; }
        int dev = 0, cus = 0, per_cu = 0;
        if (hipGetDevice(&dev) != hipSuccess || hipDeviceGetAttribute(&cus, hipDeviceAttributeMultiprocessorCount, dev) != hipSuccess) { grid = -1; return; }
        if (hipFuncSetAttribute((const void*)mk_fwd, hipFuncAttributeMaxDynamicSharedMemorySize, LDS_BYTES) != hipSuccess) { fprintf(stderr, "kernel_launch: hipFuncSetAttribute failed\n"); grid = -1; return; }
        if (hipOccupancyMaxActiveBlocksPerMultiprocessor(&per_cu, (const void*)mk_fwd, NWAVES * 64, LDS_BYTES) != hipSuccess || per_cu < 1) { fprintf(stderr, "kernel_launch: occupancy query says %d\n", per_cu); per_cu = 1; }
        (void)hipGetLastError();
        grid = cus;
        if (grid % 8 != 0 || grid > 256) fprintf(stderr, "kernel_launch: note: grid %d\n", grid);
    }
    if (grid < 0) return;
    if (hipMemsetAsync((char*)d_ws + WS_CTL, 0, CTL_ZERO_BYTES, stream) != hipSuccess) { fprintf(stderr, "kernel_launch: memset failed\n"); return; }
    Args a{};
    for (int i = 0; i < 26; ++i) a.in[i] = d_in[i];
    a.out = (float*)d_out; a.ws = (unsigned char*)d_ws;
    for (int li = 0; li < N_LAUNCHES; ++li) {
        a.ph_lo = (N_LAUNCHES == 1) ? 0 : li; a.ph_hi = (N_LAUNCHES == 1) ? NPHASE : li + 1;
        hipLaunchKernelGGL(mk_fwd, dim3(grid), dim3(NWAVES * 64), LDS_BYTES, stream, a);
        const hipError_t le = hipPeekAtLastError();
        if (le != hipSuccess) { fprintf(stderr, "kernel_launch: launch %d failed: %s\n", li, hipGetErrorName(le)); break; }
    }
}
```

```cpp
#include <hip/hip_runtime.h>
#include <cstdio>
#include <cstdint>
namespace pg8 {
#define PG8_LAS __attribute__((address_space(3)))
typedef unsigned short bf16_t;
typedef short bf16x8 __attribute__((ext_vector_type(8)));
typedef float f32x4 __attribute__((ext_vector_type(4)));
typedef unsigned u32x4 __attribute__((ext_vector_type(4)));
constexpr int BM = 256, BK = 64, HALF = 128, HTB = HALF * BK * 2  , STAGE_BYTES = 8 * HTB, NXCD = 8, WGM = 8;

__host__ __device__ __forceinline__ int lds_byte(int r, int c) { const int st = (r >> 4) * 2 + (c >> 5), rr = r & 15, cc = c & 31, ob = rr * 64 + cc * 2; return st * 1024 + (ob ^ (((ob >> 9) & 1) << 5)); }
__host__ __device__ __forceinline__ void stage_rc(int b, int& R, int& C) { const int st = b / 1024, sb = b % 1024, swz = sb ^ (((sb >> 9) & 1) << 5); R = (st >> 1) * 16 + swz / 64; C = (st & 1) * 32 + (swz % 64) / 2; }
__host__ __device__ __forceinline__ int perm32(int rho) { const int n = rho >> 4, i = rho & 15; return 8 * (i >> 2) + 4 * n + (i & 3); }

struct Unit { int pm, pn, w; };
struct Gemm { const bf16_t* A0; const bf16_t* A1; const bf16_t* B0; const bf16_t* B1; int M, N, K; };

struct StaticOrder {
    int nM, nN, nwg, G, c, passes;
    __host__ __device__ void init(int M, int N, int G_, int c_, int passes_ = 1) { nM = M / BM; nN = N / BM; nwg = nM * nN; G = G_; c = c_; passes = passes_; }
    __host__ __device__ bool next(int i, Unit& u) const {
        const int ti = (passes == 2) ? (i >> 1) : i; u.w = (passes == 2) ? (i & 1) : 0;
        const long L = (long)ti * G + c; if (L >= nwg) return false;
        int wgid = (int)L; { const int q = nwg / NXCD, r = nwg % NXCD, xcd = wgid % NXCD, off = wgid / NXCD; wgid = (xcd < r ? xcd * (q + 1) : r * (q + 1) + (xcd - r) * q) + off; }
        const int nig = WGM * nN, gid = wgid / nig, fm = gid * WGM, gsz = (nM - fm) < WGM ? (nM - fm) : WGM;
        u.pm = fm + ((wgid % nig) % gsz); u.pn = (wgid % nig) / gsz; return true;
    }
    __device__ __forceinline__ void a_ready(const Unit&) const {}
    __device__ __forceinline__ void done(const Unit&) const {}
};

typedef float f32x2c __attribute__((ext_vector_type(2))); typedef __bf16 bf16x2c __attribute__((ext_vector_type(2)));
__device__ __forceinline__ unsigned cvt_pk_bf16(float lo, float hi) { f32x2c v = {lo, hi}; bf16x2c b = __builtin_convertvector(v, bf16x2c); return __builtin_bit_cast(unsigned, b); }
typedef float f32x2 __attribute__((ext_vector_type(2)));
__device__ __forceinline__ f32x2 gelu_pk(f32x2 v) {
    const f32x2 av = __builtin_elementwise_abs(v), d = av * 0.2316418882f + 1.0f;
    f32x2 t; t.x = __builtin_amdgcn_rcpf(d.x); t.y = __builtin_amdgcn_rcpf(d.y);
    f32x2 q = t * 0.5307027145f + (-0.7265760135f); q = q * t + 0.7107068705f; q = q * t + (-0.142248368f); q = q * t + 0.127414796f; q = q * t;
    const f32x2 s = (v * v) * (-0.72134752044f);
    f32x2 e; e.x = __builtin_amdgcn_exp2f(s.x); e.y = __builtin_amdgcn_exp2f(s.y);
    const f32x2 m = v * (q * e), r = v - m;
    f32x2 o; o.x = v.x < 0.f ? m.x : r.x; o.y = v.y < 0.f ? m.y : r.y; return o;
}

template <int ACT  > struct EpiBf16 {
    static constexpr bool PERM = true, AFTER_DRAIN = false; static_assert(ACT == 0 || ACT == 1, "EpiBf16: ACT is 0 (none) or 1 (gelu_pk)");
    bf16_t* O; int ldc; const float* bias; int split_cols; size_t split_stride; float scale0;
    __device__ __forceinline__ void operator()(const f32x4 (&acc)[2][2][4][2], const Unit& u, int wr, int wc, int fr, int fq) const {
        const int row0 = u.pm * BM + wr * 64 + fr; int colt = u.pn * BM; bf16_t* base = O;
        float sc = 1.f; if (split_cols) { const int t = colt / split_cols; base += (size_t)t * split_stride; colt -= t * split_cols; if (t == 0) sc = scale0; }
        const int col0 = colt + wc * 32 + 8 * fq, bcol0 = u.pn * BM + wc * 32 + 8 * fq;
        f32x4 bv[2][2];
#pragma unroll
        for (int bj = 0; bj < 2; ++bj)
#pragma unroll
            for (int n = 0; n < 2; ++n) bv[bj][n] = bias ? *(const f32x4*)(bias + bcol0 + bj * HALF + 4 * n) : (f32x4){0.f, 0.f, 0.f, 0.f};
#pragma unroll
        for (int ai = 0; ai < 2; ++ai)
#pragma unroll
            for (int m = 0; m < 4; ++m) { bf16_t* rowp = base + (size_t)(row0 + ai * HALF + m * 16) * ldc + col0;
#pragma unroll
                for (int bj = 0; bj < 2; ++bj) { f32x4 v0 = acc[ai][bj][m][0] + bv[bj][0], v1 = acc[ai][bj][m][1] + bv[bj][1];
                    if (ACT == 1) { f32x2 a = gelu_pk((f32x2){v0[0], v0[1]}), b = gelu_pk((f32x2){v0[2], v0[3]}), c = gelu_pk((f32x2){v1[0], v1[1]}), d = gelu_pk((f32x2){v1[2], v1[3]});
                        v0 = (f32x4){a.x, a.y, b.x, b.y}; v1 = (f32x4){c.x, c.y, d.x, d.y}; }
                    v0 = v0 * sc; v1 = v1 * sc; u32x4 w; w.x = cvt_pk_bf16(v0[0], v0[1]); w.y = cvt_pk_bf16(v0[2], v0[3]); w.z = cvt_pk_bf16(v1[0], v1[1]); w.w = cvt_pk_bf16(v1[2], v1[3]);
                    *(u32x4*)(rowp + bj * HALF) = w; } }
    }
};

template <class Epi, class Sched, bool ALIGN_EPI = false, bool SP2 = false>
__device__ __forceinline__ void gemm_phase(PG8_LAS unsigned char* lds, const Gemm g, const Sched& S, const Epi& E) {
    const int tid = threadIdx.x, wid = __builtin_amdgcn_readfirstlane(tid >> 6), lane = tid & 63, wr = wid >> 2, wc = wid & 3, fr = lane & 15, fq = lane >> 4;
    const int K = g.K, nt = K / BK;
    unsigned voffA[2], voffB[2];
#pragma unroll
    for (int i = 0; i < 2; ++i) { int R, C; stage_rc(tid * 16 + i * 8192, R, C); const int Rb = Epi::PERM ? ((R & ~31) + perm32(R & 31)) : R;
        voffA[i] = (unsigned)(R * K + C) * 2u; voffB[i] = (unsigned)(Rb * K + C) * 2u; }
    const size_t kstep = (size_t)(BK * 2);
    const size_t hstep = (size_t)HALF * K * 2;
    const size_t tstep = 2 * hstep;
    const unsigned ldsw = (unsigned)wid * 1024u;
    const int aoff = lds_byte(wr * 64 + fr, fq * 8), boff = lds_byte(wc * 32 + fr, fq * 8);
#define PG8_SA(b, h) (((b) * 2 + (h)) * HTB)
#define PG8_SB(b, h) ((4 + (b) * 2 + (h)) * HTB)
#define PG8_STAGE(bufoff, gbase, voff) do { _Pragma("unroll") for (int _i = 0; _i < 2; ++_i) \
        __builtin_amdgcn_global_load_lds((const unsigned*)((const char*)(gbase) + (voff)[_i]), (PG8_LAS unsigned*)(lds + (bufoff) + ldsw + _i * 8192), 16, 0, 0); } while (0)
#define PG8_LDA(dst, b, h) do { _Pragma("unroll") for (int m = 0; m < 4; ++m) _Pragma("unroll") for (int k = 0; k < 2; ++k) dst[m][k] = *(const PG8_LAS bf16x8*)(lds + PG8_SA(b, h) + aoff + m * 2048 + k * 1024); } while (0)
#define PG8_LDB(dst, b, h) do { _Pragma("unroll") for (int n = 0; n < 2; ++n) _Pragma("unroll") for (int k = 0; k < 2; ++k) dst[n][k] = *(const PG8_LAS bf16x8*)(lds + PG8_SB(b, h) + boff + n * 2048 + k * 1024); } while (0)
#define PG8_MMA(ai, bj, At, Bt) do { __builtin_amdgcn_s_setprio(1); _Pragma("unroll") for (int m = 0; m < 4; ++m) _Pragma("unroll") for (int n = 0; n < 2; ++n) _Pragma("unroll") for (int k = 0; k < 2; ++k) \
        acc[ai][bj][m][n] = __builtin_amdgcn_mfma_f32_16x16x32_bf16(Bt[n][k], At[m][k], acc[ai][bj][m][n], 0, 0, 0); __builtin_amdgcn_s_setprio(0); } while (0)
#define PG8_WAIT_V(n) asm volatile("s_waitcnt vmcnt(" #n ")" ::: "memory")
#define PG8_WAIT_L(n) asm volatile("s_waitcnt lgkmcnt(" #n ")" ::: "memory")
#define PG8_BAR __builtin_amdgcn_s_barrier()
#define PG8_SCHED __builtin_amdgcn_sched_barrier(0)
    Unit cur, nxt; int ui = 0;
    if (!S.next(0, cur)) return;
    f32x4 acc[2][2][4][2];
#pragma unroll
    for (int a = 0; a < 2; ++a)
#pragma unroll
        for (int b = 0; b < 2; ++b)
#pragma unroll
            for (int m = 0; m < 4; ++m)
#pragma unroll
                for (int n = 0; n < 2; ++n) acc[a][b][m][n] = (f32x4){0.f, 0.f, 0.f, 0.f};
    bf16x8 At[4][2], B0[2][2], B1[2][2];
    const char* cA = (const char*)(cur.w ? g.A1 : g.A0) + (size_t)cur.pm * tstep; const char* cB = (const char*)(cur.w ? g.B1 : g.B0) + (size_t)cur.pn * tstep;
    S.a_ready(cur);
    if constexpr (SP2) {
        PG8_STAGE(PG8_SB(0, 0), cB, voffB); PG8_STAGE(PG8_SB(0, 1), cB + hstep, voffB); PG8_STAGE(PG8_SA(0, 0), cA, voffA); PG8_STAGE(PG8_SA(0, 1), cA + hstep, voffA);
        if (wr == 1) PG8_BAR;
        PG8_WAIT_V(2); PG8_BAR;
        PG8_STAGE(PG8_SB(1, 0), cB + kstep, voffB); PG8_STAGE(PG8_SA(1, 0), cA + kstep, voffA); PG8_STAGE(PG8_SB(1, 1), cB + hstep + kstep, voffB);
        PG8_WAIT_V(6); PG8_BAR;
    } else {
        PG8_STAGE(PG8_SB(0, 0), cB, voffB); PG8_STAGE(PG8_SA(0, 0), cA, voffA); PG8_STAGE(PG8_SB(0, 1), cB + hstep, voffB); PG8_STAGE(PG8_SA(0, 1), cA + hstep, voffA);
        if (wr == 1) PG8_BAR;
        PG8_WAIT_V(4); PG8_BAR;
        PG8_STAGE(PG8_SB(1, 0), cB + kstep, voffB); PG8_STAGE(PG8_SA(1, 0), cA + kstep, voffA); PG8_STAGE(PG8_SB(1, 1), cB + hstep + kstep, voffB);
        PG8_WAIT_V(6); PG8_BAR;
    }
    for (;;) {
        const bool has_next = S.next(ui + 1, nxt);
        const char* nA = has_next ? (const char*)(nxt.w ? g.A1 : g.A0) + (size_t)nxt.pm * tstep : cA; const char* nB = has_next ? (const char*)(nxt.w ? g.B1 : g.B0) + (size_t)nxt.pn * tstep : cB;
        for (int t = 0; t < nt; t += 2) {
            const bool last = (t == nt - 2);
            const char* a1 = cA + (size_t)(t + 1) * kstep;
            const char* a2 = last ? nA : cA + (size_t)(t + 2) * kstep; const char* b2 = last ? nB : cB + (size_t)(t + 2) * kstep;
            const char* a3 = a2 + kstep; const char* b3 = b2 + kstep;
            if (last && has_next) S.a_ready(nxt);
            if constexpr (SP2) {
            PG8_LDB(B0, 0, 0); PG8_LDB(B1, 0, 1); PG8_SCHED; PG8_LDA(At, 0, 0); PG8_STAGE(PG8_SA(1, 1), a1 + hstep, voffA);
            PG8_WAIT_V(8); PG8_WAIT_L(0); PG8_BAR; PG8_MMA(0, 0, At, B0); PG8_MMA(0, 1, At, B1); PG8_BAR; PG8_SCHED;
            PG8_LDA(At, 0, 1); PG8_STAGE(PG8_SB(0, 0), b2, voffB); PG8_STAGE(PG8_SB(0, 1), b2 + hstep, voffB); PG8_STAGE(PG8_SA(0, 0), a2, voffA);
            PG8_WAIT_V(8); PG8_WAIT_L(0); PG8_BAR; PG8_MMA(1, 0, At, B0); PG8_MMA(1, 1, At, B1); PG8_BAR; PG8_SCHED;
            PG8_LDB(B0, 1, 0); PG8_LDB(B1, 1, 1); PG8_SCHED; PG8_LDA(At, 1, 0); PG8_STAGE(PG8_SA(0, 1), a2 + hstep, voffA);
            PG8_WAIT_V(8); PG8_WAIT_L(0); PG8_BAR; PG8_MMA(0, 0, At, B0); PG8_MMA(0, 1, At, B1); PG8_BAR; PG8_SCHED;
            PG8_LDA(At, 1, 1); PG8_STAGE(PG8_SB(1, 0), b3, voffB); PG8_STAGE(PG8_SB(1, 1), b3 + hstep, voffB); PG8_STAGE(PG8_SA(1, 0), a3, voffA);
            PG8_WAIT_V(8); PG8_WAIT_L(0); PG8_BAR; PG8_MMA(1, 0, At, B0); PG8_MMA(1, 1, At, B1); PG8_BAR; PG8_SCHED;
            } else {
            PG8_LDB(B0, 0, 0); PG8_SCHED; PG8_LDA(At, 0, 0); PG8_STAGE(PG8_SA(1, 1), a1 + hstep, voffA);
            PG8_WAIT_L(8); PG8_BAR; PG8_WAIT_L(0); PG8_MMA(0, 0, At, B0); PG8_BAR; PG8_SCHED;
            PG8_LDB(B1, 0, 1); PG8_STAGE(PG8_SB(0, 0), b2, voffB);
            PG8_BAR; PG8_WAIT_L(0); PG8_MMA(0, 1, At, B1); PG8_BAR;
            PG8_LDA(At, 0, 1); PG8_STAGE(PG8_SA(0, 0), a2, voffA);
            PG8_BAR; PG8_WAIT_L(0); PG8_MMA(1, 0, At, B0); PG8_BAR; PG8_SCHED;
            PG8_STAGE(PG8_SB(0, 1), b2 + hstep, voffB);
            PG8_WAIT_V(6); PG8_BAR; PG8_MMA(1, 1, At, B1); PG8_BAR;
            PG8_LDB(B0, 1, 0); PG8_SCHED; PG8_LDA(At, 1, 0); PG8_STAGE(PG8_SA(0, 1), a2 + hstep, voffA);
            PG8_WAIT_L(8); PG8_BAR; PG8_WAIT_L(0); PG8_MMA(0, 0, At, B0); PG8_BAR; PG8_SCHED;
            PG8_LDB(B1, 1, 1); PG8_STAGE(PG8_SB(1, 0), b3, voffB);
            PG8_BAR; PG8_WAIT_L(0); PG8_MMA(0, 1, At, B1); PG8_BAR;
            PG8_LDA(At, 1, 1); PG8_STAGE(PG8_SA(1, 0), a3, voffA);
            PG8_BAR; PG8_WAIT_L(0); PG8_MMA(1, 0, At, B0); PG8_BAR; PG8_SCHED;
            PG8_STAGE(PG8_SB(1, 1), b3 + hstep, voffB);
            PG8_WAIT_V(6); PG8_BAR; PG8_MMA(1, 1, At, B1); PG8_BAR;
            }
        }
        if constexpr (ALIGN_EPI) { if (wr == 0) PG8_BAR; }
        if constexpr (!Epi::AFTER_DRAIN) { E(acc, cur, wr, wc, fr, fq); S.done(cur); }
        if (!has_next) break;
#pragma unroll
        for (int a = 0; a < 2; ++a)
#pragma unroll
            for (int b = 0; b < 2; ++b)
#pragma unroll
                for (int m = 0; m < 4; ++m)
#pragma unroll
                    for (int n = 0; n < 2; ++n) acc[a][b][m][n] = (f32x4){0.f, 0.f, 0.f, 0.f};
        cur = nxt; cA = nA; cB = nB; ++ui;
        if constexpr (ALIGN_EPI) { if (wr == 1) PG8_BAR; }
    }
    PG8_WAIT_V(0);
    if constexpr (!ALIGN_EPI) { if (wr == 0) PG8_BAR; }
    PG8_BAR;
    if constexpr (Epi::AFTER_DRAIN) { E.fused(acc, cur, wr, wc, fr, fq, lds, wid, lane); S.done(cur); }
#undef PG8_SA
#undef PG8_SB
#undef PG8_STAGE
#undef PG8_LDA
#undef PG8_LDB
#undef PG8_MMA
#undef PG8_WAIT_V
#undef PG8_WAIT_L
#undef PG8_BAR
#undef PG8_SCHED
}
}

constexpr int BATCH = 8, SEQ = 4096, D = 1024, M = BATCH * SEQ, NIN = 7168, NMOD = 6 * D, NEXP = 16384, NPQ = 2048;
constexpr float EPS = 1e-6f;
constexpr int NWAVES = 8;
#ifndef MK_N_LAUNCHES
#define MK_N_LAUNCHES 1
#endif
#define DBG_STOP 99
#define PEER_OPT 7
constexpr int NPHASE = 13;
constexpr int N_LAUNCHES = MK_N_LAUNCHES;

constexpr size_t MiB = 1u << 20;
constexpr size_t WS_CTL = 0, CTL_ZERO_BYTES = 2 * MiB;
constexpr size_t WS_MOD = 1 * MiB;
constexpr size_t WS_ROPE = 2 * MiB;
constexpr size_t WS_STATS = 4 * MiB;
constexpr size_t WS_WIN = 8 * MiB, WS_WA = 22 * MiB, WS_WG = 24 * MiB, WS_WOUT = 26 * MiB, WS_WPQ = 28 * MiB, WS_KEYS = 32 * MiB, WS_WSP = 33 * MiB;
constexpr size_t WS_XN = 40 * MiB, WS_Q = 104 * MiB, WS_K = 168 * MiB, WS_V = 232 * MiB, WS_U = 296 * MiB, WS_ZV = 360 * MiB, WS_END = 424 * MiB;
constexpr size_t WS_O0 = WS_XN;
constexpr size_t WS_T1 = WS_K;
constexpr size_t WS_MIXIN = WS_ZV;
constexpr size_t WS_H2 = WS_XN;
constexpr size_t WS_QP = WS_K;
constexpr size_t WS_IDX = WS_U, WS_GATE = WS_U + 16 * MiB;
constexpr size_t WS_PU = WS_Q, WS_PV = WS_Q + 32 * MiB;
constexpr size_t WS_PART = WS_K;
constexpr size_t WS_A = WS_U + 32 * MiB;
constexpr size_t WS_Y = WS_K;
constexpr int CW_TMO = 0, CW_BAR = 4096;

constexpr int RING_BYTES = 131072, LDSCTL_OFF = RING_BYTES, MISC_OFF = LDSCTL_OFF + 320, LDS_BYTES = 147456;

#define GAS __attribute__((address_space(1)))
#define LAS __attribute__((address_space(3)))
typedef unsigned short bf16;
typedef unsigned v4u __attribute__((ext_vector_type(4)));
typedef unsigned v2u __attribute__((ext_vector_type(2)));
typedef float f32x4 __attribute__((ext_vector_type(4)));
typedef float f32x2 __attribute__((ext_vector_type(2)));
typedef float f32x16 __attribute__((ext_vector_type(16)));
typedef short bf16x8 __attribute__((ext_vector_type(8)));
typedef short s16x4 __attribute__((ext_vector_type(4)));
typedef __bf16 bf16x2_t __attribute__((ext_vector_type(2)));
typedef GAS unsigned gu32;
#define RLX_AGENT __ATOMIC_RELAXED, __HIP_MEMORY_SCOPE_AGENT
#define LDS_WAIT() asm volatile("s_waitcnt lgkmcnt(0)" ::: "memory")
#define VM_WAIT() asm volatile("s_waitcnt vmcnt(0)" ::: "memory")
#define SBAR() __builtin_amdgcn_sched_barrier(0)
__device__ __forceinline__ unsigned f2bf(float f) { unsigned u = __builtin_bit_cast(unsigned, f); return (u + 0x7fffu + ((u >> 16) & 1u)) >> 16; }
__device__ __forceinline__ unsigned pk2(float lo, float hi) { f32x2 v = {lo, hi}; bf16x2_t b = __builtin_convertvector(v, bf16x2_t); return __builtin_bit_cast(unsigned, b); }
__device__ __forceinline__ float bflo(unsigned w) { return __builtin_bit_cast(float, w << 16); }
__device__ __forceinline__ float bfhi(unsigned w) { return __builtin_bit_cast(float, w & 0xffff0000u); }
__device__ __forceinline__ float gelu_tanh(float x) {
    const float u = x * (0.7978845608f + 0.035677408137f * x * x);
    const float e = __builtin_amdgcn_exp2f(-2.885390081777927f * u);
    return x * __builtin_amdgcn_rcpf(1.f + e);
}
__device__ __forceinline__ float sigmoidf_(float x) { return __builtin_amdgcn_rcpf(1.f + __builtin_amdgcn_exp2f(-1.4426950408889634f * x)); }
__device__ __forceinline__ float wave_sum(float v) {
#pragma unroll
    for (int o = 1; o < 64; o <<= 1) v += __shfl_xor(v, o);
    return v;
}
__device__ __forceinline__ int crow(int r, int hi) { return (r & 3) + 8 * (r >> 2) + 4 * hi; }


namespace pg8 {
typedef float f32x2e __attribute__((ext_vector_type(2)));
__device__ __forceinline__ float bf_lo(unsigned w) { return __builtin_bit_cast(float, w << 16); }
__device__ __forceinline__ float bf_hi(unsigned w) { return __builtin_bit_cast(float, w & 0xffff0000u); }
__device__ __forceinline__ float gelu_t(float x) { const float u = x * (0.7978845608f + 0.035677408137f * x * x); const float e = __builtin_amdgcn_exp2f(-2.885390081777927f * u); return x * __builtin_amdgcn_rcpf(1.f + e); }
__device__ __forceinline__ float sigm(float x) { return __builtin_amdgcn_rcpf(1.f + __builtin_amdgcn_exp2f(-1.4426950408889634f * x)); }
__device__ __forceinline__ u32x4 pack8(const f32x4& a, const f32x4& b) { u32x4 w; w.x = cvt_pk_bf16(a[0], a[1]); w.y = cvt_pk_bf16(a[2], a[3]); w.z = cvt_pk_bf16(b[0], b[1]); w.w = cvt_pk_bf16(b[2], b[3]); return w; }

struct EpiInProj {
    static constexpr bool PERM = true, AFTER_DRAIN = false;
    bf16_t* Q; bf16_t* K; bf16_t* V; bf16_t* U; bf16_t* ZV; bf16_t* GA; bf16_t* GG; const float* rope; float* stats;
    __device__ __forceinline__ void operator()(const f32x4 (&acc)[2][2][4][2], const Unit& u, int wr, int wc, int fr, int fq) const {
        const int ty = u.pn >> 2;
        const int row0 = u.pm * BM + wr * 64 + fr;
        const int cc0 = (u.pn & 3) * BM + wc * 32 + 8 * fq;
        bf16_t* base = ty == 0 ? Q : ty == 1 ? K : ty == 2 ? V : ty == 3 ? U : ty == 4 ? ZV : ty == 5 ? GA : GG;
        if (ty <= 1) {
            const bool even = (wc & 1) == 0;
            const bool part = even && fq < 2;
            const float sg = (fq == 0) ? -1.f : 1.f;
#pragma unroll
            for (int ai = 0; ai < 2; ++ai)
#pragma unroll
                for (int m = 0; m < 4; ++m) {
                    const int row = row0 + ai * HALF + m * 16;
                    f32x4 c0 = {1.f, 1.f, 1.f, 1.f}, c1 = c0, s0 = {0.f, 0.f, 0.f, 0.f}, s1 = s0;
                    if (even) { const f32x4* rp = (const f32x4*)(rope + (size_t)row * 16); c0 = rp[0]; c1 = rp[1]; s0 = rp[2]; s1 = rp[3]; }
#pragma unroll
                    for (int bj = 0; bj < 2; ++bj) {
                        f32x4 v0 = acc[ai][bj][m][0], v1 = acc[ai][bj][m][1];
                        if (even) {
                            f32x4 p0, p1;
#pragma unroll
                            for (int j = 0; j < 4; ++j) { p0[j] = __shfl_xor(v0[j], 16); p1[j] = __shfl_xor(v1[j], 16); }
                            if (part) { v0 = v0 * c0 + (p0 * s0) * sg; v1 = v1 * c1 + (p1 * s1) * sg; }
                        }
                        *(u32x4*)(base + (size_t)row * 1024 + cc0 + bj * HALF) = pack8(v0, v1);
                    }
                }
        } else if (ty == 2) {
#pragma unroll
            for (int ai = 0; ai < 2; ++ai)
#pragma unroll
                for (int m = 0; m < 4; ++m) { const int row = row0 + ai * HALF + m * 16;
#pragma unroll
                    for (int bj = 0; bj < 2; ++bj) *(u32x4*)(base + (size_t)row * 1024 + cc0 + bj * HALF) = pack8(acc[ai][bj][m][0], acc[ai][bj][m][1]); }
        } else if (ty <= 4) {
#pragma unroll
            for (int ai = 0; ai < 2; ++ai)
#pragma unroll
                for (int m = 0; m < 4; ++m) { const int row = row0 + ai * HALF + m * 16; float s = 0.f, q = 0.f;
#pragma unroll
                    for (int bj = 0; bj < 2; ++bj) { f32x4 v0 = acc[ai][bj][m][0], v1 = acc[ai][bj][m][1];
#pragma unroll
                        for (int j = 0; j < 4; ++j) { v0[j] = gelu_t(v0[j]); v1[j] = gelu_t(v1[j]); }
                        const u32x4 w = pack8(v0, v1);
                        *(u32x4*)(base + (size_t)row * 1024 + cc0 + bj * HALF) = w;
                        if (ty == 4) {
#pragma unroll
                            for (int j = 0; j < 4; ++j) { const float a = bf_lo(w[j]), b = bf_hi(w[j]); s += a + b; q += a * a + b * b; } }
                    }
                    if (ty == 4) { s += __shfl_xor(s, 16); s += __shfl_xor(s, 32); q += __shfl_xor(q, 16); q += __shfl_xor(q, 32);
                        if (fq == 0) { f32x2e o = {s, q}; *(f32x2e*)(stats + ((size_t)row * 16 + (u.pn & 3) * 4 + wc) * 2) = o; } }
                }
        } else {
#pragma unroll
            for (int ai = 0; ai < 2; ++ai)
#pragma unroll
                for (int m = 0; m < 4; ++m) { const int row = row0 + ai * HALF + m * 16;
#pragma unroll
                    for (int bj = 0; bj < 2; ++bj) { f32x4 v0 = acc[ai][bj][m][0], v1 = acc[ai][bj][m][1];
#pragma unroll
                        for (int j = 0; j < 4; ++j) { v0[j] = sigm(v0[j]); v1[j] = sigm(v1[j]); }
                        *(u32x4*)(base + (size_t)row * 1024 + cc0 + bj * HALF) = pack8(v0, v1); } }
        }
    }
};

struct EpiMerge {
    static constexpr bool PERM = true, AFTER_DRAIN = false;
    const bf16_t* GA; const bf16_t* GG; bf16_t* O;
    __device__ __forceinline__ void operator()(const f32x4 (&acc)[2][2][4][2], const Unit& u, int wr, int wc, int fr, int fq) const {
        const int row0 = u.pm * BM + wr * 64 + fr, col0 = u.pn * BM + wc * 32 + 8 * fq;
        const bf16_t* G = u.w == 0 ? GA : GG;
#pragma unroll
        for (int ai = 0; ai < 2; ++ai)
#pragma unroll
            for (int m = 0; m < 4; ++m) { const size_t ro = (size_t)(row0 + ai * HALF + m * 16) * 1024 + col0;
#pragma unroll
                for (int bj = 0; bj < 2; ++bj) { const size_t off = ro + bj * HALF;
                    const u32x4 g = *(const u32x4*)(G + off);
                    f32x4 v0 = acc[ai][bj][m][0], v1 = acc[ai][bj][m][1];
                    v0[0] *= bf_lo(g.x); v0[1] *= bf_hi(g.x); v0[2] *= bf_lo(g.y); v0[3] *= bf_hi(g.y);
                    v1[0] *= bf_lo(g.z); v1[1] *= bf_hi(g.z); v1[2] *= bf_lo(g.w); v1[3] *= bf_hi(g.w);
                    if (u.w != 0) { const u32x4 t = *(const u32x4*)(O + off);
                        v0[0] += bf_lo(t.x); v0[1] += bf_hi(t.x); v0[2] += bf_lo(t.y); v0[3] += bf_hi(t.y); v1[0] += bf_lo(t.z); v1[1] += bf_hi(t.z); v1[2] += bf_lo(t.w); v1[3] += bf_hi(t.w); }
                    *(u32x4*)(O + off) = pack8(v0, v1); } }
    }
};

struct EpiF32 {
    static constexpr bool PERM = true, AFTER_DRAIN = false;
    float* O; int ldc;
    __device__ __forceinline__ void operator()(const f32x4 (&acc)[2][2][4][2], const Unit& u, int wr, int wc, int fr, int fq) const {
        const int row0 = u.pm * BM + wr * 64 + fr, col0 = u.pn * BM + wc * 32 + 8 * fq;
#pragma unroll
        for (int ai = 0; ai < 2; ++ai)
#pragma unroll
            for (int m = 0; m < 4; ++m) { float* rowp = O + (size_t)(row0 + ai * HALF + m * 16) * ldc + col0;
#pragma unroll
                for (int bj = 0; bj < 2; ++bj) { *(f32x4*)(rowp + bj * HALF) = acc[ai][bj][m][0]; *(f32x4*)(rowp + bj * HALF + 4) = acc[ai][bj][m][1]; } }
    }
};
}
#define XB_TMO      128
#define XB_XCNT(j)  (256  + 64 * (j))
#define XB_XSUB(j)  (1280 + 64 * (j))
#define XB_XGEN(j)  (2304 + 64 * (j))
#define XB_TOP      3328
#define XB_TOPGEN   3392
#define XCD_BAR_WORDS 3456
#define XB_SPIN_CAP (1u << 18)

__device__ __forceinline__ unsigned xb_ld(unsigned* p)              { return __hip_atomic_load(p, __ATOMIC_RELAXED, __HIP_MEMORY_SCOPE_AGENT); }
__device__ __forceinline__ unsigned xb_add(unsigned* p, unsigned v) { return __hip_atomic_fetch_add(p, v, __ATOMIC_RELAXED, __HIP_MEMORY_SCOPE_AGENT); }
__device__ __forceinline__ unsigned xb_xcc_id() { return (unsigned)__builtin_amdgcn_s_getreg((3 << 11) | 20) & 0xFu; }
#define XB_SPIN(cond, bar) do { unsigned _sp = 0; while (cond) { __builtin_amdgcn_s_sleep(1); \
    if ((++_sp & 255u) == 0u) { if (xb_ld(&(bar)[XB_TMO])) break; if (_sp > XB_SPIN_CAP) { atomicAdd(&(bar)[XB_TMO], 1u); break; } } } } while (0)

struct XcdBarrier {
    unsigned* bar; unsigned x;
    volatile LAS unsigned* st;
};

__device__ __forceinline__ XcdBarrier xcd_barrier_post(unsigned* bar, volatile LAS unsigned* st) {
    XcdBarrier b; b.bar = bar; b.x = xb_xcc_id(); b.st = st;
    if (threadIdx.x == 0) (void)xb_add(&bar[XB_XCNT(b.x)], 1u);
    return b;
}
__device__ __forceinline__ void xcd_barrier_complete(unsigned* bar, unsigned x, unsigned& nloc, unsigned& nx) {
    const unsigned G = gridDim.x * gridDim.y * gridDim.z;
    unsigned sum, cnt, mine, sp = 0u;
    for (;;) {
        sum = 0u; cnt = 0u; mine = 0u;
#pragma unroll
        for (unsigned j = 0; j < 16; ++j) { const unsigned c = xb_ld(&bar[XB_XCNT(j)]); sum += c; cnt += (c > 0u) ? 1u : 0u; mine = (j == x) ? c : mine; }
        if (sum == G) break;
        __builtin_amdgcn_s_sleep(1);
        if ((++sp & 255u) == 0u) { if (xb_ld(&bar[XB_TMO])) break; if (sp > XB_SPIN_CAP) { atomicAdd(&bar[XB_TMO], 1u); break; } }
    }
    nloc = mine > 0u ? mine : 1u; nx = cnt > 0u ? cnt : 1u;
}

__device__ __forceinline__ void xcd_barrier(const XcdBarrier& b) {
    asm volatile("s_waitcnt vmcnt(0)" ::: "memory");
    __syncthreads();
    if (threadIdx.x == 0) {
        unsigned* bar = b.bar;
        __builtin_amdgcn_s_waitcnt(0);
        unsigned nloc = b.st[0], nx = b.st[1];
        if (nloc == 0u) { xcd_barrier_complete(bar, b.x, nloc, nx); b.st[0] = nloc; b.st[1] = nx; }
        const unsigned old = xb_add(&bar[XB_XSUB(b.x)], 1u);
        const unsigned gen = old / nloc;
        if (old + 1u == (gen + 1u) * nloc) {
            __builtin_amdgcn_fence(__ATOMIC_RELEASE, "agent");
            asm volatile("s_waitcnt vmcnt(0)" ::: "memory");
            const unsigned og = xb_add(&bar[XB_TOP], 1u);
            const unsigned tg = og / nx;
            if (og + 1u == (tg + 1u) * nx) xb_add(&bar[XB_TOPGEN], 1u);
            else XB_SPIN(xb_ld(&bar[XB_TOPGEN]) == tg, bar);
            __builtin_amdgcn_fence(__ATOMIC_ACQUIRE, "agent");
            xb_add(&bar[XB_XGEN(b.x)], 1u);
            asm volatile("s_waitcnt vmcnt(0)" ::: "memory");
        } else {
            XB_SPIN(xb_ld(&bar[XB_XGEN(b.x)]) == gen, bar);
            __builtin_amdgcn_fence(__ATOMIC_ACQUIRE, "agent");
            asm volatile("s_waitcnt vmcnt(0)" ::: "memory");
        }
    }
    __syncthreads();
}

struct Frame {
    LAS unsigned char* lds; int tid, lane, wave, vcu, G;
};

__device__ __forceinline__ void p0_transpose_item(const float* W, int K, int N, bf16* WT, LAS float* scr, int item, int lane) {
    const int nblk = N / 32, kb = item / nblk, nb = item % nblk, k0 = 64 * kb, n0 = 32 * nb;
#pragma unroll 8
    for (int i = 0; i < 32; ++i) { const int kk = 2 * i + (lane >> 5); scr[kk * 33 + (lane & 31)] = W[(size_t)(k0 + kk) * N + n0 + (lane & 31)]; }
    LDS_WAIT(); asm volatile("" ::: "memory");
    const int c = lane & 7;
#pragma unroll
    for (int j = 0; j < 4; ++j) { const int n = (lane >> 3) + 8 * j; const LAS float* s = scr + (8 * c) * 33 + n;
        v4u o; o.x = pk2(s[0 * 33], s[1 * 33]); o.y = pk2(s[2 * 33], s[3 * 33]); o.z = pk2(s[4 * 33], s[5 * 33]); o.w = pk2(s[6 * 33], s[7 * 33]);
        *(GAS v4u*)(WT + (size_t)(n0 + n) * K + k0 + 8 * c) = o; }
    LDS_WAIT(); asm volatile("" ::: "memory");
}
__device__ __forceinline__ void cvt_plain(const Frame& F, const float* src, bf16* dst, long n8) {
    const long gt = (long)(F.vcu * NWAVES + F.wave) * 64 + F.lane, NT = (long)F.G * NWAVES * 64;
    for (long i = gt; i < n8; i += NT) { const f32x4 a = *(const GAS f32x4*)(src + i * 8), b = *(const GAS f32x4*)(src + i * 8 + 4);
        v4u o; o.x = pk2(a[0], a[1]); o.y = pk2(a[2], a[3]); o.z = pk2(b[0], b[1]); o.w = pk2(b[2], b[3]); *(GAS v4u*)(dst + i * 8) = o; }
}
__device__ __forceinline__ void sincos_d(double r, float& s, float& c) {
    const double z = r * r;
    double ps = 1.9572941063391263e-20; ps = ps * z + -8.22063524662433e-18; ps = ps * z + 2.8114572543455206e-15; ps = ps * z + -7.647163731819816e-13; ps = ps * z + 1.6059043836821613e-10;
    ps = ps * z + -2.505210838544172e-08; ps = ps * z + 2.7557319223985893e-06; ps = ps * z + -0.0001984126984126984; ps = ps * z + 0.008333333333333333; ps = ps * z + -0.16666666666666666; ps = ps * z + 1.0;
    double pc = -8.896791392450574e-22; pc = pc * z + 4.110317623312165e-19; pc = pc * z + -1.5619206968586225e-16; pc = pc * z + 4.779477332387385e-14; pc = pc * z + -1.1470745597729725e-11; pc = pc * z + 2.08767569878681e-09;
    pc = pc * z + -2.755731922398589e-07; pc = pc * z + 2.48015873015873e-05; pc = pc * z + -0.001388888888888889; pc = pc * z + 0.041666666666666664; pc = pc * z + -0.5; pc = pc * z + 1.0;
    s = (float)(r * ps); c = (float)pc;
}
struct P0Args { const float *c, *w_ada, *b_ada, *w_in, *w_a, *w_g, *w_out, *w_pq, *keys, *wsp; const int* pos; unsigned char* ws; };
__device__ __forceinline__ void p0_prologue(const Frame& F, const P0Args& a) {
    LAS float* scr = (LAS float*)(F.lds + F.wave * 16384);
    const int gw = F.vcu * NWAVES + F.wave, NGW = F.G * NWAVES;
    constexpr int I_IN = (D / 64) * (NIN / 32), I_SQ = (D / 64) * (D / 32), I_PQ = (D / 64) * (NPQ / 32), NITEMS = I_IN + 3 * I_SQ + I_PQ;
    for (int it = gw; it < NITEMS; it += NGW) {
        int r = it;
        if (r < I_IN) { p0_transpose_item(a.w_in, D, NIN, (bf16*)(a.ws + WS_WIN), scr, r, F.lane); continue; } r -= I_IN;
        if (r < I_SQ) { p0_transpose_item(a.w_a, D, D, (bf16*)(a.ws + WS_WA), scr, r, F.lane); continue; } r -= I_SQ;
        if (r < I_SQ) { p0_transpose_item(a.w_g, D, D, (bf16*)(a.ws + WS_WG), scr, r, F.lane); continue; } r -= I_SQ;
        if (r < I_SQ) { p0_transpose_item(a.w_out, D, D, (bf16*)(a.ws + WS_WOUT), scr, r, F.lane); continue; } r -= I_SQ;
        p0_transpose_item(a.w_pq, D, NPQ, (bf16*)(a.ws + WS_WPQ), scr, r, F.lane);
    }
    cvt_plain(F, a.keys, (bf16*)(a.ws + WS_KEYS), 8 * 2 * 128 * 128 / 8);
    cvt_plain(F, a.wsp, (bf16*)(a.ws + WS_WSP), 8 * 128 * 128 / 8);
    { const long gt = (long)gw * 64 + F.lane, NT = (long)NGW * 64; float* rope = (float*)(a.ws + WS_ROPE);
      for (long m = gt; m < M; m += NT) { const double p = (double)a.pos[m];
          const double invf[8] = {1.0, 0.19392274474868576, 0.03760603093086393, 0.007292664737217109, 0.001414213562373095, 0.0002742481756762073, 5.318295896944988e-05, 1.031338537721246e-05};
          float cs[8], sn[8];
#pragma unroll
          for (int i = 0; i < 8; ++i) { const double ang = p * invf[i]; const double k = __builtin_rint(ang * 0.15915494309189535); const double r = ang - k * 6.283185307179586; sincos_d(r, sn[i], cs[i]); }
          f32x4* o = (f32x4*)(rope + m * 16);
          o[0] = (f32x4){cs[0], cs[1], cs[2], cs[3]}; o[1] = (f32x4){cs[4], cs[5], cs[6], cs[7]}; o[2] = (f32x4){sn[0], sn[1], sn[2], sn[3]}; o[3] = (f32x4){sn[4], sn[5], sn[6], sn[7]}; } }
    { float* mod = (float*)(a.ws + WS_MOD); LAS float* red = (LAS float*)F.lds;
      __syncthreads();
      for (int it = F.vcu; it < NMOD / 32; it += F.G) { const int col = it * 32 + (F.lane & 31), kh = F.lane >> 5, k0 = F.wave * 128 + kh * 64;
          float acc[8];
#pragma unroll
          for (int b = 0; b < 8; ++b) acc[b] = 0.f;
#pragma unroll 8
          for (int kk = 0; kk < 64; ++kk) { const int k = k0 + kk; const float w = a.w_ada[(size_t)k * NMOD + col];
#pragma unroll
              for (int b = 0; b < 8; ++b) { const float cv = a.c[b * D + k]; const float sl = cv * __builtin_amdgcn_rcpf(1.f + __expf(-cv)); acc[b] += sl * w; } }
#pragma unroll
          for (int b = 0; b < 8; ++b) red[((F.wave * 2 + kh) * 8 + b) * 32 + (F.lane & 31)] = acc[b];
          __syncthreads();
          if (F.tid < 256) { const int b = F.tid >> 5, c = F.tid & 31; float s = a.b_ada[it * 32 + c];
#pragma unroll
              for (int p = 0; p < 16; ++p) s += red[(p * 8 + b) * 32 + c];
              mod[b * NMOD + it * 32 + c] = s; }
          __syncthreads(); } }
}

__device__ __forceinline__ void p1_xn(const Frame& F, const float* x, const float* g_pre, const float* mod, bf16* XN) {
    const int gw = F.vcu * NWAVES + F.wave, NGW = F.G * NWAVES;
    f32x4 nx[4];
    { const GAS f32x4* xr = (const GAS f32x4*)(x + (size_t)gw * D) + F.lane;
#pragma unroll
      for (int j = 0; j < 4; ++j) nx[j] = xr[64 * j]; }
    for (int m = gw; m < M; m += NGW) { const int b = m >> 12;
        f32x4 v[4]; float ss = 0.f;
#pragma unroll
        for (int j = 0; j < 4; ++j) { v[j] = nx[j]; ss += (v[j].x * v[j].x + v[j].y * v[j].y) + (v[j].z * v[j].z + v[j].w * v[j].w); }
        { const int mn = (m + NGW < M) ? m + NGW : m; const GAS f32x4* xr = (const GAS f32x4*)(x + (size_t)mn * D) + F.lane;
#pragma unroll
          for (int j = 0; j < 4; ++j) nx[j] = xr[64 * j]; }
        const float rs = 1.f / sqrtf(wave_sum(ss) * (1.f / D) + EPS);
        GAS v2u* o8 = (GAS v2u*)(XN + (size_t)m * D) + F.lane;
#pragma unroll
        for (int j = 0; j < 4; ++j) { const int col = 256 * j + 4 * F.lane;
            const f32x4 g = *(const f32x4*)(g_pre + col), sh = *(const f32x4*)(mod + b * NMOD + col), sc = *(const f32x4*)(mod + b * NMOD + D + col);
            const f32x4 h = v[j] * rs * g * (sc + 1.f) + sh; v2u w; w.x = pk2(h.x, h.y); w.y = pk2(h.z, h.w); o8[64 * j] = w; }
    }
}

__device__ __forceinline__ s16x4 tr_read_dyn(unsigned addr) { s16x4 r; asm volatile("ds_read_b64_tr_b16 %0, %1" : "=&v"(r) : "v"(addr) : "memory"); return r; }
struct GmlpArgs { const bf16* ZV; bf16* U; bf16* SGo; const float* stats; const float* ln_g; const float* ln_b; const bf16* wsp; const float* b_s; };
__device__ __forceinline__ void p3_gmlp(const Frame& F, const GmlpArgs& a) {
    LAS unsigned char* T = F.lds + F.wave * 16384;
    LAS float* MR = (LAS float*)(F.lds + LDSCTL_OFF + 1024);
    const int g = F.wave, lane = F.lane, L31 = lane & 31, hh = lane >> 5;
    const unsigned Tb = (unsigned)(uintptr_t)T;
    const int qq = (lane & 15) >> 2, p4 = lane & 3, g16 = (lane >> 4) & 1, sw = (qq >> 1) & 1;
    const unsigned rb0 = Tb + (8 * hh + qq) * 128 + 64 * (0 ^ sw) + (16 * g16 + 4 * p4) * 2;
    const unsigned rb1 = Tb + (8 * hh + qq) * 128 + 64 * (1 ^ sw) + (16 * g16 + 4 * p4) * 2;
    for (int ck = F.vcu; ck < M / 128; ck += F.G) {
        const size_t rowc = (size_t)ck * 128;
        __syncthreads();
        if (F.tid < 128) { const f32x4* sp = (const f32x4*)(a.stats + (rowc + F.tid) * 32); float s = 0.f, q = 0.f;
#pragma unroll
            for (int j = 0; j < 8; ++j) { const f32x4 t = sp[j]; s += t.x + t.z; q += t.y + t.w; }
            const float mu = s * (1.f / 1024.f), var = q * (1.f / 1024.f) - mu * mu;
            MR[2 * F.tid] = mu; MR[2 * F.tid + 1] = 1.f / sqrtf(fmaxf(var, 0.f) + EPS); }
        __syncthreads();
#pragma unroll 1
        for (int half = 0; half < 2; ++half) {
            const int cbase = g * 128 + half * 64;
            { const int c0 = 8 * (lane & 7);
              const f32x4 ga = *(const f32x4*)(a.ln_g + cbase + c0), gb = *(const f32x4*)(a.ln_g + cbase + c0 + 4), ba = *(const f32x4*)(a.ln_b + cbase + c0), bb = *(const f32x4*)(a.ln_b + cbase + c0 + 4);
#pragma unroll 4
              for (int i = 0; i < 16; ++i) { const int q = (lane >> 3) + 8 * i;
                  const v4u w = *(const GAS v4u*)(a.ZV + (rowc + q) * 1024 + cbase + c0);
                  const float mu = MR[2 * q], rs = MR[2 * q + 1];
                  f32x4 x0 = {bflo(w.x), bfhi(w.x), bflo(w.y), bfhi(w.y)}, x1 = {bflo(w.z), bfhi(w.z), bflo(w.w), bfhi(w.w)};
                  x0 = (x0 - mu) * rs * ga + ba; x1 = (x1 - mu) * rs * gb + bb;
                  v4u o; o.x = pk2(x0[0], x0[1]); o.y = pk2(x0[2], x0[3]); o.z = pk2(x1[0], x1[1]); o.w = pk2(x1[2], x1[3]);
                  *(LAS v4u*)(T + q * 128 + ((c0 * 2) ^ (((q >> 1) & 1) << 6))) = o; } }
            LDS_WAIT(); asm volatile("" ::: "memory");
#pragma unroll 1
            for (int pb = 0; pb < 4; ++pb) {
                bf16x8 af[8];
#pragma unroll
                for (int ks = 0; ks < 8; ++ks) af[ks] = *(const GAS bf16x8*)(a.wsp + ((size_t)(g * 128 + pb * 32 + L31)) * 128 + 16 * ks + 8 * hh);
                f32x16 acc0 = {}, acc1 = {};
#pragma unroll
                for (int ks = 0; ks < 8; ++ks) {
                    const s16x4 l0 = tr_read_dyn(rb0 + ks * 2048), h0 = tr_read_dyn(rb0 + ks * 2048 + 512), l1 = tr_read_dyn(rb1 + ks * 2048), h1 = tr_read_dyn(rb1 + ks * 2048 + 512);
                    asm volatile("s_waitcnt lgkmcnt(0)" ::: "memory"); SBAR();
                    const bf16x8 b0 = {l0[0], l0[1], l0[2], l0[3], h0[0], h0[1], h0[2], h0[3]}, b1 = {l1[0], l1[1], l1[2], l1[3], h1[0], h1[1], h1[2], h1[3]};
                    acc0 = __builtin_amdgcn_mfma_f32_32x32x16_bf16(af[ks], b0, acc0, 0, 0, 0);
                    acc1 = __builtin_amdgcn_mfma_f32_32x32x16_bf16(af[ks], b1, acc1, 0, 0, 0);
                }
#pragma unroll
                for (int r = 0; r < 16; ++r) { const int p = pb * 32 + crow(r, hh); const float bs = a.b_s[g * 128 + p];
                    const bf16* up = a.U + (rowc + p) * 1024 + cbase + L31; bf16* op = a.SGo + (rowc + p) * 1024 + cbase + L31;
                    const float u0 = bflo((unsigned)up[0]), u1 = bflo((unsigned)up[32]);
                    op[0] = (bf16)f2bf(u0 * (acc0[r] + bs)); op[32] = (bf16)f2bf(u1 * (acc1[r] + bs)); }
            }
            LDS_WAIT(); asm volatile("" ::: "memory");
        }
    }
    __syncthreads();
}

namespace att {
#ifndef ATT_PV_PIPE
#define ATT_PV_PIPE 0
#endif
constexpr int NW = 8, QBLK = 32, KVBLK = 64, LD = 1024;
constexpr float SCALE = 0.125f, THR = 8.f;
constexpr int SHM_V = 16384, SHM_K = 8192, OFF_K = 0, OFF_V = 2 * SHM_K, OFF_WS = OFF_V + 3 * SHM_V, OFF_STG = OFF_WS + NW * 64 * 4, ATT_LDS = OFF_STG + NW * 4096;
static_assert(ATT_LDS <= 131072, "attention LDS");
#define KSWZ64(row, colB) ((row) * 128 + ((colB) ^ ((((row) >> 1) & 7) << 4)))
__device__ __forceinline__ void glds16(const void* gsrc, unsigned lds_dst) { unsigned keep;
  asm volatile("s_mov_b32 %0, m0\n\ts_mov_b32 m0, %2\n\ts_nop 0\n\tglobal_load_lds_dwordx4 %1, off\n\ts_mov_b32 m0, %0" : "=&s"(keep) : "v"(gsrc), "s"(lds_dst) : "memory"); }
#define WAIT_BAR(N) asm volatile("s_waitcnt vmcnt(" #N ") lgkmcnt(0)\n\ts_barrier" ::: "memory")
__device__ __forceinline__ unsigned cvtpk(float lo, float hi) { return pk2(lo, hi); }
__device__ __forceinline__ void partialSM(f32x16& p0, f32x16& p1, float& m_reg, float& mn, float& alpha) {
  constexpr float C = SCALE * 1.4426950408889634f;
  float pmax = p0[0];
#pragma unroll
  for (int r = 1; r < 16; ++r) pmax = fmaxf(pmax, p0[r]);
#pragma unroll
  for (int r = 0; r < 16; ++r) pmax = fmaxf(pmax, p1[r]);
  { auto rr = __builtin_amdgcn_permlane32_swap(__float_as_uint(pmax), __float_as_uint(pmax), false, false);
    pmax = fmaxf(__uint_as_float(rr[0]), __uint_as_float(rr[1])); }
  if (__builtin_expect(__all(pmax - m_reg <= THR / SCALE), 1)) { mn = m_reg; alpha = 1.f; }
  else { mn = fmaxf(m_reg, pmax); alpha = __builtin_amdgcn_exp2f((m_reg - mn) * C); m_reg = mn; }
  float mnC = -mn * C;
#pragma unroll
  for (int r = 0; r < 16; ++r) p0[r] = fmaf(p0[r], C, mnC);
#pragma unroll
  for (int r = 0; r < 16; ++r) p1[r] = fmaf(p1[r], C, mnC);
#pragma unroll
  for (int r = 0; r < 16; ++r) p0[r] = __builtin_amdgcn_exp2f(p0[r]);
}
__device__ __forceinline__ void finishSM(f32x16& p0, f32x16& p1, float alpha, float& l_reg, bf16x8& pa0, bf16x8& pa1, bf16x8& pa2, bf16x8& pa3) {
#pragma unroll
  for (int r = 0; r < 16; ++r) p1[r] = __builtin_amdgcn_exp2f(p1[r]);
  float ps = 0;
#pragma unroll
  for (int r = 0; r < 16; ++r) ps += p0[r];
#pragma unroll
  for (int r = 0; r < 16; ++r) ps += p1[r];
  { auto rr = __builtin_amdgcn_permlane32_swap(__float_as_uint(ps), __float_as_uint(ps), false, false);
    ps = __uint_as_float(rr[0]) + __uint_as_float(rr[1]); }
  l_reg = l_reg * alpha + ps;
#define PK4(P, BASE, OUT) do { unsigned a0 = cvtpk(P[BASE + 0], P[BASE + 1]), a1 = cvtpk(P[BASE + 2], P[BASE + 3]);   \
    unsigned b0 = cvtpk(P[BASE + 4], P[BASE + 5]), b1 = cvtpk(P[BASE + 6], P[BASE + 7]);                              \
    auto r0 = __builtin_amdgcn_permlane32_swap(a0, b0, false, false); auto r1 = __builtin_amdgcn_permlane32_swap(a1, b1, false, false); \
    v4u w = {r0[0], r1[0], r0[1], r1[1]}; OUT = *reinterpret_cast<bf16x8*>(&w); } while (0)
  PK4(p0, 0, pa0); PK4(p0, 8, pa1); PK4(p1, 0, pa2); PK4(p1, 8, pa3);
#undef PK4
}
__device__ __forceinline__ void qkt(f32x16& p0, f32x16& p1, const char* Ks, const bf16x8* qr, int r32, int hi) {
  p0 = f32x16{}; p1 = f32x16{};
#pragma unroll
  for (int d0 = 0; d0 < 4; ++d0) { const int cb = (d0 * 16 + hi * 8) * 2;
    bf16x8 b0 = *reinterpret_cast<const bf16x8*>(Ks + KSWZ64(r32, cb));
    bf16x8 b1 = *reinterpret_cast<const bf16x8*>(Ks + KSWZ64(32 + r32, cb));
    p0 = __builtin_amdgcn_mfma_f32_32x32x16_bf16(b0, qr[d0], p0, 0, 0, 0);
    p1 = __builtin_amdgcn_mfma_f32_32x32x16_bf16(b1, qr[d0], p1, 0, 0, 0); }
}
__device__ __forceinline__ int v_st(int k, int c) { const int kk = (k & ~0xC) | ((k & 4) << 1) | ((k & 8) >> 1); return ((kk >> 3) * 4 + (c >> 5)) * 512 + ((kk & 7) * 32 + (c & 31)) * 2; }
__device__ __forceinline__ int v_rd_base(int lane) { return ((lane & 3) << 3) | (((lane >> 2) & 3) << 6) | (((lane >> 4) & 1) << 5) | (((lane >> 5) & 1) << 8); }
constexpr int v_rd_off(int d0, int ks, int half) { return d0 * 512 + ks * 4096 + half * 2048; }
template <int OFF> __device__ __forceinline__ s16x4 tr_read(int vb) {
  s16x4 r; asm volatile("ds_read_b64_tr_b16 %0, %1 offset:%2" : "=&v"(r) : "v"(vb), "i"(OFF) : "memory"); return r;
}
struct VFrag { s16x4 l0, h0, l1, h1, l2, h2, l3, h3; };
template <int D0> __device__ __forceinline__ void pv_issue(VFrag& f, int vb) {
  f.l0 = tr_read<v_rd_off(D0, 0, 0)>(vb); f.h0 = tr_read<v_rd_off(D0, 0, 1)>(vb); f.l1 = tr_read<v_rd_off(D0, 1, 0)>(vb); f.h1 = tr_read<v_rd_off(D0, 1, 1)>(vb);
  f.l2 = tr_read<v_rd_off(D0, 2, 0)>(vb); f.h2 = tr_read<v_rd_off(D0, 2, 1)>(vb); f.l3 = tr_read<v_rd_off(D0, 3, 0)>(vb); f.h3 = tr_read<v_rd_off(D0, 3, 1)>(vb);
}
__device__ __forceinline__ void pv_mma(f32x16& od, const VFrag& f, bf16x8 pa0, bf16x8 pa1, bf16x8 pa2, bf16x8 pa3) {
#define PK(L, H) (bf16x8){L[0], L[1], L[2], L[3], H[0], H[1], H[2], H[3]}
  od = __builtin_amdgcn_mfma_f32_32x32x16_bf16(pa0, PK(f.l0, f.h0), od, 0, 0, 0);
  od = __builtin_amdgcn_mfma_f32_32x32x16_bf16(pa1, PK(f.l1, f.h1), od, 0, 0, 0);
  od = __builtin_amdgcn_mfma_f32_32x32x16_bf16(pa2, PK(f.l2, f.h2), od, 0, 0, 0);
  od = __builtin_amdgcn_mfma_f32_32x32x16_bf16(pa3, PK(f.l3, f.h3), od, 0, 0, 0);
#undef PK
}
__device__ __forceinline__ void pv_d0(f32x16* o, int vb, bf16x8 pa0, bf16x8 pa1, bf16x8 pa2, bf16x8 pa3) {
#if ATT_PV_PIPE
  VFrag fa, fb;
  pv_issue<0>(fa, vb);
  pv_issue<1>(fb, vb); asm volatile("s_waitcnt lgkmcnt(8)" ::: "memory"); SBAR(); pv_mma(o[0], fa, pa0, pa1, pa2, pa3);
  pv_issue<2>(fa, vb); asm volatile("s_waitcnt lgkmcnt(8)" ::: "memory"); SBAR(); pv_mma(o[1], fb, pa0, pa1, pa2, pa3);
  pv_issue<3>(fb, vb); asm volatile("s_waitcnt lgkmcnt(8)" ::: "memory"); SBAR(); pv_mma(o[2], fa, pa0, pa1, pa2, pa3);
  asm volatile("s_waitcnt lgkmcnt(0)" ::: "memory"); SBAR(); pv_mma(o[3], fb, pa0, pa1, pa2, pa3);
#else
  VFrag f;
  pv_issue<0>(f, vb); asm volatile("s_waitcnt lgkmcnt(0)" ::: "memory"); SBAR(); pv_mma(o[0], f, pa0, pa1, pa2, pa3);
  pv_issue<1>(f, vb); asm volatile("s_waitcnt lgkmcnt(0)" ::: "memory"); SBAR(); pv_mma(o[1], f, pa0, pa1, pa2, pa3);
  pv_issue<2>(f, vb); asm volatile("s_waitcnt lgkmcnt(0)" ::: "memory"); SBAR(); pv_mma(o[2], f, pa0, pa1, pa2, pa3);
  pv_issue<3>(f, vb); asm volatile("s_waitcnt lgkmcnt(0)" ::: "memory"); SBAR(); pv_mma(o[3], f, pa0, pa1, pa2, pa3);
#endif
}

template <int t>
__device__ __forceinline__ void attn_pass(const bf16* Qh, const bf16* __restrict__ Kh, const bf16* __restrict__ Vh, bf16* ONh, int q0, float lam, const float* gsub, float* stash, char* lds) {
  int tid = threadIdx.x; asm volatile("" : "+v"(tid));
  const int wid = tid >> 6, lane = tid & 63, r32 = lane & 31, hi = lane >> 5;
  char* V_lds = lds + OFF_V; char* K_lds = lds + OFF_K;
  float* ws = (float*)(lds + OFF_WS) + wid * 64; float* li_l = ws; float* al_l = ws + 32;
  bf16* stg = (bf16*)(lds + OFF_STG + wid * 4096);
  const int ku = tid, krow = ku >> 3, kchunk = (ku & 7) ^ ((krow >> 1) & 7);
  const int vu0 = tid, vu1 = 512 + tid;
  const int vkk0 = ((vu0 >> 5) >> 2) * 8 + ((vu0 & 31) >> 2), vkey0 = (vkk0 & ~0xC) | ((vkk0 & 8) >> 1) | ((vkk0 & 4) << 1), vcol0 = ((vu0 >> 5) & 3) * 32 + (vu0 & 3) * 8;
  const int vkk1 = ((vu1 >> 5) >> 2) * 8 + ((vu1 & 31) >> 2), vkey1 = (vkk1 & ~0xC) | ((vkk1 & 8) >> 1) | ((vkk1 & 4) << 1), vcol1 = ((vu1 >> 5) & 3) * 32 + (vu1 & 3) * 8;
  const unsigned lds0 = (unsigned)(uintptr_t)lds, kdst = lds0 + OFF_K + wid * 1024, vdst = lds0 + OFF_V + wid * 1024;
  const int vb0 = (int)(uintptr_t)V_lds + v_rd_base(lane);
  constexpr int NT = SEQ / KVBLK;
  {
    const bf16* Kt = Kh + t * 64;
    float m_reg = -1e30f, l_reg = 0; f32x16 o[4] = {}; bf16x8 qr[4];
    const bf16* Qw = Qh + (long)(q0 + wid * QBLK + r32) * LD + t * 64 + hi * 8;
#pragma unroll
    for (int d0 = 0; d0 < 4; ++d0) qr[d0] = *reinterpret_cast<const bf16x8*>(Qw + d0 * 16);
    const bf16* ksrc = Kt + (long)krow * LD + kchunk * 8; const bf16* vsrc0 = Vh + (long)vkey0 * LD + vcol0; const bf16* vsrc1 = Vh + (long)vkey1 * LD + vcol1;
#define DMA_TILE(tt, kslot, vslotoff) do { glds16(ksrc + (long)(tt) * KVBLK * LD, (unsigned)__builtin_amdgcn_readfirstlane(kdst + (kslot) * SHM_K)); \
    glds16(vsrc0 + (long)(tt) * KVBLK * LD, (unsigned)__builtin_amdgcn_readfirstlane(vdst + (vslotoff))); glds16(vsrc1 + (long)(tt) * KVBLK * LD, (unsigned)__builtin_amdgcn_readfirstlane(vdst + (vslotoff) + 8192)); } while (0)
#define RESC(a) do { if (__any((a) < 1.f)) { if (hi == 0) al_l[r32] = (a); asm volatile("s_waitcnt lgkmcnt(0)" ::: "memory"); \
    _Pragma("unroll") for (int d = 0; d < 4; ++d) _Pragma("unroll") for (int r = 0; r < 16; ++r) o[d][r] *= al_l[crow(r, hi)]; } } while (0)
    f32x16 pA0, pA1, pB0, pB1; float mnA, mnB, alA, alB; bf16x8 pa0, pa1, pa2, pa3;
    int vprev = 2 * SHM_V, vcur = 0, vnext = SHM_V;
#define ROTV() do { const int t_ = vprev; vprev = vcur; vcur = vnext; vnext = t_; } while (0)
    WAIT_BAR(0);
    DMA_TILE(0, 0, 0); DMA_TILE(1, 1, SHM_V);
    WAIT_BAR(3);
    qkt(pA0, pA1, K_lds, qr, r32, hi); partialSM(pA0, pA1, m_reg, mnA, alA);
    vprev = 0; vcur = SHM_V; vnext = 2 * SHM_V;
#define STEP(X0, X1, mnX, alX, Y0, Y1, alY, j, HASW, HASL) do { \
      WAIT_BAR(0); \
      if (HASW) DMA_TILE((j) + 1, ((j) + 1) & 1, vnext); \
      SBAR(); qkt(X0, X1, K_lds + ((j) & 1) * SHM_K, qr, r32, hi); \
      finishSM(Y0, Y1, alY, l_reg, pa0, pa1, pa2, pa3); SBAR(); \
      pv_d0(o, vb0 + vprev, pa0, pa1, pa2, pa3); partialSM(X0, X1, m_reg, mnX, alX); \
      RESC(alX); ROTV(); } while (0)
#pragma unroll 1
    for (int j = 1; j + 3 < NT; j += 2) {
      STEP(pB0, pB1, mnB, alB, pA0, pA1, alA, j, true, true);
      STEP(pA0, pA1, mnA, alA, pB0, pB1, alB, j + 1, true, true);
    }
    STEP(pB0, pB1, mnB, alB, pA0, pA1, alA, NT - 3, true, true);
    STEP(pA0, pA1, mnA, alA, pB0, pB1, alB, NT - 2, true, false);
    STEP(pB0, pB1, mnB, alB, pA0, pA1, alA, NT - 1, false, false);
    finishSM(pB0, pB1, alB, l_reg, pa0, pa1, pa2, pa3); SBAR();
    pv_d0(o, vb0 + vprev, pa0, pa1, pa2, pa3);
#undef STEP
#undef ROTV
#undef DMA_TILE
#undef RESC
    if (hi == 0) li_l[r32] = l_reg; asm volatile("s_waitcnt lgkmcnt(0)" ::: "memory");
    float rli[16];
#pragma unroll
    for (int r = 0; r < 16; ++r) rli[r] = __builtin_amdgcn_rcpf(li_l[crow(r, hi)]);
    GAS float* sp = (GAS float*)(stash + (size_t)wid * 4096 + lane);
    asm volatile("" : "+v"(sp));
    if (t == 0) {
#pragma unroll
      for (int r = 0; r < 16; ++r)
#pragma unroll
        for (int d0 = 0; d0 < 4; ++d0) sp[(d0 * 16 + r) * 64] = o[d0][r] * rli[r];
    } else {
      float gs[4];
#pragma unroll
      for (int d0 = 0; d0 < 4; ++d0) gs[d0] = gsub[d0 * 32 + r32] * 0.8f;
      bf16* Ow = ONh + (long)(q0 + wid * QBLK) * LD;
#pragma unroll
      for (int half = 0; half < 2; ++half) {
#pragma unroll
        for (int rr = 0; rr < 8; ++rr) { const int r = half * 8 + rr; float oc[4]; float ss = 0.f;
#pragma unroll
          for (int d0 = 0; d0 < 4; ++d0) { oc[d0] = sp[(d0 * 16 + r) * 64] - lam * (o[d0][r] * rli[r]); ss += oc[d0] * oc[d0]; }
          ss += __shfl_xor(ss, 1); ss += __shfl_xor(ss, 2); ss += __shfl_xor(ss, 4); ss += __shfl_xor(ss, 8); ss += __shfl_xor(ss, 16);
          const float rs = 1.f / sqrtf(ss * (1.f / 128.f) + EPS); const int orow = crow(r, hi) - 16 * half;
#pragma unroll
          for (int d0 = 0; d0 < 4; ++d0) stg[orow * 128 + d0 * 32 + r32] = (bf16)f2bf(oc[d0] * rs * gs[d0]); }
        asm volatile("s_waitcnt lgkmcnt(0)" ::: "memory");
#pragma unroll
        for (int i = 0; i < 4; ++i) { const int row = i * 4 + (lane >> 4), ch = lane & 15; const v4u v = *(const v4u*)(stg + row * 128 + ch * 8); *(v4u*)(Ow + (long)(half * 16 + row) * LD + ch * 8) = v; }
        asm volatile("s_waitcnt lgkmcnt(0)" ::: "memory");
      }
    }
  }
}
__device__ __forceinline__ void attn_unit(const bf16* Qh, const bf16* __restrict__ Kh, const bf16* __restrict__ Vh, bf16* ONh, int q0, float lam, const float* gsub, float* stash, char* lds) {
  attn_pass<0>(Qh, Kh, Vh, ONh, q0, lam, gsub, stash, lds);
  asm volatile("s_waitcnt vmcnt(0) lgkmcnt(0)" ::: "memory"); SBAR();
  attn_pass<1>(Qh, Kh, Vh, ONh, q0, lam, gsub, stash, lds);
  asm volatile("s_waitcnt vmcnt(0) lgkmcnt(0)" ::: "memory"); SBAR();
}
}

__device__ __forceinline__ void p6_rows(const Frame& F, const float* x, float* io, float* x1out, const float* g_post, const float* g_pre2, const float* mod, bf16* H2) {
    const int gw = F.vcu * NWAVES + F.wave, NGW = F.G * NWAVES;
    f32x4 nv[4], nx[4];
    { const GAS f32x4* mr = (const GAS f32x4*)(io + (size_t)gw * D) + F.lane; const GAS f32x4* xr = (const GAS f32x4*)(x + (size_t)gw * D) + F.lane;
#pragma unroll
      for (int j = 0; j < 4; ++j) { nv[j] = mr[64 * j]; nx[j] = xr[64 * j]; } }
    for (int m = gw; m < M; m += NGW) { const int b = m >> 12; const float* mb = mod + b * NMOD;
        GAS f32x4* xo = (GAS f32x4*)(x1out + (size_t)m * D) + F.lane;
        f32x4 v[4], xv[4]; float ss = 0.f;
#pragma unroll
        for (int j = 0; j < 4; ++j) { v[j] = nv[j]; xv[j] = nx[j]; ss += (v[j].x * v[j].x + v[j].y * v[j].y) + (v[j].z * v[j].z + v[j].w * v[j].w); }
        { const int mn = (m + NGW < M) ? m + NGW : m; const GAS f32x4* mr = (const GAS f32x4*)(io + (size_t)mn * D) + F.lane; const GAS f32x4* xr = (const GAS f32x4*)(x + (size_t)mn * D) + F.lane;
          if (mn != m) {
#pragma unroll
          for (int j = 0; j < 4; ++j) { nv[j] = mr[64 * j]; nx[j] = xr[64 * j]; } } }
        const float rs = 1.f / sqrtf(wave_sum(ss) * (1.f / D) + EPS); float s2 = 0.f;
#pragma unroll
        for (int j = 0; j < 4; ++j) { const int col = 256 * j + 4 * F.lane;
            const f32x4 g = *(const f32x4*)(g_post + col), gt = *(const f32x4*)(mb + 2 * D + col);
            v[j] = xv[j] + gt * (v[j] * rs * g); xo[64 * j] = v[j];
            s2 += (v[j].x * v[j].x + v[j].y * v[j].y) + (v[j].z * v[j].z + v[j].w * v[j].w); }
        const float rs2 = 1.f / sqrtf(wave_sum(s2) * (1.f / D) + EPS);
        GAS v2u* o8 = (GAS v2u*)(H2 + (size_t)m * D) + F.lane;
#pragma unroll
        for (int j = 0; j < 4; ++j) { const int col = 256 * j + 4 * F.lane;
            const f32x4 g = *(const f32x4*)(g_pre2 + col), sh = *(const f32x4*)(mb + 3 * D + col), sc = *(const f32x4*)(mb + 4 * D + col);
            const f32x4 h = v[j] * rs2 * g * (sc + 1.f) + sh; v2u w; w.x = pk2(h.x, h.y); w.y = pk2(h.z, h.w); o8[64 * j] = w; }
    }
}

__device__ __forceinline__ float vmaxf(float a, float b) { float r; asm("v_max_f32_e32 %0, %1, %2" : "=v"(r) : "v"(a), "v"(b)); return r; }
__device__ __forceinline__ float vminf(float a, float b) { float r; asm("v_min_f32_e32 %0, %1, %2" : "=v"(r) : "v"(a), "v"(b)); return r; }
#define CE_DESC(a, b) do { const float _mx = vmaxf(a, b), _mn = vminf(a, b); a = _mx; b = _mn; } while (0)
__device__ __forceinline__ void sort16_desc(float (&v)[16]) {
#pragma unroll
    for (int k = 2; k <= 16; k <<= 1)
#pragma unroll
        for (int j = k >> 1; j > 0; j >>= 1)
#pragma unroll
            for (int i = 0; i < 16; ++i) { const int l = i ^ j; if (l > i) { if ((i & k) == 0) CE_DESC(v[i], v[l]); else CE_DESC(v[l], v[i]); } }
}
__device__ __forceinline__ void merge16_desc(float (&a)[16], const float (&b)[16]) {
#pragma unroll
    for (int i = 0; i < 16; ++i) a[i] = vmaxf(a[i], b[15 - i]);
#pragma unroll
    for (int j = 8; j > 0; j >>= 1)
#pragma unroll
        for (int i = 0; i < 16; ++i) { const int l = i ^ j; if (l > i) CE_DESC(a[i], a[l]); }
}
#define FILL_ROUND0 bt[0] = CAND(0, 0); bt[1] = CAND(0, 1); bt[2] = CAND(1, 0); bt[3] = CAND(0, 2); bt[4] = CAND(2, 0); bt[5] = CAND(1, 1); bt[6] = CAND(0, 3); bt[7] = CAND(3, 0); bt[8] = CAND(0, 4); bt[9] = CAND(4, 0); bt[10] = CAND(1, 2); bt[11] = CAND(2, 1); bt[12] = CAND(0, 5); bt[13] = CAND(5, 0); bt[14] = CAND(0, 6); bt[15] = CAND(6, 0);
#define FILL_ROUND1 bt[0] = CAND(1, 3); bt[1] = CAND(3, 1); bt[2] = CAND(0, 7); bt[3] = CAND(7, 0); bt[4] = CAND(2, 2); bt[5] = CAND(0, 8); bt[6] = CAND(8, 0); bt[7] = CAND(1, 4); bt[8] = CAND(4, 1); bt[9] = CAND(0, 9); bt[10] = CAND(9, 0); bt[11] = CAND(0, 10); bt[12] = CAND(10, 0); bt[13] = CAND(2, 3); bt[14] = CAND(3, 2); bt[15] = CAND(1, 5);
#define FILL_ROUND2 bt[0] = CAND(5, 1); bt[1] = CAND(0, 11); bt[2] = CAND(11, 0); bt[3] = CAND(0, 12); bt[4] = CAND(12, 0); bt[5] = CAND(1, 6); bt[6] = CAND(6, 1); bt[7] = CAND(0, 13); bt[8] = CAND(13, 0); bt[9] = CAND(2, 4); bt[10] = CAND(4, 2); bt[11] = CAND(0, 14); bt[12] = CAND(14, 0); bt[13] = CAND(3, 3); bt[14] = CAND(1, 7); bt[15] = CAND(7, 1);
#define FILL_ROUND3 bt[0] = CAND(0, 15); bt[1] = CAND(15, 0); bt[2] = NEG_INF; bt[3] = NEG_INF; bt[4] = NEG_INF; bt[5] = NEG_INF; bt[6] = NEG_INF; bt[7] = NEG_INF; bt[8] = NEG_INF; bt[9] = NEG_INF; bt[10] = NEG_INF; bt[11] = NEG_INF; bt[12] = NEG_INF; bt[13] = NEG_INF; bt[14] = NEG_INF; bt[15] = NEG_INF;
struct RouteArgs { const bf16* QP; const bf16* keys; int* IDX; float* GATE; };
__device__ __forceinline__ void p8_route(const Frame& F, const RouteArgs& a) {
    const int lane = F.lane, L31 = lane & 31, hh = lane >> 5, h = F.wave;
    LAS unsigned char* tab = F.lds + F.wave * 2048 + lane * 32;
    for (int tb = F.vcu; tb < M / 32; tb += F.G) {
        const int tok = tb * 32 + L31;
        float st[2][16];
#pragma unroll
        for (int t = 0; t < 2; ++t) {
            bf16x8 bq[8];
#pragma unroll
            for (int ks = 0; ks < 8; ++ks) bq[ks] = *(const GAS bf16x8*)(a.QP + (size_t)tok * NPQ + h * 256 + t * 128 + 16 * ks + 8 * hh);
            const bf16* kb = a.keys + (size_t)((h * 2 + t) * 128 + L31) * 128 + 8 * hh;
            float top[16];
#pragma unroll 1
            for (int nb = 0; nb < 4; ++nb) {
                f32x16 acc = {};
#pragma unroll
                for (int ks = 0; ks < 8; ++ks) { const bf16x8 af = *(const GAS bf16x8*)(kb + (size_t)nb * 32 * 128 + 16 * ks);
                    acc = __builtin_amdgcn_mfma_f32_32x32x16_bf16(af, bq[ks], acc, 0, 0, 0); }
                float bt[16];
#pragma unroll
                for (int r = 0; r < 16; ++r) bt[r] = __uint_as_float((__float_as_uint(acc[r]) & 0xFFFFFF80u) | (unsigned)(nb * 32 + crow(r, hh)));
                sort16_desc(bt);
                if (nb == 0) {
#pragma unroll
                    for (int r = 0; r < 16; ++r) top[r] = bt[r];
                } else merge16_desc(top, bt);
            }
            { float pt[16];
#pragma unroll
              for (int r = 0; r < 16; ++r) { auto rr = __builtin_amdgcn_permlane32_swap(__float_as_uint(top[r]), __float_as_uint(top[r]), false, false); pt[r] = __uint_as_float(hh ? rr[0] : rr[1]); }
              merge16_desc(top, pt); }
#pragma unroll
            for (int r = 0; r < 16; ++r) st[t][r] = top[r];
        }
        { unsigned w[8];
#pragma unroll
          for (int d = 0; d < 4; ++d) { w[d] = 0u; w[4 + d] = 0u;
#pragma unroll
              for (int k = 0; k < 4; ++k) { w[d] |= (__float_as_uint(st[0][4 * d + k]) & 0x7Fu) << (8 * k); w[4 + d] |= (__float_as_uint(st[1][4 * d + k]) & 0x7Fu) << (8 * k); } }
          *(LAS v4u*)(tab) = (v4u){w[0], w[1], w[2], w[3]}; *(LAS v4u*)(tab + 16) = (v4u){w[4], w[5], w[6], w[7]}; }
        float top[16], bt[16];
        const float NEG_INF = -__builtin_inff();
#define CAND(i, j) __uint_as_float((__float_as_uint(st[0][i] + st[1][j]) & 0xFFFFFF00u) | (unsigned)((i) * 16 + (j)))
        FILL_ROUND0 sort16_desc(bt);
#pragma unroll
        for (int r = 0; r < 16; ++r) top[r] = bt[r];
        FILL_ROUND1 sort16_desc(bt); merge16_desc(top, bt);
        FILL_ROUND2 sort16_desc(bt); merge16_desc(top, bt);
        FILL_ROUND3 sort16_desc(bt); merge16_desc(top, bt);
#undef CAND
        float e[16], es = 0.f;
#pragma unroll
        for (int r = 0; r < 16; ++r) { e[r] = __builtin_amdgcn_exp2f((top[r] - top[0]) * 1.4426950408889634f); es += e[r]; }
        const float inv = 1.f / es;
        LDS_WAIT();
        int ex[16];
#pragma unroll
        for (int r = 0; r < 16; ++r) { const unsigned cell = __float_as_uint(top[r]) & 0xFFu; const unsigned n0 = tab[cell >> 4], n1 = tab[16 + (cell & 15u)]; ex[r] = (int)(n0 * 128u + n1); e[r] *= inv; }
        int oi[8]; float og[8];
#pragma unroll
        for (int k = 0; k < 8; ++k) { oi[k] = hh ? ex[8 + k] : ex[k]; og[k] = hh ? e[8 + k] : e[k]; }
        int* ip = a.IDX + (size_t)tok * 128 + h * 16 + 8 * hh; float* gp = a.GATE + (size_t)tok * 128 + h * 16 + 8 * hh;
        *(GAS v4u*)ip = (v4u){(unsigned)oi[0], (unsigned)oi[1], (unsigned)oi[2], (unsigned)oi[3]}; *(GAS v4u*)(ip + 4) = (v4u){(unsigned)oi[4], (unsigned)oi[5], (unsigned)oi[6], (unsigned)oi[7]};
        *(GAS f32x4*)gp = (f32x4){og[0], og[1], og[2], og[3]}; *(GAS f32x4*)(gp + 4) = (f32x4){og[4], og[5], og[6], og[7]};
        LDS_WAIT(); asm volatile("" ::: "memory");
    }
}

#ifndef TBL_FP8
#define TBL_FP8 1
#endif
constexpr int NSL = TBL_FP8 ? 8 : 16, CW = D / NSL, ESZ = TBL_FP8 ? 1 : 2, ROWB = CW * ESZ, CPL = 16 / ESZ;
static_assert(ROWB == 128 && CPL * 8 == CW, "one cache line per (expert, slice) row, 8 lanes per row");
constexpr float U_SCALE = TBL_FP8 ? 1024.f : 1.f, V_SCALE = TBL_FP8 ? 16.f : 1.f;
__device__ __forceinline__ float dot2bf(unsigned a, unsigned b, float c) { return __builtin_amdgcn_fdot2_f32_bf16(__builtin_bit_cast(bf16x2_t, a), __builtin_bit_cast(bf16x2_t, b), c, false); }
__device__ __forceinline__ float dot8(const v4u a, const v4u b, float c) {
    c = dot2bf(a.x, b.x, c); c = dot2bf(a.y, b.y, c); c = dot2bf(a.z, b.z, c); c = dot2bf(a.w, b.w, c); return c;
}
__device__ __forceinline__ void cvt_table(const Frame& F, const float* src, unsigned char* dst, float scale) {
    const long gt = (long)(F.vcu * NWAVES + F.wave) * 64 + F.lane, NT = (long)F.G * NWAVES * 64, n8 = (long)NEXP * D / 8;
    for (long i = gt; i < n8; i += NT) { const long e = i >> 7; const int c0 = (int)(i & 127) * 8, s = c0 / CW, cc = c0 % CW;
        const f32x4 a = *(const GAS f32x4*)(src + i * 8), b = *(const GAS f32x4*)(src + i * 8 + 4);
        unsigned char* d = dst + ((size_t)s * NEXP + e) * ROWB + cc * ESZ;
#if TBL_FP8
        int w0 = 0, w1 = 0;
        w0 = __builtin_amdgcn_cvt_pk_fp8_f32(a[0] * scale, a[1] * scale, w0, false); w0 = __builtin_amdgcn_cvt_pk_fp8_f32(a[2] * scale, a[3] * scale, w0, true);
        w1 = __builtin_amdgcn_cvt_pk_fp8_f32(b[0] * scale, b[1] * scale, w1, false); w1 = __builtin_amdgcn_cvt_pk_fp8_f32(b[2] * scale, b[3] * scale, w1, true);
        *(GAS v2u*)d = (v2u){(unsigned)w0, (unsigned)w1};
#else
        (void)scale; v4u o; o.x = pk2(a[0], a[1]); o.y = pk2(a[2], a[3]); o.z = pk2(b[0], b[1]); o.w = pk2(b[2], b[3]); *(GAS v4u*)d = o;
#endif
    }
}
template <int CTRL> __device__ __forceinline__ float dpp_mov(float v) { return __builtin_bit_cast(float, __builtin_amdgcn_update_dpp(0, __builtin_bit_cast(int, v), CTRL, 0xF, 0xF, true)); }
#ifndef PEER_OPT
#define PEER_OPT 7
#endif
__device__ __forceinline__ float red8(float v) {
#if PEER_OPT & 1
    v += dpp_mov<0xB1>(v); v += dpp_mov<0x4E>(v); v += dpp_mov<0x141>(v); return v;
#else
    v += __shfl_xor(v, 1); v += __shfl_xor(v, 2); v += __shfl_xor(v, 4); return v;
#endif
}
__device__ __forceinline__ float red_groups(float v) {
#if !(PEER_OPT & 4)
    v += __shfl_xor(v, 8); v += __shfl_xor(v, 16); v += __shfl_xor(v, 32); return v;
#endif
    v += dpp_mov<0x128>(v);
    { unsigned a = __float_as_uint(v), b = a; asm volatile("" : "+v"(a), "+v"(b)); auto r = __builtin_amdgcn_permlane16_swap(a, b, false, false); v = __uint_as_float(r[0]) + __uint_as_float(r[1]); }
    { unsigned a = __float_as_uint(v), b = a; asm volatile("" : "+v"(a), "+v"(b)); auto r = __builtin_amdgcn_permlane32_swap(a, b, false, false); v = __uint_as_float(r[0]) + __uint_as_float(r[1]); }
    return v;
}
#if TBL_FP8
__device__ __forceinline__ void tbl_unpack2(const v4u w, f32x2 (&f)[8]) {
    f[0] = __builtin_amdgcn_cvt_pk_f32_fp8((int)w.x, false); f[1] = __builtin_amdgcn_cvt_pk_f32_fp8((int)w.x, true); f[2] = __builtin_amdgcn_cvt_pk_f32_fp8((int)w.y, false); f[3] = __builtin_amdgcn_cvt_pk_f32_fp8((int)w.y, true);
    f[4] = __builtin_amdgcn_cvt_pk_f32_fp8((int)w.z, false); f[5] = __builtin_amdgcn_cvt_pk_f32_fp8((int)w.z, true); f[6] = __builtin_amdgcn_cvt_pk_f32_fp8((int)w.w, false); f[7] = __builtin_amdgcn_cvt_pk_f32_fp8((int)w.w, true);
}
#endif
__device__ __forceinline__ void tbl_unpack(const v4u w, float (&f)[CPL]) {
#if TBL_FP8
#pragma unroll
    for (int i = 0; i < 4; ++i) { const unsigned x = i == 0 ? w.x : i == 1 ? w.y : i == 2 ? w.z : w.w;
        const f32x2 lo = __builtin_amdgcn_cvt_pk_f32_fp8((int)x, false), hi = __builtin_amdgcn_cvt_pk_f32_fp8((int)x, true);
        f[4 * i] = lo[0]; f[4 * i + 1] = lo[1]; f[4 * i + 2] = hi[0]; f[4 * i + 3] = hi[1]; }
#else
    f[0] = bflo(w.x); f[1] = bfhi(w.x); f[2] = bflo(w.y); f[3] = bfhi(w.y); f[4] = bflo(w.z); f[5] = bfhi(w.z); f[6] = bflo(w.w); f[7] = bfhi(w.w);
#endif
}
struct PeerArgs { const bf16* H2; const int* IDX; const float* GATE; const unsigned char* PU; const unsigned char* PV; float* PART; float* A; float* Y; float* io; const float* g_post2; const float* mod; };
__device__ __forceinline__ void pk_issue8(const unsigned char* tab, const v4u ia, const v4u ib, v4u (&w)[8]) {
    w[0] = *(const GAS v4u*)(tab + (size_t)ia.x * ROWB); w[1] = *(const GAS v4u*)(tab + (size_t)ia.y * ROWB); w[2] = *(const GAS v4u*)(tab + (size_t)ia.z * ROWB); w[3] = *(const GAS v4u*)(tab + (size_t)ia.w * ROWB);
    w[4] = *(const GAS v4u*)(tab + (size_t)ib.x * ROWB); w[5] = *(const GAS v4u*)(tab + (size_t)ib.y * ROWB); w[6] = *(const GAS v4u*)(tab + (size_t)ib.z * ROWB); w[7] = *(const GAS v4u*)(tab + (size_t)ib.w * ROWB);
}
__device__ __forceinline__ void p9_half(const v4u (&w)[8], const v4u h0, const v4u h1, float* val  ) {
#if TBL_FP8
    const f32x2 hp[8] = {{bflo(h0.x), bfhi(h0.x)}, {bflo(h0.y), bfhi(h0.y)}, {bflo(h0.z), bfhi(h0.z)}, {bflo(h0.w), bfhi(h0.w)}, {bflo(h1.x), bfhi(h1.x)}, {bflo(h1.y), bfhi(h1.y)}, {bflo(h1.z), bfhi(h1.z)}, {bflo(h1.w), bfhi(h1.w)}};
#pragma unroll
    for (int i = 0; i < 8; ++i) { f32x2 f[8]; tbl_unpack2(w[i], f);
        f32x2 s0 = f[0] * hp[0], s1 = f[1] * hp[1];
        s0 = f[2] * hp[2] + s0; s1 = f[3] * hp[3] + s1; s0 = f[4] * hp[4] + s0; s1 = f[5] * hp[5] + s1; s0 = f[6] * hp[6] + s0; s1 = f[7] * hp[7] + s1;
        const f32x2 t = s0 + s1; val[i] = red8(t.x + t.y) * (1.f / U_SCALE); }
#else
    (void)h1;
#pragma unroll
    for (int i = 0; i < 8; ++i) val[i] = red8(dot8(w[i], h0, 0.f));
#endif
}
__device__ __forceinline__ void p9_udots(const Frame& F, const PeerArgs& a) {
    const int lane = F.lane, sub = lane & 7, g8 = lane >> 3, label = F.vcu >> 5, rank = F.vcu & 31;
    constexpr int TS = 32 * NWAVES, NT = M / TS;
#pragma unroll 1
    for (int ps = 0; ps < NSL / 8; ++ps) {
        const int s = label + 8 * ps;
        const unsigned char* tab = a.PU + (size_t)s * NEXP * ROWB + sub * 16;
        float* part = a.PART + (size_t)label * M * 128;
        const int t0 = rank * NWAVES + F.wave;
        v4u wA[8], wB[8], ix0, ix1, ix2, ix3, h0, h1 = {0u, 0u, 0u, 0u}, n0, n1 = {0u, 0u, 0u, 0u};
        { const GAS v4u* ip = (const GAS v4u*)(a.IDX + (size_t)t0 * 128 + 16 * g8); ix0 = ip[0]; ix1 = ip[1]; ix2 = ip[2]; ix3 = ip[3]; }
        pk_issue8(tab, ix0, ix1, wA); pk_issue8(tab, ix2, ix3, wB);
        { const bf16* hp = a.H2 + (size_t)t0 * D + s * CW + sub * CPL; h0 = *(const GAS v4u*)hp; if (TBL_FP8) h1 = *(const GAS v4u*)(hp + 8); }
        { const GAS v4u* ip = (const GAS v4u*)(a.IDX + (size_t)(t0 + TS) * 128 + 16 * g8); ix0 = ip[0]; ix1 = ip[1]; ix2 = ip[2]; ix3 = ip[3]; }
#pragma unroll 1
        for (int k = 0; k < NT; ++k) { const int tk = t0 + k * TS, tn = (k + 1 < NT) ? tk + TS : tk, tnn = (k + 2 < NT) ? tk + 2 * TS : tk;
            float val[16];
            p9_half(wA, h0, h1, val); SBAR();
            pk_issue8(tab, ix0, ix1, wA); SBAR();
            p9_half(wB, h0, h1, val + 8); SBAR();
            pk_issue8(tab, ix2, ix3, wB); { const bf16* hp = a.H2 + (size_t)tn * D + s * CW + sub * CPL; n0 = *(const GAS v4u*)hp; if (TBL_FP8) n1 = *(const GAS v4u*)(hp + 8); }
            { const GAS v4u* ip = (const GAS v4u*)(a.IDX + (size_t)tnn * 128 + 16 * g8); ix0 = ip[0]; ix1 = ip[1]; ix2 = ip[2]; ix3 = ip[3]; } SBAR();
            if (sub == 0) { GAS f32x4* pp = (GAS f32x4*)(part + (size_t)tk * 128 + 16 * g8);
#pragma unroll
                for (int q = 0; q < 4; ++q) { f32x4 v = {val[4 * q], val[4 * q + 1], val[4 * q + 2], val[4 * q + 3]}; if (ps > 0) v += pp[q]; pp[q] = v; } }
            h0 = n0; h1 = n1;
        }
    }
}
__device__ __forceinline__ void p10_acomb(const Frame& F, const PeerArgs& a) {
    const long gt = (long)(F.vcu * NWAVES + F.wave) * 64 + F.lane, NT = (long)F.G * NWAVES * 64, n4 = (long)M * 128 / 4;
    for (long i = gt; i < n4; i += NT) { f32x4 s = *(const GAS f32x4*)(a.PART + i * 4);
#pragma unroll
        for (int j = 1; j < 8; ++j) s += *(const GAS f32x4*)(a.PART + (size_t)j * M * 128 + i * 4);
        const f32x4 g = *(const GAS f32x4*)(a.GATE + i * 4);
        *(GAS f32x4*)(a.A + i * 4) = (f32x4){gelu_tanh(s[0]) * g[0], gelu_tanh(s[1]) * g[1], gelu_tanh(s[2]) * g[2], gelu_tanh(s[3]) * g[3]}; }
}
__device__ __forceinline__ void p11_half(const v4u (&w)[8], const f32x4 aa, const f32x4 ab, float (&acc)[CPL]) {
#pragma unroll
    for (int i = 0; i < 8; ++i) { const float ai = i == 0 ? aa.x : i == 1 ? aa.y : i == 2 ? aa.z : i == 3 ? aa.w : i == 4 ? ab.x : i == 5 ? ab.y : i == 6 ? ab.z : ab.w;
#if TBL_FP8
        f32x2 f[8]; tbl_unpack2(w[i], f); const f32x2 a2 = {ai, ai};
#pragma unroll
        for (int c = 0; c < 8; ++c) { f32x2 t = {acc[2 * c], acc[2 * c + 1]}; t = f[c] * a2 + t; acc[2 * c] = t.x; acc[2 * c + 1] = t.y; }
#else
        float f[CPL]; tbl_unpack(w[i], f);
#pragma unroll
        for (int c = 0; c < CPL; ++c) acc[c] += ai * f[c];
#endif
    }
}
__device__ __forceinline__ void p11_vaxpy(const Frame& F, const PeerArgs& a) {
    const int lane = F.lane, sub = lane & 7, g8 = lane >> 3, label = F.vcu >> 5, rank = F.vcu & 31;
    constexpr int TS = 32 * NWAVES, NT = M / TS;
#pragma unroll 1
    for (int ps = 0; ps < NSL / 8; ++ps) {
        const int s = label + 8 * ps;
        const unsigned char* tab = a.PV + (size_t)s * NEXP * ROWB + sub * 16;
        const int t0 = rank * NWAVES + F.wave;
        v4u wA[8], wB[8], ix0, ix1, ix2, ix3; f32x4 a0, a1, a2, a3, m0, m1, m2, m3;
        { const GAS v4u* ip = (const GAS v4u*)(a.IDX + (size_t)t0 * 128 + 16 * g8); ix0 = ip[0]; ix1 = ip[1]; ix2 = ip[2]; ix3 = ip[3]; }
        pk_issue8(tab, ix0, ix1, wA); pk_issue8(tab, ix2, ix3, wB);
        { const GAS f32x4* ap = (const GAS f32x4*)(a.A + (size_t)t0 * 128 + 16 * g8); a0 = ap[0]; a1 = ap[1]; a2 = ap[2]; a3 = ap[3]; }
        { const GAS v4u* ip = (const GAS v4u*)(a.IDX + (size_t)(t0 + TS) * 128 + 16 * g8); ix0 = ip[0]; ix1 = ip[1]; ix2 = ip[2]; ix3 = ip[3]; }
        m0 = a0; m1 = a1; m2 = a2; m3 = a3;
#pragma unroll 1
        for (int k = 0; k < NT; ++k) { const int tk = t0 + k * TS, tn = (k + 1 < NT) ? tk + TS : tk, tnn = (k + 2 < NT) ? tk + 2 * TS : tk;
            float acc[CPL];
#pragma unroll
            for (int c = 0; c < CPL; ++c) acc[c] = 0.f;
            p11_half(wA, a0, a1, acc); SBAR();
            pk_issue8(tab, ix0, ix1, wA); SBAR();
            p11_half(wB, a2, a3, acc); SBAR();
            pk_issue8(tab, ix2, ix3, wB); { const GAS f32x4* ap = (const GAS f32x4*)(a.A + (size_t)tn * 128 + 16 * g8); m0 = ap[0]; m1 = ap[1]; m2 = ap[2]; m3 = ap[3]; }
            { const GAS v4u* ip = (const GAS v4u*)(a.IDX + (size_t)tnn * 128 + 16 * g8); ix0 = ip[0]; ix1 = ip[1]; ix2 = ip[2]; ix3 = ip[3]; } SBAR();
#pragma unroll
            for (int c = 0; c < CPL; ++c) acc[c] = red_groups(acc[c]) * (1.f / V_SCALE);
            if (g8 == 0) { GAS f32x4* yp = (GAS f32x4*)(a.Y + (size_t)tk * D + s * CW + sub * CPL);
#pragma unroll
                for (int q = 0; q < CPL / 4; ++q) yp[q] = (f32x4){acc[4 * q], acc[4 * q + 1], acc[4 * q + 2], acc[4 * q + 3]}; }
            a0 = m0; a1 = m1; a2 = m2; a3 = m3;
        }
    }
}
__device__ __forceinline__ void p12_final(const Frame& F, const PeerArgs& a) {
    const int gw = F.vcu * NWAVES + F.wave, NGW = F.G * NWAVES;
    f32x4 ny[4], nx[4];
    { const GAS f32x4* yr = (const GAS f32x4*)(a.Y + (size_t)gw * D) + F.lane; const GAS f32x4* xr = (const GAS f32x4*)(a.io + (size_t)gw * D) + F.lane;
#pragma unroll
      for (int j = 0; j < 4; ++j) { ny[j] = yr[64 * j]; nx[j] = xr[64 * j]; } }
    for (int m = gw; m < M; m += NGW) { const int b = m >> 12; const float* gt2 = a.mod + b * NMOD + 5 * D;
        GAS f32x4* orow = (GAS f32x4*)(a.io + (size_t)m * D) + F.lane;
        f32x4 v[4], xv[4]; float ss = 0.f;
#pragma unroll
        for (int j = 0; j < 4; ++j) { v[j] = ny[j]; xv[j] = nx[j]; ss += (v[j].x * v[j].x + v[j].y * v[j].y) + (v[j].z * v[j].z + v[j].w * v[j].w); }
        { const int mn = (m + NGW < M) ? m + NGW : m;
          if (mn != m) { const GAS f32x4* yr = (const GAS f32x4*)(a.Y + (size_t)mn * D) + F.lane; const GAS f32x4* xr = (const GAS f32x4*)(a.io + (size_t)mn * D) + F.lane;
#pragma unroll
          for (int j = 0; j < 4; ++j) { ny[j] = yr[64 * j]; nx[j] = xr[64 * j]; } } }
        const float rs = 1.f / sqrtf(wave_sum(ss) * (1.f / D) + EPS);
#pragma unroll
        for (int j = 0; j < 4; ++j) { const int col = 256 * j + 4 * F.lane; const f32x4 g = *(const f32x4*)(a.g_post2 + col), gt = *(const f32x4*)(gt2 + col);
            orow[64 * j] = xv[j] + gt * (v[j] * rs * g); }
    }
}


#ifndef DBG_STOP
#define DBG_STOP 99
#endif
__device__ __forceinline__ void dbg_dump(const Frame& F, float* out, const bf16* b0, const bf16* b1, const bf16* b2, const bf16* b3, const bf16* b4) {
    const int gw = F.vcu * NWAVES + F.wave, NGW = F.G * NWAVES;
    for (int m = gw; m < M; m += NGW) {
#pragma unroll
        for (int j = 0; j < 4; ++j) { const size_t off = (size_t)m * D + 256 * j + 4 * F.lane; f32x4 s = {0.f, 0.f, 0.f, 0.f};
            const bf16* bs[5] = {b0, b1, b2, b3, b4};
#pragma unroll
            for (int k = 0; k < 5; ++k) if (bs[k]) { const v2u w = *(const GAS v2u*)(bs[k] + off); s += (f32x4){bflo(w.x), bfhi(w.x), bflo(w.y), bfhi(w.y)}; }
            *(GAS f32x4*)(out + off) = s; }
    }
}
struct Args { const void* in[26]; float* out; unsigned char* ws; int ph_lo, ph_hi; };
__global__ void __launch_bounds__(NWAVES * 64, 2) mk_fwd(Args args) {
    extern __shared__ __attribute__((aligned(16))) unsigned char lds[];
    Frame F;
    F.lds = (LAS unsigned char*)lds;
    F.tid = threadIdx.x; F.lane = F.tid & 63; F.wave = __builtin_amdgcn_readfirstlane(F.tid >> 6);
    F.G = gridDim.x; { const int bx = blockIdx.x; F.vcu = (F.G % 8 == 0) ? (bx % 8) * (F.G / 8) + bx / 8 : bx; }
    unsigned char* ws = args.ws;
    gu32* ctl = (gu32*)(ws + WS_CTL);
    volatile LAS unsigned* MISC = (volatile LAS unsigned*)(F.lds + MISC_OFF);
    for (int u = F.tid; u < (LDS_BYTES - LDSCTL_OFF) / 4; u += NWAVES * 64) ((LAS unsigned*)(F.lds + LDSCTL_OFF))[u] = 0u;
    __syncthreads();
    XcdBarrier bar; bar.bar = (unsigned*)(ctl + CW_BAR); bar.x = 0; bar.st = nullptr;
    if (N_LAUNCHES == 1) bar = xcd_barrier_post((unsigned*)(ctl + CW_BAR), MISC + 8);
#define GRID_BAR() do { if (N_LAUNCHES == 1) xcd_barrier(bar); } while (0)
    const int lo = args.ph_lo, hi = args.ph_hi;
#ifndef PH_MASK
#define PH_MASK 0x1FFF
#endif
#define IN(k) ((((PH_MASK) >> (k)) & 1) && (k) <= DBG_STOP && lo <= (k) && (k) < hi)
#define BOTH(k) (IN(k) && IN((k) + 1))
#ifndef REP_MASK
#define REP_MASK 0
#endif
#define NREP(k) ((((REP_MASK) >> (k)) & 1) ? 2 : 1)
    const float* x = (const float*)args.in[0]; const float* mod = (const float*)(ws + WS_MOD);
    float* out = args.out;
    bf16* GA = (bf16*)out; bf16* GG = (bf16*)out + (size_t)M * D;

    if (IN(0)) {
        P0Args a{(const float*)args.in[1], (const float*)args.in[3], (const float*)args.in[4], (const float*)args.in[7], (const float*)args.in[13], (const float*)args.in[18], (const float*)args.in[19],
                 (const float*)args.in[22], (const float*)args.in[23], (const float*)args.in[16], (const int*)args.in[2], ws};
        for (int rep = 0; rep < NREP(0); ++rep) p0_prologue(F, a); if (BOTH(0)) GRID_BAR();
    }
    if (IN(1)) { for (int rep = 0; rep < NREP(1); ++rep) p1_xn(F, x, (const float*)args.in[5], mod, (bf16*)(ws + WS_XN)); if (BOTH(1)) GRID_BAR(); }
    if (IN(2)) {
        pg8::Gemm g{(const bf16*)(ws + WS_XN), nullptr, (const bf16*)(ws + WS_WIN), nullptr, M, NIN, D}; pg8::StaticOrder S; S.init(M, NIN, F.G, (int)blockIdx.x);
        pg8::EpiInProj E{(bf16*)(ws + WS_Q), (bf16*)(ws + WS_K), (bf16*)(ws + WS_V), (bf16*)(ws + WS_U), (bf16*)(ws + WS_ZV), GA, GG, (const float*)(ws + WS_ROPE), (float*)(ws + WS_STATS)};
        for (int rep = 0; rep < NREP(2); ++rep) pg8::gemm_phase<pg8::EpiInProj, pg8::StaticOrder, true, true>(F.lds, g, S, E);
        if (BOTH(2)) GRID_BAR();
    }
    if (IN(3)) {
        GmlpArgs ga{(const bf16*)(ws + WS_ZV), (bf16*)(ws + WS_U), (bf16*)(ws + WS_U), (const float*)(ws + WS_STATS), (const float*)args.in[14], (const float*)args.in[15], (const bf16*)(ws + WS_WSP), (const float*)args.in[17]};
#ifndef NO_GMLP
        if (NREP(13) == 2) { GmlpArgs gd = ga; gd.SGo = (bf16*)(ws + 424 * MiB); p3_gmlp(F, gd); }
        p3_gmlp(F, ga);
#endif
        float lam;
        { const float* lq1 = (const float*)args.in[8]; const float* lk1 = (const float*)args.in[9]; const float* lq2 = (const float*)args.in[10]; const float* lk2 = (const float*)args.in[11];
          float s1 = 0.f, s2 = 0.f; for (int i = 0; i < 64; ++i) { s1 += lq1[i] * lk1[i]; s2 += lq2[i] * lk2[i]; }
          lam = __expf(s1) - __expf(s2) + 0.2f; }
        const bf16* Qb = (const bf16*)(ws + WS_Q); const bf16* Kb = (const bf16*)(ws + WS_K); const bf16* Vb = (const bf16*)(ws + WS_V);
        float* stash = (float*)(ws + WS_O0) + (size_t)blockIdx.x * 32768;
#ifndef NO_ATT
#ifndef ATT_VAR
#define ATT_VAR 0
#endif
        if (NREP(3) == 2)
        for (int uu = F.vcu; uu < 1024; uu += F.G) {
            const int bh = uu >> 4, qb = uu & 15, b = bh >> 3, h = bh & 7; const size_t ro = (size_t)b * SEQ * D + h * 128;
            att::attn_unit(Qb + ro, Kb + ro, Vb + ro, (bf16*)(ws + 424 * MiB) + ro, qb * 256, lam, (const float*)args.in[12], stash, (char*)lds); }
        for (int uu = F.vcu; uu < 1024; uu += F.G) {
            const int bh = uu >> 4, qb = uu & 15, b = bh >> 3, h = bh & 7; const size_t ro = (size_t)b * SEQ * D + h * 128;
            att::attn_unit(Qb + ro, Kb + ro, Vb + ro, (bf16*)(ws + WS_Q) + ro, qb * 256, lam, (const float*)args.in[12], stash, (char*)lds); }
#endif
        if (BOTH(3)) GRID_BAR();
    }
    if (IN(4)) {
        pg8::Gemm g{(const bf16*)(ws + WS_Q), (const bf16*)(ws + WS_U), (const bf16*)(ws + WS_WA), (const bf16*)(ws + WS_WG), M, D, D}; pg8::StaticOrder S; S.init(M, D, F.G, (int)blockIdx.x, 2);
        pg8::EpiMerge E{GA, GG, (bf16*)(ws + WS_MIXIN)};
        for (int rep = 0; rep < NREP(4); ++rep) pg8::gemm_phase<pg8::EpiMerge, pg8::StaticOrder, true, true>(F.lds, g, S, E);
        if (BOTH(4)) GRID_BAR();
    }
    if (IN(5)) {
        pg8::Gemm g{(const bf16*)(ws + WS_MIXIN), nullptr, (const bf16*)(ws + WS_WOUT), nullptr, M, D, D}; pg8::StaticOrder S; S.init(M, D, F.G, (int)blockIdx.x);
        pg8::EpiF32 E{out, D};
        for (int rep = 0; rep < NREP(5); ++rep) pg8::gemm_phase<pg8::EpiF32, pg8::StaticOrder, true, true>(F.lds, g, S, E);
        if (BOTH(5)) GRID_BAR();
    }
    if (IN(6)) {
        if (NREP(6) == 2) p6_rows(F, x, out, (float*)(ws + WS_PART), (const float*)args.in[6], (const float*)args.in[20], mod, (bf16*)(ws + WS_H2));
        p6_rows(F, x, out, out, (const float*)args.in[6], (const float*)args.in[20], mod, (bf16*)(ws + WS_H2));
        cvt_table(F, (const float*)args.in[24], ws + WS_PU, U_SCALE);
        cvt_table(F, (const float*)args.in[25], ws + WS_PV, V_SCALE);
        if (BOTH(6)) GRID_BAR();
    }
    if (IN(7)) {
        pg8::Gemm g{(const bf16*)(ws + WS_H2), nullptr, (const bf16*)(ws + WS_WPQ), nullptr, M, NPQ, D}; pg8::StaticOrder S; S.init(M, NPQ, F.G, (int)blockIdx.x);
        pg8::EpiBf16<0> E{(bf16*)(ws + WS_QP), NPQ, nullptr, 0, 0, 1.f};
        for (int rep = 0; rep < NREP(7); ++rep) pg8::gemm_phase<pg8::EpiBf16<0>, pg8::StaticOrder, true, true>(F.lds, g, S, E);
        if (BOTH(7)) GRID_BAR();
    }
    if (IN(8)) { RouteArgs ra{(const bf16*)(ws + WS_QP), (const bf16*)(ws + WS_KEYS), (int*)(ws + WS_IDX), (float*)(ws + WS_GATE)}; for (int rep = 0; rep < NREP(8); ++rep) p8_route(F, ra); if (BOTH(8)) GRID_BAR(); }
    PeerArgs pa{(const bf16*)(ws + WS_H2), (const int*)(ws + WS_IDX), (const float*)(ws + WS_GATE), ws + WS_PU, ws + WS_PV, (float*)(ws + WS_PART), (float*)(ws + WS_A), (float*)(ws + WS_Y), out, (const float*)args.in[21], mod};
    if (IN(9)) { for (int rep = 0; rep < NREP(9); ++rep) p9_udots(F, pa); if (BOTH(9)) GRID_BAR(); }
    if (IN(10)) { for (int rep = 0; rep < NREP(10); ++rep) p10_acomb(F, pa); if (BOTH(10)) GRID_BAR(); }
    if (IN(11)) { for (int rep = 0; rep < NREP(11); ++rep) p11_vaxpy(F, pa); if (BOTH(11)) GRID_BAR(); }
    if (IN(12)) { p12_final(F, pa); }
    if (DBG_STOP < 9 && lo <= DBG_STOP && DBG_STOP < hi) {
        if (N_LAUNCHES == 1) GRID_BAR();
        if (N_LAUNCHES != 1) {   }
    }
    if (DBG_STOP < 9 && ((N_LAUNCHES == 1 && hi > DBG_STOP) || (N_LAUNCHES != 1 && lo == DBG_STOP + 1))) {
        if (DBG_STOP == 2) dbg_dump(F, out, GA, nullptr, nullptr, nullptr, nullptr);
        if (DBG_STOP == 3) dbg_dump(F, out, (const bf16*)(ws + WS_Q), (const bf16*)(ws + WS_U), nullptr, nullptr, nullptr);
        if (DBG_STOP == 4) dbg_dump(F, out, (const bf16*)(ws + WS_MIXIN), nullptr, nullptr, nullptr, nullptr);

        if (DBG_STOP == 7) dbg_dump(F, out, (const bf16*)(ws + WS_QP), (const bf16*)(ws + WS_QP) + (size_t)M * D, nullptr, nullptr, nullptr);
        if (DBG_STOP == 8) dbg_dump(F, out, (const bf16*)(ws + WS_IDX), (const bf16*)(ws + WS_GATE), nullptr, nullptr, nullptr);
    }
#undef IN
#undef BOTH
}

extern "C" void kernel_launch(void* const* d_in, const int* in_sizes, int n_in, void* d_out, int out_size, void* d_ws, size_t ws_size, hipStream_t stream) {
    static int grid = 0;
    if (grid == 0) {
        if (n_in != 26 || in_sizes[0] != M * D || out_size != M * D || ws_size < WS_END) { fprintf(stderr, "kernel_launch: shape/workspace mismatch (n_in %d, in0 %d, out %d, ws %zu, need %zu)\n", n_in, n_in > 0 ? in_sizes[0] : -1, out_size, ws_size, (size_t)WS_END); grid = -1; return; }
        int dev = 0, cus = 0, per_cu = 0;
        if (hipGetDevice(&dev) != hipSuccess || hipDeviceGetAttribute(&cus, hipDeviceAttributeMultiprocessorCount, dev) != hipSuccess) { grid = -1; return; }
        if (hipFuncSetAttribute((const void*)mk_fwd, hipFuncAttributeMaxDynamicSharedMemorySize, LDS_BYTES) != hipSuccess) { fprintf(stderr, "kernel_launch: hipFuncSetAttribute failed\n"); grid = -1; return; }
        if (hipOccupancyMaxActiveBlocksPerMultiprocessor(&per_cu, (const void*)mk_fwd, NWAVES * 64, LDS_BYTES) != hipSuccess || per_cu < 1) { fprintf(stderr, "kernel_launch: occupancy query says %d\n", per_cu); per_cu = 1; }
        (void)hipGetLastError();
        grid = cus;
        if (grid % 8 != 0 || grid > 256) fprintf(stderr, "kernel_launch: note: grid %d\n", grid);
    }
    if (grid < 0) return;
    if (hipMemsetAsync((char*)d_ws + WS_CTL, 0, CTL_ZERO_BYTES, stream) != hipSuccess) { fprintf(stderr, "kernel_launch: memset failed\n"); return; }
    Args a{};
    for (int i = 0; i < 26; ++i) a.in[i] = d_in[i];
    a.out = (float*)d_out; a.ws = (unsigned char*)d_ws;
    for (int li = 0; li < N_LAUNCHES; ++li) {
        a.ph_lo = (N_LAUNCHES == 1) ? 0 : li; a.ph_hi = (N_LAUNCHES == 1) ? NPHASE : li + 1;
        hipLaunchKernelGGL(mk_fwd, dim3(grid), dim3(NWAVES * 64), LDS_BYTES, stream, a);
        const hipError_t le = hipPeekAtLastError();
        if (le != hipSuccess) { fprintf(stderr, "kernel_launch: launch %d failed: %s\n", li, hipGetErrorName(le)); break; }
    }
}
```
